# Optimizing an MI355X kernel written in HIP

```python
import jax
import jax.numpy as jnp
from jax import lax
import numpy as np

D_MODEL = 1024
BATCH = 8
SEQ = 4096
DEPTH = 4

HEAD_DIM = 64
N_HEADS_A = 8
N_HEADS_B = 8
AB_WIDTH = (N_HEADS_A + N_HEADS_B) * HEAD_DIM
ROT_DIM = HEAD_DIM // 4
ROPE_THETA = 500000.0
MOBA_BLOCK = 256
MOBA_TOPK = 3
MOBA_QCHUNK = 16
DILATED_BRANCHES = ((128, 1), (512, 4), (2048, 16))
DILATED_QCHUNK = 32
HGRN_EXPAND = 128
N_HEADS_C = D_MODEL // HGRN_EXPAND
HGRN_DV = D_MODEL // N_HEADS_C
HGRN_CHUNK = 64
N_GROUPS = 4
EXPERTS_PER_GROUP = 8
N_EXPERTS = N_GROUPS * EXPERTS_PER_GROUP
TOPK_IN_GROUP = 2
D_EXPERT = D_MODEL // 2
MOE_BLOCK = 128
N_EVEN = (DEPTH + 1) // 2
N_ODD = DEPTH // 2
DEEPNORM_ALPHA = (2.0 * DEPTH) ** 0.25
DEEPNORM_BETA = (8.0 * DEPTH) ** -0.25
LN_EPS = 1e-5
RMS_EPS = 1e-6

kernel_name = 'hybrid_moba_dilated_hgrn2_hmoe'


def layer_norm(x, g, b):
    xf = x.astype(jnp.float32)
    mu = jnp.mean(xf, axis=-1, keepdims=True)
    var = jnp.mean(jnp.square(xf - mu), axis=-1, keepdims=True)
    return ((xf - mu) * lax.rsqrt(var + LN_EPS) * g + b).astype(x.dtype)


def rope_tables(seq):
    half = ROT_DIM // 2
    inv = ROPE_THETA ** (-jnp.arange(half, dtype=jnp.float32) / half)
    ang = jnp.arange(seq, dtype=jnp.float32)[:, None] * inv[None, :]
    return jnp.cos(ang), jnp.sin(ang)


def apply_partial_rope(x, cos, sin):
    half = ROT_DIM // 2
    c = cos.astype(x.dtype)
    s = sin.astype(x.dtype)
    x1 = x[..., :half]
    x2 = x[..., half:ROT_DIM]
    return jnp.concatenate([x1 * c - x2 * s, x2 * c + x1 * s, x[..., ROT_DIM:]], axis=-1)


def moba_attention(q, k, v):
    B, H, S, hd = q.shape
    nb = -(-S // MOBA_BLOCK)
    pad = nb * MOBA_BLOCK - S
    k_blk = jnp.pad(k, ((0, 0), (0, 0), (0, pad), (0, 0))).reshape(B, H, nb, MOBA_BLOCK, hd)
    v_blk = jnp.pad(v, ((0, 0), (0, 0), (0, pad), (0, 0))).reshape(B, H, nb, MOBA_BLOCK, hd)
    k_mean = jnp.mean(k_blk.astype(jnp.float32), axis=3)
    topk = min(MOBA_TOPK, nb - 1)
    scale = hd ** -0.5
    b_idx = jnp.arange(B)[:, None, None, None]
    h_idx = jnp.arange(H)[None, :, None, None]
    blk_ids = jnp.arange(nb)
    in_blk = jnp.arange(MOBA_BLOCK)

    def one_chunk(c):
        start = c * MOBA_QCHUNK
        qc = lax.dynamic_slice_in_dim(q, start, MOBA_QCHUNK, axis=2)
        t = start + jnp.arange(MOBA_QCHUNK)
        own = start // MOBA_BLOCK
        k_own = lax.dynamic_index_in_dim(k_blk, own, axis=2, keepdims=False)
        v_own = lax.dynamic_index_in_dim(v_blk, own, axis=2, keepdims=False)
        s_own = jnp.einsum('bhqd,bhkd->bhqk', qc, k_own).astype(jnp.float32) * scale
        s_own = jnp.where((own * MOBA_BLOCK + in_blk)[None, :] <= t[:, None], s_own, -jnp.inf)
        if topk == 0:
            p = jax.nn.softmax(s_own, axis=-1).astype(v.dtype)
            return jnp.einsum('bhqk,bhkd->bhqd', p, v_own)
        gate = jnp.einsum('bhqd,bhnd->bhqn', qc.astype(jnp.float32), k_mean)
        gate = jnp.where(blk_ids < own, gate, -jnp.inf)
        _, sel = lax.top_k(gate, topk)
        sel_ok = jnp.arange(topk) < own
        k_sel = k_blk[b_idx, h_idx, sel]
        v_sel = v_blk[b_idx, h_idx, sel]
        s_sel = jnp.einsum('bhqd,bhqnkd->bhqnk', qc, k_sel).astype(jnp.float32) * scale
        s_sel = jnp.where(sel_ok[:, None], s_sel, -jnp.inf)
        s = jnp.concatenate([s_sel.reshape(B, H, MOBA_QCHUNK, topk * MOBA_BLOCK), s_own], axis=-1)
        p = jax.nn.softmax(s, axis=-1).astype(v.dtype)
        p_sel = p[..., :topk * MOBA_BLOCK].reshape(B, H, MOBA_QCHUNK, topk, MOBA_BLOCK)
        p_own = p[..., topk * MOBA_BLOCK:]
        return (jnp.einsum('bhqnk,bhqnkd->bhqd', p_sel, v_sel)
                + jnp.einsum('bhqk,bhkd->bhqd', p_own, v_own))

    out = lax.map(one_chunk, jnp.arange(S // MOBA_QCHUNK))
    return jnp.moveaxis(out, 0, 2).reshape(B, H, S, hd)


def dilated_attention(q, k, v):
    B, H, S, hd = q.shape
    scale = hd ** -0.5

    def one_chunk(c):
        start = c * DILATED_QCHUNK
        qc = lax.dynamic_slice_in_dim(q, start, DILATED_QCHUNK, axis=2)
        t = start + jnp.arange(DILATED_QCHUNK)
        outs = []
        lses = []
        for window, dil in DILATED_BRANCHES:
            offs = dil * jnp.arange(window // dil + 1)
            idx = t[:, None] - offs[None, :]
            valid = idx >= 0
            idx = jnp.maximum(idx, 0)
            k_g = k[:, :, idx]
            v_g = v[:, :, idx]
            s = jnp.einsum('bhqd,bhqnd->bhqn', qc, k_g).astype(jnp.float32) * scale
            s = jnp.where(valid, s, -jnp.inf)
            m = jnp.max(s, axis=-1, keepdims=True)
            p = jnp.exp(s - m)
            den = jnp.sum(p, axis=-1, keepdims=True)
            outs.append(jnp.einsum('bhqn,bhqnd->bhqd', (p / den).astype(v.dtype), v_g))
            lses.append(m + jnp.log(den))
        w = jax.nn.softmax(jnp.concatenate(lses, axis=-1), axis=-1).astype(v.dtype)
        return jnp.einsum('bhqr,rbhqd->bhqd', w, jnp.stack(outs))

    out = lax.map(one_chunk, jnp.arange(S // DILATED_QCHUNK))
    return jnp.moveaxis(out, 0, 2).reshape(B, H, S, hd)


def attn_ab_mixer(x, w_in, w_out, cos, sin):
    B, S, _ = x.shape
    wa = N_HEADS_A * HEAD_DIM
    wb = N_HEADS_B * HEAD_DIM
    h = x @ w_in
    cuts = [wa, 2 * wa, 3 * wa, 3 * wa + wb, 3 * wa + 2 * wb]
    q_a, k_a, v_a, q_b, k_b, v_b = jnp.split(h, cuts, axis=-1)

    def heads(z, n):
        return z.reshape(B, S, n, HEAD_DIM).transpose(0, 2, 1, 3)

    o_a = moba_attention(apply_partial_rope(heads(q_a, N_HEADS_A), cos, sin),
                         apply_partial_rope(heads(k_a, N_HEADS_A), cos, sin),
                         heads(v_a, N_HEADS_A))
    o_b = dilated_attention(apply_partial_rope(heads(q_b, N_HEADS_B), cos, sin),
                            apply_partial_rope(heads(k_b, N_HEADS_B), cos, sin),
                            heads(v_b, N_HEADS_B))
    o = jnp.concatenate([o_a, o_b], axis=1).transpose(0, 2, 1, 3).reshape(B, S, AB_WIDTH)
    return o @ w_out


def hgrn2_mixer(x, w_in, w_out, norm_g, lb):
    B, S, D = x.shape
    H, dk, dv, C = N_HEADS_C, HGRN_EXPAND, HGRN_DV, HGRN_CHUNK
    h = x @ w_in
    q, fz, i, g = jnp.split(h, 4, axis=-1)

    def heads(z, d):
        return z.reshape(B, S, H, d).transpose(0, 2, 1, 3).astype(jnp.float32)

    q = heads(q, dk)
    fz = heads(fz, dk)
    v = heads(i, dv)
    lb_h = lb.astype(jnp.float32).reshape(H, dk)[None, :, None, :]
    log_f = jnp.logaddexp(jnp.log(lb_h), jnp.log1p(-lb_h) + jax.nn.log_sigmoid(fz))
    kk = (1.0 - lb_h) * jax.nn.sigmoid(-fz)
    nc = S // C

    def to_chunks(z):
        return z.reshape(B, H, nc, C, z.shape[-1]).transpose(2, 0, 1, 3, 4)

    causal = jnp.tril(jnp.ones((C, C), dtype=bool))

    def step(state, inp):
        qc, kc, vc, lfc = inp
        b = jnp.cumsum(lfc, axis=2)
        inter = jnp.einsum('bhcd,bhde->bhce', qc * jnp.exp(b), state)
        diff = b[:, :, :, None, :] - b[:, :, None, :, :]
        decay = jnp.exp(jnp.where(causal[:, :, None], diff, -jnp.inf))
        attn = jnp.einsum('bhid,bhijd,bhjd->bhij', qc, decay, kc)
        intra = jnp.einsum('bhij,bhje->bhie', attn, vc)
        b_last = b[:, :, -1:, :]
        state = (jnp.exp(b_last[:, :, 0, :])[..., None] * state
                 + jnp.einsum('bhjd,bhje->bhde', kc * jnp.exp(b_last - b), vc))
        return state, inter + intra

    s0 = jnp.zeros((B, H, dk, dv), jnp.float32)
    _, o = lax.scan(step, s0, (to_chunks(q), to_chunks(kk), to_chunks(v), to_chunks(log_f)))
    o = o.transpose(1, 2, 0, 3, 4).reshape(B, H, S, dv)
    o = o * lax.rsqrt(jnp.mean(jnp.square(o), axis=-1, keepdims=True) + RMS_EPS) * norm_g
    o = o.transpose(0, 2, 1, 3).reshape(B, S, D) * jax.nn.silu(g.astype(jnp.float32))
    return o.astype(x.dtype) @ w_out


def hier_moe(x, wg, bg, we, be, w1, w3, w2):
    B, S, D = x.shape
    xt = x.reshape(-1, D)
    T = xt.shape[0]
    lg = (xt @ wg).astype(jnp.float32) + bg
    grp = jnp.argmax(lg, axis=-1)
    pg = jnp.take_along_axis(jax.nn.softmax(lg, axis=-1), grp[:, None], axis=-1)
    le = ((xt @ we).astype(jnp.float32) + be).reshape(T, N_GROUPS, EXPERTS_PER_GROUP)
    le_g = jnp.take_along_axis(le, grp[:, None, None], axis=1)[:, 0]
    top_l, top_i = lax.top_k(le_g, TOPK_IN_GROUP)
    gate = pg * jax.nn.softmax(top_l, axis=-1)
    eid = grp[:, None] * EXPERTS_PER_GROUP + top_i
    A = T * TOPK_IN_GROUP
    eid_f = eid.reshape(-1)
    tok_f = jnp.repeat(jnp.arange(T), TOPK_IN_GROUP)
    wt_f = gate.reshape(-1)
    order = jnp.argsort(eid_f)
    eid_s = eid_f[order]
    tok_s = tok_f[order]
    wt_s = wt_f[order]
    counts = jax.ops.segment_sum(jnp.ones((A,), jnp.int32), eid_f, num_segments=N_EXPERTS)
    starts = jnp.cumsum(counts) - counts
    padded = (counts + MOE_BLOCK - 1) // MOE_BLOCK * MOE_BLOCK
    pends = jnp.cumsum(padded)
    pstarts = pends - padded
    dest = pstarts[eid_s] + jnp.arange(A) - starts[eid_s]
    n_blk = (A + N_EXPERTS * (MOE_BLOCK - 1) + MOE_BLOCK - 1) // MOE_BLOCK
    P = n_blk * MOE_BLOCK
    buf_tok = jnp.zeros((P,), jnp.int32).at[dest].set(tok_s.astype(jnp.int32))
    buf_wt = jnp.zeros((P,), jnp.float32).at[dest].set(wt_s)
    blk_exp = jnp.minimum(jnp.searchsorted(pends, jnp.arange(n_blk) * MOE_BLOCK, side='right'),
                          N_EXPERTS - 1)

    def expert_block(args):
        e, toks, wts = args
        xb = xt[toks]
        hb = jax.nn.silu(xb @ w1[e]) * (xb @ w3[e])
        return (hb @ w2[e]) * wts[:, None].astype(xb.dtype)

    yb = lax.map(expert_block, (blk_exp, buf_tok.reshape(n_blk, MOE_BLOCK),
                                buf_wt.reshape(n_blk, MOE_BLOCK)))
    y = jax.ops.segment_sum(yb.reshape(P, D), buf_tok, num_segments=T)
    return y.reshape(B, S, D)


def setup_inputs(seed: int = 0) -> dict:
    key = jax.random.key(seed)
    ks = jax.random.split(key, 17)
    f32 = jnp.float32
    D, F = D_MODEL, D_EXPERT
    nrm = lambda k, shape: jax.random.normal(k, shape, f32)
    return {
        'x': nrm(ks[0], (BATCH, SEQ, D)),
        'ab_w_in': nrm(ks[1], (N_EVEN, D, 3 * AB_WIDTH)) * D ** -0.5,
        'ab_w_out': nrm(ks[2], (N_EVEN, AB_WIDTH, D)) * AB_WIDTH ** -0.5 * DEEPNORM_BETA,
        'c_w_in': nrm(ks[3], (N_ODD, D, 4 * D)) * D ** -0.5,
        'c_w_out': nrm(ks[4], (N_ODD, D, D)) * D ** -0.5 * DEEPNORM_BETA,
        'c_norm_g': 1.0 + 0.02 * nrm(ks[5], (N_ODD, HGRN_DV)),
        'hgrn_lb_logits': 0.1 * nrm(ks[6], (N_ODD, D)),
        'ln_g': 1.0 + 0.02 * nrm(ks[7], (DEPTH, 2, D)),
        'ln_b': 0.02 * nrm(ks[8], (DEPTH, 2, D)),
        'router_g_w': nrm(ks[9], (DEPTH, D, N_GROUPS)) * D ** -0.5,
        'router_g_b': 0.01 * nrm(ks[10], (DEPTH, N_GROUPS)),
        'router_e_w': nrm(ks[11], (DEPTH, D, N_EXPERTS)) * D ** -0.5,
        'router_e_b': 0.01 * nrm(ks[12], (DEPTH, N_EXPERTS)),
        'exp_w1': nrm(ks[13], (DEPTH, N_EXPERTS, D, F)) * D ** -0.5,
        'exp_w3': nrm(ks[14], (DEPTH, N_EXPERTS, D, F)) * D ** -0.5,
        'exp_w2': nrm(ks[15], (DEPTH, N_EXPERTS, F, D)) * F ** -0.5 * DEEPNORM_BETA,
    }


def reference(x, ab_w_in, ab_w_out, c_w_in, c_w_out, c_norm_g, hgrn_lb_logits, ln_g, ln_b,
              router_g_w, router_g_b, router_e_w, router_e_b, exp_w1, exp_w3, exp_w2):
    S = x.shape[1]
    cos, sin = rope_tables(S)
    lb_all = jnp.cumsum(jax.nn.softmax(hgrn_lb_logits.astype(jnp.float32), axis=0), axis=0)
    lb_all = lb_all - lb_all[0:1]
    for l in range(DEPTH):
        j = l // 2
        if l % 2 == 0:
            mix = attn_ab_mixer(x, ab_w_in[j], ab_w_out[j], cos, sin)
        else:
            mix = hgrn2_mixer(x, c_w_in[j], c_w_out[j], c_norm_g[j], lb_all[j])
        x = layer_norm(DEEPNORM_ALPHA * x + mix, ln_g[l, 0], ln_b[l, 0])
        ffn = hier_moe(x, router_g_w[l], router_g_b[l], router_e_w[l], router_e_b[l],
                       exp_w1[l], exp_w3[l], exp_w2[l])
        x = layer_norm(DEEPNORM_ALPHA * x + ffn, ln_g[l, 1], ln_b[l, 1])
    return x
```

```cpp
#include <hip/hip_runtime.h>
#include <cstdio>
#include <cstdint>
#include <cmath>
namespace pg8 {
#define PG8_LAS __attribute__((address_space(3)))
typedef unsigned short bf16_t;
typedef short bf16x8 __attribute__((ext_vector_type(8)));
typedef float f32x4 __attribute__((ext_vector_type(4)));
typedef unsigned u32x4 __attribute__((ext_vector_type(4)));
constexpr int BM = 256, BK = 64, HALF = 128, HTB = HALF * BK * 2  , STAGE_BYTES = 8 * HTB, NXCD = 8, WGM = 8;

__host__ __device__ __forceinline__ int lds_byte(int r, int c) { const int st = (r >> 4) * 2 + (c >> 5), rr = r & 15, cc = c & 31, ob = rr * 64 + cc * 2; return st * 1024 + (ob ^ (((ob >> 9) & 1) << 5)); }
__host__ __device__ __forceinline__ void stage_rc(int b, int& R, int& C) { const int st = b / 1024, sb = b % 1024, swz = sb ^ (((sb >> 9) & 1) << 5); R = (st >> 1) * 16 + swz / 64; C = (st & 1) * 32 + (swz % 64) / 2; }
__host__ __device__ __forceinline__ int perm32(int rho) { const int n = rho >> 4, i = rho & 15; return 8 * (i >> 2) + 4 * n + (i & 3); }

struct Unit { int pm, pn; };
struct Gemm { const bf16_t* A; const bf16_t* Bt; int M, N, K; };

struct StaticOrder {
    int nM, nN, nwg, G, c;
    __host__ __device__ void init(int M, int N, int G_, int c_) { nM = M / BM; nN = N / BM; nwg = nM * nN; G = G_; c = c_; }
    __host__ __device__ bool next(int i, Unit& u) const {
        const long L = (long)i * G + c; if (L >= nwg) return false;
        int wgid = (int)L; { const int q = nwg / NXCD, r = nwg % NXCD, xcd = wgid % NXCD, off = wgid / NXCD; wgid = (xcd < r ? xcd * (q + 1) : r * (q + 1) + (xcd - r) * q) + off; }
        const int nig = WGM * nN, gid = wgid / nig, fm = gid * WGM, gsz = (nM - fm) < WGM ? (nM - fm) : WGM;
        u.pm = fm + ((wgid % nig) % gsz); u.pn = (wgid % nig) / gsz; return true;
    }
    __device__ __forceinline__ void a_ready(const Unit&) const {}
    __device__ __forceinline__ void done(const Unit&) const {}
};

__device__ __forceinline__ unsigned cvt_pk_bf16(float lo, float hi) { unsigned r; asm volatile("v_cvt_pk_bf16_f32 %0, %1, %2" : "=v"(r) : "v"(lo), "v"(hi)); return r; }
typedef float f32x2 __attribute__((ext_vector_type(2)));

__device__ __forceinline__ float silu_f(float a) { return a / (1.0f + __expf(-a)); }
struct EpiPlain {
    static constexpr bool PERM = true, AFTER_DRAIN = false;
    bf16_t* O; int ldc; int pn_mask;
    __device__ __forceinline__ void operator()(const f32x4 (&acc)[2][2][4][2], const Unit& u, int wr, int wc, int fr, int fq) const {
        const int row0 = u.pm * BM + wr * 64 + fr; const int col0 = (u.pn & pn_mask) * BM + wc * 32 + 8 * fq;
#pragma unroll
        for (int ai = 0; ai < 2; ++ai)
#pragma unroll
            for (int m = 0; m < 4; ++m) { bf16_t* rowp = O + (size_t)(row0 + ai * HALF + m * 16) * ldc + col0;
#pragma unroll
                for (int bj = 0; bj < 2; ++bj) { const f32x4 v0 = acc[ai][bj][m][0], v1 = acc[ai][bj][m][1];
                    u32x4 w; w.x = cvt_pk_bf16(v0[0], v0[1]); w.y = cvt_pk_bf16(v0[2], v0[3]); w.z = cvt_pk_bf16(v1[0], v1[1]); w.w = cvt_pk_bf16(v1[2], v1[3]);
                    *(u32x4*)(rowp + bj * HALF) = w; } }
    }
};
struct EpiSwiGlu {
    static constexpr bool PERM = true, AFTER_DRAIN = false;
    bf16_t* O; int ldc;
    __device__ __forceinline__ void operator()(const f32x4 (&acc)[2][2][4][2], const Unit& u, int wr, int wc, int fr, int fq) const {
        const int row0 = u.pm * BM + wr * 64 + fr; const int col0 = (u.pn & 3) * HALF + wc * 32 + 8 * fq;
#pragma unroll
        for (int ai = 0; ai < 2; ++ai)
#pragma unroll
            for (int m = 0; m < 4; ++m) { bf16_t* rowp = O + (size_t)(row0 + ai * HALF + m * 16) * ldc + col0;
                const f32x4 a0 = acc[ai][0][m][0], a1 = acc[ai][0][m][1], b0 = acc[ai][1][m][0], b1 = acc[ai][1][m][1];
                u32x4 w; w.x = cvt_pk_bf16(silu_f(a0[0]) * b0[0], silu_f(a0[1]) * b0[1]); w.y = cvt_pk_bf16(silu_f(a0[2]) * b0[2], silu_f(a0[3]) * b0[3]);
                w.z = cvt_pk_bf16(silu_f(a1[0]) * b1[0], silu_f(a1[1]) * b1[1]); w.w = cvt_pk_bf16(silu_f(a1[2]) * b1[2], silu_f(a1[3]) * b1[3]);
                *(u32x4*)rowp = w; }
    }
};
struct EpiResid {
    static constexpr bool PERM = false, AFTER_DRAIN = false;
    const float* base; float* out; float alpha;
    __device__ __forceinline__ void operator()(const f32x4 (&acc)[2][2][4][2], const Unit& u, int wr, int wc, int fr, int fq) const {
        const int row0 = u.pm * BM + wr * 64 + fr; const int col0 = u.pn * BM + wc * 32 + 4 * fq;
#pragma unroll
        for (int ai = 0; ai < 2; ++ai)
#pragma unroll
            for (int m = 0; m < 4; ++m) { const size_t off = (size_t)(row0 + ai * HALF + m * 16) * 1024 + col0;
#pragma unroll
                for (int bj = 0; bj < 2; ++bj)
#pragma unroll
                    for (int n = 0; n < 2; ++n) { const f32x4 bs = *(const f32x4*)(base + off + bj * HALF + n * 16);
                        *(f32x4*)(out + off + bj * HALF + n * 16) = bs * alpha + acc[ai][bj][m][n]; } }
    }
};
struct MoeOrder {
    const PG8_LAS int* tab; int G, vc;
    __device__ __forceinline__ bool next(int i, Unit& u) const {
        const long L = (long)i * G + vc; const int nt = __builtin_amdgcn_readfirstlane(tab[0]); if (L >= (long)nt * 4) return false;
        const int pm = (int)(L >> 2); u.pm = pm; u.pn = __builtin_amdgcn_readfirstlane(tab[1 + pm]) * 4 + (int)(L & 3); return true;
    }
    __device__ __forceinline__ void a_ready(const Unit&) const {}
    __device__ __forceinline__ void done(const Unit&) const {}
};
template <class Epi, class Sched, bool ALIGN_EPI = false, bool SP2 = false>
__device__ __forceinline__ void gemm_phase(PG8_LAS unsigned char* lds, const Gemm g, const Sched& S, const Epi& E) {
    int tid_ = threadIdx.x; asm volatile("" : "+v"(tid_));
    const int tid = tid_, wid = __builtin_amdgcn_readfirstlane(tid >> 6), lane = tid & 63, wr = wid >> 2, wc = wid & 3, fr = lane & 15, fq = lane >> 4;
    const int K = g.K, nt = K / BK;
    unsigned voffA[2], voffB[2];
#pragma unroll
    for (int i = 0; i < 2; ++i) { int R, C; stage_rc(tid * 16 + i * 8192, R, C); const int Rb = Epi::PERM ? ((R & ~31) + perm32(R & 31)) : R;
        voffA[i] = (unsigned)(R * K + C) * 2u; voffB[i] = (unsigned)(Rb * K + C) * 2u; }
    const size_t kstep = (size_t)(BK * 2);
    const size_t hstep = (size_t)HALF * K * 2;
    const size_t tstep = 2 * hstep;
    const unsigned ldsw = (unsigned)wid * 1024u;
    const int aoff = lds_byte(wr * 64 + fr, fq * 8), boff = lds_byte(wc * 32 + fr, fq * 8);
#define PG8_SA(b, h) (((b) * 2 + (h)) * HTB)
#define PG8_SB(b, h) ((4 + (b) * 2 + (h)) * HTB)
#define PG8_STAGE(bufoff, gbase, voff) do { _Pragma("unroll") for (int _i = 0; _i < 2; ++_i) \
        __builtin_amdgcn_global_load_lds((const unsigned*)((const char*)(gbase) + (voff)[_i]), (PG8_LAS unsigned*)(lds + (bufoff) + ldsw + _i * 8192), 16, 0, 0); } while (0)
#define PG8_LDA(dst, b, h) do { _Pragma("unroll") for (int m = 0; m < 4; ++m) _Pragma("unroll") for (int k = 0; k < 2; ++k) dst[m][k] = *(const PG8_LAS bf16x8*)(lds + PG8_SA(b, h) + aoff + m * 2048 + k * 1024); } while (0)
#define PG8_LDB(dst, b, h) do { _Pragma("unroll") for (int n = 0; n < 2; ++n) _Pragma("unroll") for (int k = 0; k < 2; ++k) dst[n][k] = *(const PG8_LAS bf16x8*)(lds + PG8_SB(b, h) + boff + n * 2048 + k * 1024); } while (0)
#define PG8_MMA(ai, bj, At, Bt) do { __builtin_amdgcn_s_setprio(1); _Pragma("unroll") for (int m = 0; m < 4; ++m) _Pragma("unroll") for (int n = 0; n < 2; ++n) _Pragma("unroll") for (int k = 0; k < 2; ++k) \
        acc[ai][bj][m][n] = __builtin_amdgcn_mfma_f32_16x16x32_bf16(Bt[n][k], At[m][k], acc[ai][bj][m][n], 0, 0, 0); __builtin_amdgcn_s_setprio(0); } while (0)
#define PG8_WAIT_V(n) asm volatile("s_waitcnt vmcnt(" #n ")" ::: "memory")
#define PG8_WAIT_L(n) asm volatile("s_waitcnt lgkmcnt(" #n ")" ::: "memory")
#define PG8_BAR __builtin_amdgcn_s_barrier()
#define PG8_SCHED __builtin_amdgcn_sched_barrier(0)
    Unit cur, nxt; int ui = 0;
    if (!S.next(0, cur)) return;
    f32x4 acc[2][2][4][2];
#pragma unroll
    for (int a = 0; a < 2; ++a)
#pragma unroll
        for (int b = 0; b < 2; ++b)
#pragma unroll
            for (int m = 0; m < 4; ++m)
#pragma unroll
                for (int n = 0; n < 2; ++n) acc[a][b][m][n] = (f32x4){0.f, 0.f, 0.f, 0.f};
    bf16x8 At[4][2], B0[2][2], B1[2][2];
    const char* cA = (const char*)g.A + (size_t)cur.pm * tstep; const char* cB = (const char*)g.Bt + (size_t)cur.pn * tstep;
    S.a_ready(cur);
    if constexpr (SP2) {
        PG8_STAGE(PG8_SB(0, 0), cB, voffB); PG8_STAGE(PG8_SB(0, 1), cB + hstep, voffB); PG8_STAGE(PG8_SA(0, 0), cA, voffA); PG8_STAGE(PG8_SA(0, 1), cA + hstep, voffA);
        if (wr == 1) PG8_BAR;
        PG8_WAIT_V(2); PG8_BAR;
        PG8_STAGE(PG8_SB(1, 0), cB + kstep, voffB); PG8_STAGE(PG8_SA(1, 0), cA + kstep, voffA); PG8_STAGE(PG8_SB(1, 1), cB + hstep + kstep, voffB);
        PG8_WAIT_V(6); PG8_BAR;
    } else {
        PG8_STAGE(PG8_SB(0, 0), cB, voffB); PG8_STAGE(PG8_SA(0, 0), cA, voffA); PG8_STAGE(PG8_SB(0, 1), cB + hstep, voffB); PG8_STAGE(PG8_SA(0, 1), cA + hstep, voffA);
        if (wr == 1) PG8_BAR;
        PG8_WAIT_V(4); PG8_BAR;
        PG8_STAGE(PG8_SB(1, 0), cB + kstep, voffB); PG8_STAGE(PG8_SA(1, 0), cA + kstep, voffA); PG8_STAGE(PG8_SB(1, 1), cB + hstep + kstep, voffB);
        PG8_WAIT_V(6); PG8_BAR;
    }
    for (;;) {
        const bool has_next = S.next(ui + 1, nxt);
        const char* nA = has_next ? (const char*)g.A + (size_t)nxt.pm * tstep : cA; const char* nB = has_next ? (const char*)g.Bt + (size_t)nxt.pn * tstep : cB;
        for (int t = 0; t < nt; t += 2) {
            const bool last = (t == nt - 2);
            const char* a1 = cA + (size_t)(t + 1) * kstep;
            const char* a2 = last ? nA : cA + (size_t)(t + 2) * kstep; const char* b2 = last ? nB : cB + (size_t)(t + 2) * kstep;
            const char* a3 = a2 + kstep; const char* b3 = b2 + kstep;
            if (last && has_next) S.a_ready(nxt);
            if constexpr (SP2) {
            PG8_LDB(B0, 0, 0); PG8_LDB(B1, 0, 1); PG8_SCHED; PG8_LDA(At, 0, 0); PG8_STAGE(PG8_SA(1, 1), a1 + hstep, voffA);
            PG8_WAIT_V(8); PG8_WAIT_L(0); PG8_BAR; PG8_MMA(0, 0, At, B0); PG8_MMA(0, 1, At, B1); PG8_BAR; PG8_SCHED;
            PG8_LDA(At, 0, 1); PG8_STAGE(PG8_SB(0, 0), b2, voffB); PG8_STAGE(PG8_SB(0, 1), b2 + hstep, voffB); PG8_STAGE(PG8_SA(0, 0), a2, voffA);
            PG8_WAIT_V(8); PG8_WAIT_L(0); PG8_BAR; PG8_MMA(1, 0, At, B0); PG8_MMA(1, 1, At, B1); PG8_BAR; PG8_SCHED;
            PG8_LDB(B0, 1, 0); PG8_LDB(B1, 1, 1); PG8_SCHED; PG8_LDA(At, 1, 0); PG8_STAGE(PG8_SA(0, 1), a2 + hstep, voffA);
            PG8_WAIT_V(8); PG8_WAIT_L(0); PG8_BAR; PG8_MMA(0, 0, At, B0); PG8_MMA(0, 1, At, B1); PG8_BAR; PG8_SCHED;
            PG8_LDA(At, 1, 1); PG8_STAGE(PG8_SB(1, 0), b3, voffB); PG8_STAGE(PG8_SB(1, 1), b3 + hstep, voffB); PG8_STAGE(PG8_SA(1, 0), a3, voffA);
            PG8_WAIT_V(8); PG8_WAIT_L(0); PG8_BAR; PG8_MMA(1, 0, At, B0); PG8_MMA(1, 1, At, B1); PG8_BAR; PG8_SCHED;
            } else {
            PG8_LDB(B0, 0, 0); PG8_SCHED; PG8_LDA(At, 0, 0); PG8_STAGE(PG8_SA(1, 1), a1 + hstep, voffA);
            PG8_WAIT_L(8); PG8_BAR; PG8_WAIT_L(0); PG8_MMA(0, 0, At, B0); PG8_BAR; PG8_SCHED;
            PG8_LDB(B1, 0, 1); PG8_STAGE(PG8_SB(0, 0), b2, voffB);
            PG8_BAR; PG8_WAIT_L(0); PG8_MMA(0, 1, At, B1); PG8_BAR;
            PG8_LDA(At, 0, 1); PG8_STAGE(PG8_SA(0, 0), a2, voffA);
            PG8_BAR; PG8_WAIT_L(0); PG8_MMA(1, 0, At, B0); PG8_BAR; PG8_SCHED;
            PG8_STAGE(PG8_SB(0, 1), b2 + hstep, voffB);
            PG8_WAIT_V(6); PG8_BAR; PG8_MMA(1, 1, At, B1); PG8_BAR;
            PG8_LDB(B0, 1, 0); PG8_SCHED; PG8_LDA(At, 1, 0); PG8_STAGE(PG8_SA(0, 1), a2 + hstep, voffA);
            PG8_WAIT_L(8); PG8_BAR; PG8_WAIT_L(0); PG8_MMA(0, 0, At, B0); PG8_BAR; PG8_SCHED;
            PG8_LDB(B1, 1, 1); PG8_STAGE(PG8_SB(1, 0), b3, voffB);
            PG8_BAR; PG8_WAIT_L(0); PG8_MMA(0, 1, At, B1); PG8_BAR;
            PG8_LDA(At, 1, 1); PG8_STAGE(PG8_SA(1, 0), a3, voffA);
            PG8_BAR; PG8_WAIT_L(0); PG8_MMA(1, 0, At, B0); PG8_BAR; PG8_SCHED;
            PG8_STAGE(PG8_SB(1, 1), b3 + hstep, voffB);
            PG8_WAIT_V(6); PG8_BAR; PG8_MMA(1, 1, At, B1); PG8_BAR;
            }
        }
        if constexpr (ALIGN_EPI) { if (wr == 0) PG8_BAR; }
        if constexpr (!Epi::AFTER_DRAIN) { E(acc, cur, wr, wc, fr, fq); S.done(cur); }
        if (!has_next) break;
#pragma unroll
        for (int a = 0; a < 2; ++a)
#pragma unroll
            for (int b = 0; b < 2; ++b)
#pragma unroll
                for (int m = 0; m < 4; ++m)
#pragma unroll
                    for (int n = 0; n < 2; ++n) acc[a][b][m][n] = (f32x4){0.f, 0.f, 0.f, 0.f};
        cur = nxt; cA = nA; cB = nB; ++ui;
        if constexpr (ALIGN_EPI) { if (wr == 1) PG8_BAR; }
    }
    PG8_WAIT_V(0);
    if constexpr (!ALIGN_EPI) { if (wr == 0) PG8_BAR; }
    PG8_BAR;
    if constexpr (Epi::AFTER_DRAIN) { E.fused(acc, cur, wr, wc, fr, fq, lds, wid, lane); S.done(cur); }
#undef PG8_SA
#undef PG8_SB
#undef PG8_STAGE
#undef PG8_LDA
#undef PG8_LDB
#undef PG8_MMA
#undef PG8_WAIT_V
#undef PG8_WAIT_L
#undef PG8_BAR
#undef PG8_SCHED
}
}

#define LAS __attribute__((address_space(3)))
#define XB_TMO      128
#define XB_XCNT(j)  (256  + 64 * (j))
#define XB_XSUB(j)  (1280 + 64 * (j))
#define XB_XGEN(j)  (2304 + 64 * (j))
#define XB_TOP      3328
#define XB_TOPGEN   3392
#define XCD_BAR_WORDS 3456
#define XB_SPIN_CAP (1u << 22)

__device__ __forceinline__ unsigned xb_ld(unsigned* p)              { return __hip_atomic_load(p, __ATOMIC_RELAXED, __HIP_MEMORY_SCOPE_AGENT); }
__device__ __forceinline__ unsigned xb_add(unsigned* p, unsigned v) { return __hip_atomic_fetch_add(p, v, __ATOMIC_RELAXED, __HIP_MEMORY_SCOPE_AGENT); }
__device__ __forceinline__ unsigned xb_xcc_id() { return (unsigned)__builtin_amdgcn_s_getreg((3 << 11) | 20) & 0xFu; }
#define XB_SPIN(cond, bar) do { unsigned _sp = 0; while (cond) { __builtin_amdgcn_s_sleep(1); \
    if ((++_sp & 255u) == 0u) { if (xb_ld(&(bar)[XB_TMO])) break; if (_sp > XB_SPIN_CAP) { atomicAdd(&(bar)[XB_TMO], 1u); break; } } } } while (0)

struct XcdBarrier {
    unsigned* bar; unsigned x;
    volatile LAS unsigned* st;
};

__device__ __forceinline__ XcdBarrier xcd_barrier_post(unsigned* bar, volatile LAS unsigned* st) {
    XcdBarrier b; b.bar = bar; b.x = xb_xcc_id(); b.st = st;
    if (threadIdx.x == 0) (void)xb_add(&bar[XB_XCNT(b.x)], 1u);
    return b;
}
__device__ __forceinline__ void xcd_barrier_complete(unsigned* bar, unsigned x, unsigned& nloc, unsigned& nx) {
    const unsigned G = gridDim.x * gridDim.y * gridDim.z;
    unsigned sum, cnt, mine, sp = 0u;
    for (;;) {
        sum = 0u; cnt = 0u; mine = 0u;
#pragma unroll
        for (unsigned j = 0; j < 16; ++j) { const unsigned c = xb_ld(&bar[XB_XCNT(j)]); sum += c; cnt += (c > 0u) ? 1u : 0u; mine = (j == x) ? c : mine; }
        if (sum == G) break;
        __builtin_amdgcn_s_sleep(1);
        if ((++sp & 255u) == 0u) { if (xb_ld(&bar[XB_TMO])) break; if (sp > XB_SPIN_CAP) { atomicAdd(&bar[XB_TMO], 1u); break; } }
    }
    nloc = mine > 0u ? mine : 1u; nx = cnt > 0u ? cnt : 1u;
}

__device__ __forceinline__ void xcd_barrier(const XcdBarrier& b) {
    asm volatile("s_waitcnt vmcnt(0)" ::: "memory");
    __syncthreads();
    if (threadIdx.x == 0) {
        unsigned* bar = b.bar;
        __builtin_amdgcn_s_waitcnt(0);
        unsigned nloc = b.st[0], nx = b.st[1];
        if (nloc == 0u) { xcd_barrier_complete(bar, b.x, nloc, nx); b.st[0] = nloc; b.st[1] = nx; }
        const unsigned old = xb_add(&bar[XB_XSUB(b.x)], 1u);
        const unsigned gen = old / nloc;
        if (old + 1u == (gen + 1u) * nloc) {
            __builtin_amdgcn_fence(__ATOMIC_RELEASE, "agent");
            asm volatile("s_waitcnt vmcnt(0)" ::: "memory");
            const unsigned og = xb_add(&bar[XB_TOP], 1u);
            const unsigned tg = og / nx;
            if (og + 1u == (tg + 1u) * nx) xb_add(&bar[XB_TOPGEN], 1u);
            else XB_SPIN(xb_ld(&bar[XB_TOPGEN]) == tg, bar);
            __builtin_amdgcn_fence(__ATOMIC_ACQUIRE, "agent");
            xb_add(&bar[XB_XGEN(b.x)], 1u);
            asm volatile("s_waitcnt vmcnt(0)" ::: "memory");
        } else {
            XB_SPIN(xb_ld(&bar[XB_XGEN(b.x)]) == gen, bar);
            __builtin_amdgcn_fence(__ATOMIC_ACQUIRE, "agent");
            asm volatile("s_waitcnt vmcnt(0)" ::: "memory");
        }
    }
    __syncthreads();
}

constexpr int NWAVES = 8;
constexpr int BATCH = 8, SEQ = 4096, D = 1024, T = BATCH * SEQ, DEPTH = 4;
constexpr int NQKV = 3072, NH4 = 4096, NEXP = 32, FEXP = 512;
constexpr int MAX_TILES = 288;
constexpr float ALPHA = 1.6817928305074292f;
constexpr float LN_EPS = 1e-5f, RMS_EPS = 1e-6f;
constexpr size_t MiB = 1u << 20;
constexpr size_t WS_CTL = 0, CTL_ZERO_BYTES = 1 * MiB;
constexpr size_t WS_ROPE = 1 * MiB;
constexpr size_t WS_LB = 1 * MiB + 256 * 1024;
constexpr size_t WS_KMEAN = 1 * MiB + 512 * 1024;
constexpr size_t WS_RE = 2 * MiB;
constexpr size_t WS_RW = 2 * MiB + 256 * 1024;
constexpr size_t WS_POS = 2 * MiB + 512 * 1024;
constexpr size_t WS_X = 8 * MiB;
constexpr size_t WS_XB = 136 * MiB;
constexpr size_t WS_WIN = 200 * MiB, WS_WOUT = 208 * MiB, WS_W13 = 210 * MiB, WS_W2 = 274 * MiB;
constexpr size_t WS_MIX = 306 * MiB;
constexpr size_t WS_O = 562 * MiB;
constexpr size_t WS_O32 = 626 * MiB;
constexpr size_t WS_XG = 306 * MiB, WS_HB = 450 * MiB, WS_YB = 522 * MiB;
constexpr size_t WS_END = 754 * MiB;
constexpr int CW_BAR = 4096;
constexpr int CW_CNT = 16384;
constexpr int CW_CUR = 16384 + 512;
constexpr int RING_BYTES = 131072, MISC_OFF = RING_BYTES, LDS_BYTES = RING_BYTES + 4096;

#define GAS __attribute__((address_space(1)))
typedef unsigned short bf16;
typedef unsigned v4u __attribute__((ext_vector_type(4)));
typedef unsigned v2u __attribute__((ext_vector_type(2)));
typedef float f32x4 __attribute__((ext_vector_type(4)));
#define LDS_WAIT() asm volatile("s_waitcnt lgkmcnt(0)" ::: "memory")
__device__ __forceinline__ unsigned f2bf(float f) { unsigned u = __builtin_bit_cast(unsigned, f); return (u + 0x7fffu + ((u >> 16) & 1u)) >> 16; }
__device__ __forceinline__ unsigned pk2(float lo, float hi) { return f2bf(lo) | (f2bf(hi) << 16); }
__device__ __forceinline__ float bf2f(unsigned short b) { return __builtin_bit_cast(float, (unsigned)b << 16); }
__device__ __forceinline__ float bflo(unsigned w) { return __builtin_bit_cast(float, w << 16); }
__device__ __forceinline__ float bfhi(unsigned w) { return __builtin_bit_cast(float, w & 0xffff0000u); }
__device__ __forceinline__ float wave_sum(float v) {
#pragma unroll
    for (int o = 1; o < 64; o <<= 1) v += __shfl_xor(v, o);
    return v;
}

struct Frame {
    LAS unsigned char* lds;
    volatile LAS unsigned* MISC;
    unsigned char* ws;
    int tid, lane, wave, gw, NGW, G;
};
__device__ __forceinline__ const float* in_ptr(const Frame& F, int i) {
    const unsigned lo = __builtin_amdgcn_readfirstlane(F.MISC[512 + 2 * i]), hi = __builtin_amdgcn_readfirstlane(F.MISC[513 + 2 * i]);
    return (const float*)(((unsigned long long)hi << 32) | lo);
}
#define LAUNDER_WS() unsigned char* ws = F.ws; int bx = blockIdx.x; asm volatile("" : "+s"(ws), "+s"(bx))
#define PHASE_BEGIN() unsigned char* ws = F.ws; int tid = threadIdx.x, bx = blockIdx.x; asm volatile("" : "+s"(ws), "+v"(tid), "+s"(bx)); const int lane = tid & 63, gw = bx * NWAVES + __builtin_amdgcn_readfirstlane(tid >> 6); (void)tid; (void)gw; (void)lane; (void)bx
__device__ __forceinline__ void transpose_item(const float* W, int K, int N, bf16* WT, int k0, int n0, size_t dst_row0, LAS float* scr, int lane) {
#pragma unroll 8
    for (int i = 0; i < 32; ++i) { const int kk = 2 * i + (lane >> 5); scr[kk * 33 + (lane & 31)] = W[(size_t)(k0 + kk) * N + n0 + (lane & 31)]; }
    LDS_WAIT(); asm volatile("" ::: "memory");
    const int c = lane & 7;
#pragma unroll
    for (int j = 0; j < 4; ++j) { const int n = (lane >> 3) + 8 * j; const LAS float* s = scr + (8 * c) * 33 + n;
        v4u o; o.x = pk2(s[0 * 33], s[1 * 33]); o.y = pk2(s[2 * 33], s[3 * 33]); o.z = pk2(s[4 * 33], s[5 * 33]); o.w = pk2(s[6 * 33], s[7 * 33]);
        *(v4u*)(WT + (dst_row0 + n) * (size_t)K + k0 + 8 * c) = o; }
    LDS_WAIT(); asm volatile("" ::: "memory");
}
__device__ __forceinline__ void convert_weights(Frame& F, int l) {
    PHASE_BEGIN();
    LAS float* scr = (LAS float*)(F.lds + F.wave * 16384);
    const int j = l >> 1; const bool even = (l & 1) == 0;
    const int Nin = even ? NQKV : NH4;
    const float* Win = even ? in_ptr(F, 1) + (size_t)j * D * NQKV : in_ptr(F, 3) + (size_t)j * D * NH4;
    const float* Wout = even ? in_ptr(F, 2) + (size_t)j * D * D : in_ptr(F, 4) + (size_t)j * D * D;
    const int I_in = 16 * (Nin / 32), I_out = 16 * 32, I_13 = 64 * 256, I_2 = 32 * 256;
    const int NIT = I_in + I_out + I_13 + I_2;
    for (int it = gw; it < NIT; it += F.NGW) {
        int r = it;
        if (r < I_in) { const int nb = Nin / 32, kb = r / nb, n0 = (r % nb) * 32; transpose_item(Win, D, Nin, (bf16*)(ws + WS_WIN), kb * 64, n0, (size_t)n0, scr, lane); continue; } r -= I_in;
        if (r < I_out) { const int kb = r / 32, n0 = (r % 32) * 32; transpose_item(Wout, D, D, (bf16*)(ws + WS_WOUT), kb * 64, n0, (size_t)n0, scr, lane); continue; } r -= I_out;
        if (r < I_13) { const int mat = r >> 8, e = mat >> 1, which = mat & 1, q = r & 255, kb = q >> 4, n0 = (q & 15) * 32;
            const float* W = in_ptr(F, which ? 14 : 13) + (size_t)(l * NEXP + e) * D * FEXP;
            transpose_item(W, D, FEXP, (bf16*)(ws + WS_W13), kb * 64, n0, (size_t)e * 1024 + (size_t)(n0 >> 7) * 256 + (n0 & 127) + which * 128, scr, lane); continue; } r -= I_13;
        { const int e = r >> 8, q = r & 255, kb = q >> 5, n0 = (q & 31) * 32;
            const float* W = in_ptr(F, 15) + (size_t)(l * NEXP + e) * FEXP * D;
            transpose_item(W, FEXP, D, (bf16*)(ws + WS_W2), kb * 64, n0, (size_t)e * 1024 + n0, scr, lane); }
    }
}

__device__ __forceinline__ void prologue(Frame& F) {
    PHASE_BEGIN();
    const float* x = in_ptr(F, 0); bf16* xb = (bf16*)(ws + WS_XB);
    for (int m = gw; m < T; m += F.NGW) {
        const f32x4* xr = (const f32x4*)(x + (size_t)m * D) + lane; v2u* o8 = (v2u*)(xb + (size_t)m * D) + lane;
#pragma unroll
        for (int j = 0; j < 4; ++j) { const f32x4 v = xr[64 * j]; v2u o; o.x = pk2(v.x, v.y); o.y = pk2(v.z, v.w); o8[64 * j] = o; }
    }
    float* rope = (float*)(ws + WS_ROPE);
    const int gt = gw * 64 + lane, NGT = F.NGW * 64;
    for (int idx = gt; idx < SEQ * 8; idx += NGT) { const int pos = idx >> 3, i = idx & 7;
        const float inv = powf(500000.0f, -(float)i / 8.0f); const float ang = (float)pos * inv;
        rope[pos * 16 + i] = cosf(ang); rope[pos * 16 + 8 + i] = sinf(ang); }
    float* lb = (float*)(ws + WS_LB);
    for (int idx = gt; idx < D; idx += NGT) { const float l0 = in_ptr(F, 6)[idx], l1 = in_ptr(F, 6)[D + idx];
        lb[idx] = 0.f; lb[D + idx] = 1.0f / (1.0f + expf(l0 - l1)); }
}

__device__ __forceinline__ void rope_phase(Frame& F) {
    PHASE_BEGIN();
    bf16* qkv = (bf16*)(ws + WS_MIX); const float* rope = (const float*)(ws + WS_ROPE);
    const int gt = gw * 64 + lane, NGT = F.NGW * 64;
    for (int idx = gt; idx < T * 256; idx += NGT) { const int row = idx >> 8, rh = (idx >> 3) & 31, i = idx & 7, pos = row & (SEQ - 1);
        const int col = (rh < 16 ? rh * 64 : 1536 + (rh - 16) * 64) + i;
        bf16* p = qkv + (size_t)row * NQKV + col;
        const float x1 = bf2f(p[0]), x2 = bf2f(p[8]), c = rope[pos * 16 + i], s = rope[pos * 16 + 8 + i];
        p[0] = (bf16)f2bf(x1 * c - x2 * s); p[8] = (bf16)f2bf(x2 * c + x1 * s); }
}
__device__ __forceinline__ void kmean_phase(Frame& F) {
    PHASE_BEGIN();
    const bf16* qkv = (const bf16*)(ws + WS_MIX); float* km = (float*)(ws + WS_KMEAN);
    const int gt = gw * 64 + lane, NGT = F.NGW * 64;
    for (int idx = gt; idx < BATCH * 8 * 16 * 64; idx += NGT) { const int d = idx & 63, blk = (idx >> 6) & 15, h = (idx >> 10) & 7, b = idx >> 13;
        const bf16* p = qkv + (size_t)(b * SEQ + blk * 256) * NQKV + 512 + h * 64 + d; float s = 0.f;
        for (int j = 0; j < 256; ++j) s += bf2f(p[(size_t)j * NQKV]);
        km[idx] = s * (1.0f / 256.0f); }
}

__device__ __forceinline__ void load64(const bf16* p, float (&v)[64]) {
    const v4u* q = (const v4u*)p;
#pragma unroll
    for (int i = 0; i < 8; ++i) { const v4u w = q[i];
        v[8 * i + 0] = bflo(w.x); v[8 * i + 1] = bfhi(w.x); v[8 * i + 2] = bflo(w.y); v[8 * i + 3] = bfhi(w.y);
        v[8 * i + 4] = bflo(w.z); v[8 * i + 5] = bfhi(w.z); v[8 * i + 6] = bflo(w.w); v[8 * i + 7] = bfhi(w.w); }
}
__device__ __forceinline__ void attend_key(const bf16* kp, const bf16* vp, const float (&q)[64], float (&acc)[64], float& m, float& l) {
    float kv[64]; load64(kp, kv); float s = 0.f;
#pragma unroll
    for (int d = 0; d < 64; ++d) s += q[d] * kv[d];
    s *= 0.125f;
    const float mn = fmaxf(m, s), c = __expf(m - mn), p = __expf(s - mn);
    l = l * c + p; m = mn;
    load64(vp, kv);
#pragma unroll
    for (int d = 0; d < 64; ++d) acc[d] = acc[d] * c + p * kv[d];
}
__device__ __forceinline__ void attn_naive_phase(Frame& F) {
    PHASE_BEGIN();
    const bf16* qkv = (const bf16*)(ws + WS_MIX); bf16* O = (bf16*)(ws + WS_O); const float* km = (const float*)(ws + WS_KMEAN);
    const int gt = bx * 512 + tid, NGT = F.G * 512;
    for (int item = gt; item < 16 * BATCH * SEQ; item += NGT) {
        const int t = item & (SEQ - 1), b = (item >> 12) & 7, hh = item >> 15;
        const size_t rowbase = (size_t)b * SEQ;
        float q[64], acc[64]; float m = -INFINITY, l = 0.f;
#pragma unroll
        for (int d = 0; d < 64; ++d) acc[d] = 0.f;
        if (hh < 8) {
            const int h = hh, own = t >> 8;
            load64(qkv + (rowbase + t) * NQKV + h * 64, q);
            const bf16* Kb = qkv + rowbase * NQKV + 512 + h * 64; const bf16* Vb = qkv + rowbase * NQKV + 1024 + h * 64;
            float g[16];
#pragma unroll
            for (int n = 0; n < 16; ++n) { g[n] = -INFINITY;
                if (n < own) { const float* kp = km + ((size_t)(b * 8 + h) * 16 + n) * 64; float s = 0.f;
#pragma unroll
                    for (int d = 0; d < 64; ++d) s += q[d] * kp[d];
                    g[n] = s; } }
            const int nsel = own < 3 ? own : 3; unsigned picked = 0u;
            for (int kt = own * 256; kt <= t; ++kt) attend_key(Kb + (size_t)kt * NQKV, Vb + (size_t)kt * NQKV, q, acc, m, l);
            for (int s = 0; s < nsel; ++s) { float best = -INFINITY; int bi = 0;
#pragma unroll
                for (int n = 0; n < 16; ++n) if (!((picked >> n) & 1u) && n < own && g[n] > best) { best = g[n]; bi = n; }
                picked |= 1u << bi;
                for (int kt = bi * 256; kt < bi * 256 + 256; ++kt) attend_key(Kb + (size_t)kt * NQKV, Vb + (size_t)kt * NQKV, q, acc, m, l); }
        } else {
            const int h = hh - 8;
            load64(qkv + (rowbase + t) * NQKV + 1536 + h * 64, q);
            const bf16* Kb = qkv + rowbase * NQKV + 2048 + h * 64; const bf16* Vb = qkv + rowbase * NQKV + 2560 + h * 64;
            for (int br = 0; br < 3; ++br) { const int dil = br == 0 ? 1 : (br == 1 ? 4 : 16);
                for (int n = 0; n <= 128; ++n) { const int kt = t - dil * n; if (kt < 0) break;
                    attend_key(Kb + (size_t)kt * NQKV, Vb + (size_t)kt * NQKV, q, acc, m, l); } }
        }
        const float rl = 1.0f / l; v4u* op = (v4u*)(O + (rowbase + t) * D + hh * 64);
#pragma unroll
        for (int i = 0; i < 8; ++i) { v4u w; w.x = pk2(acc[8 * i] * rl, acc[8 * i + 1] * rl); w.y = pk2(acc[8 * i + 2] * rl, acc[8 * i + 3] * rl);
            w.z = pk2(acc[8 * i + 4] * rl, acc[8 * i + 5] * rl); w.w = pk2(acc[8 * i + 6] * rl, acc[8 * i + 7] * rl); op[i] = w; }
    }
}

__device__ __forceinline__ void hgrn_naive_phase(Frame& F, int j) {
    PHASE_BEGIN();
    const bf16* H = (const bf16*)(ws + WS_MIX); float* O32 = (float*)(ws + WS_O32); const float* lbp = (const float*)(ws + WS_LB) + (size_t)j * D;
    const int gtw = bx * 8 + F.wave;
    if (gtw >= 128) return;
    const int bh = gtw >> 1, b = bh >> 3, h = bh & 7, e = (gtw & 1) * 64 + lane;
    float S[128];
#pragma unroll
    for (int d = 0; d < 128; ++d) S[d] = 0.f;
    const float* lbh = lbp + h * 128;
    for (int t = 0; t < SEQ; ++t) {
        const size_t row = (size_t)b * SEQ + t;
        const v4u* qp = (const v4u*)(H + row * NH4 + h * 128); const v4u* zp = (const v4u*)(H + row * NH4 + 1024 + h * 128);
        const float v = bf2f(H[row * NH4 + 2048 + h * 128 + e]);
        float o = 0.f;
#pragma unroll
        for (int c = 0; c < 16; ++c) { const v4u qw = qp[c], zw = zp[c];
            const unsigned qa[4] = {qw.x, qw.y, qw.z, qw.w}, za[4] = {zw.x, zw.y, zw.z, zw.w};
#pragma unroll
            for (int k = 0; k < 8; ++k) { const int d = 8 * c + k;
                const float z = (k & 1) ? bfhi(za[k >> 1]) : bflo(za[k >> 1]); const float qv = (k & 1) ? bfhi(qa[k >> 1]) : bflo(qa[k >> 1]);
                const float sg = 1.0f / (1.0f + __expf(-z)); const float lbv = lbh[d];
                const float f = lbv + (1.0f - lbv) * sg, kk = (1.0f - lbv) * (1.0f - sg);
                S[d] = f * S[d] + kk * v; o += qv * S[d]; } }
        O32[row * D + h * 128 + e] = o;
    }
}
__device__ __forceinline__ void hgrn_norm_phase(Frame& F, int j) {
    PHASE_BEGIN();
    const float* O32 = (const float*)(ws + WS_O32); const bf16* H = (const bf16*)(ws + WS_MIX); bf16* O = (bf16*)(ws + WS_O);
    const float* ng = in_ptr(F, 5) + (size_t)j * 128;
    for (int m = gw; m < T; m += F.NGW) {
        const f32x4* orow = (const f32x4*)(O32 + (size_t)m * D) + lane; const v2u* grow = (const v2u*)(H + (size_t)m * NH4 + 3072) + lane; v2u* out = (v2u*)(O + (size_t)m * D) + lane;
#pragma unroll
        for (int jj = 0; jj < 4; ++jj) { const f32x4 o = orow[64 * jj]; const v2u gw = grow[64 * jj];
            float ss = (o.x * o.x + o.y * o.y) + (o.z * o.z + o.w * o.w);
#pragma unroll
            for (int s = 1; s < 32; s <<= 1) ss += __shfl_xor(ss, s);
            const float r = 1.0f / sqrtf(ss * (1.0f / 128.0f) + RMS_EPS);
            const f32x4 gn = *(const f32x4*)(ng + ((4 * lane) & 127));
            const float g0 = bflo(gw.x), g1 = bfhi(gw.x), g2 = bflo(gw.y), g3 = bfhi(gw.y);
            v2u w; w.x = pk2(o.x * r * gn.x * (g0 / (1.0f + __expf(-g0))), o.y * r * gn.y * (g1 / (1.0f + __expf(-g1))));
            w.y = pk2(o.z * r * gn.z * (g2 / (1.0f + __expf(-g2))), o.w * r * gn.w * (g3 / (1.0f + __expf(-g3))));
            out[64 * jj] = w; }
    }
}

__device__ __forceinline__ void lna_phase(Frame& F, int l) {
    PHASE_BEGIN();
    float* X = (float*)(ws + WS_X); bf16* XB = (bf16*)(ws + WS_XB);
    const float* lg_ = in_ptr(F, 7) + (size_t)(l * 2) * D; const float* lb_ = in_ptr(F, 8) + (size_t)(l * 2) * D;
    const float* wg = in_ptr(F, 9) + (size_t)l * D * 4; const float* bg = in_ptr(F, 10) + l * 4; const float* we = in_ptr(F, 11) + (size_t)l * D * 32; const float* be = in_ptr(F, 12) + l * 32;
    int* RE = (int*)(ws + WS_RE); float* RW = (float*)(ws + WS_RW); unsigned* cnt = (unsigned*)(ws + WS_CTL) + CW_CNT + 64 * l;
    for (int m = gw; m < T; m += F.NGW) {
        f32x4* xr = (f32x4*)(X + (size_t)m * D) + lane; f32x4 v[4]; float s = 0.f;
#pragma unroll
        for (int j = 0; j < 4; ++j) { v[j] = xr[64 * j]; s += (v[j].x + v[j].y) + (v[j].z + v[j].w); }
        const float mean = wave_sum(s) * (1.f / D); float s2 = 0.f;
#pragma unroll
        for (int j = 0; j < 4; ++j) { v[j] = v[j] - mean; s2 += (v[j].x * v[j].x + v[j].y * v[j].y) + (v[j].z * v[j].z + v[j].w * v[j].w); }
        const float rstd = 1.f / sqrtf(wave_sum(s2) * (1.f / D) + LN_EPS);
        v2u* o8 = (v2u*)(XB + (size_t)m * D) + lane;
        float lg[4] = {0.f, 0.f, 0.f, 0.f}; float le[32];
#pragma unroll
        for (int i = 0; i < 32; ++i) le[i] = 0.f;
#pragma unroll
        for (int j = 0; j < 4; ++j) { const int c0 = 4 * lane + 256 * j; const f32x4 g = *(const f32x4*)(lg_ + c0), bb = *(const f32x4*)(lb_ + c0);
            v[j] = v[j] * rstd * g + bb; xr[64 * j] = v[j];
            v2u o; o.x = pk2(v[j].x, v[j].y); o.y = pk2(v[j].z, v[j].w); o8[64 * j] = o;
#pragma unroll
            for (int i = 0; i < 4; ++i) { const float xv = v[j][i]; const int k = c0 + i;
                const f32x4 w4 = *(const f32x4*)(wg + (size_t)k * 4); lg[0] += xv * w4.x; lg[1] += xv * w4.y; lg[2] += xv * w4.z; lg[3] += xv * w4.w;
#pragma unroll
                for (int q = 0; q < 8; ++q) { const f32x4 w = *(const f32x4*)(we + (size_t)k * 32 + 4 * q);
                    le[4 * q] += xv * w.x; le[4 * q + 1] += xv * w.y; le[4 * q + 2] += xv * w.z; le[4 * q + 3] += xv * w.w; } } }
#pragma unroll
        for (int i = 0; i < 4; ++i) lg[i] = wave_sum(lg[i]) + bg[i];
#pragma unroll
        for (int i = 0; i < 32; ++i) le[i] = wave_sum(le[i]) + be[i];
        float best = lg[0]; int grp = 0;
#pragma unroll
        for (int i = 1; i < 4; ++i) if (lg[i] > best) { best = lg[i]; grp = i; }
        float den = 0.f;
#pragma unroll
        for (int i = 0; i < 4; ++i) den += expf(lg[i] - best);
        const float pg = 1.0f / den;
        float b1 = -INFINITY, b2 = -INFINITY; int i1 = 0, i2 = 0;
#pragma unroll
        for (int i = 0; i < 32; ++i) if ((i >> 3) == grp && le[i] > b1) { b1 = le[i]; i1 = i; }
#pragma unroll
        for (int i = 0; i < 32; ++i) if ((i >> 3) == grp && i != i1 && le[i] > b2) { b2 = le[i]; i2 = i; }
        const float e21 = expf(b2 - b1); const float w1 = pg / (1.0f + e21), w2 = pg * e21 / (1.0f + e21);
        if (lane == 0) { RE[2 * m] = i1; RE[2 * m + 1] = i2; RW[2 * m] = w1; RW[2 * m + 1] = w2;
            __hip_atomic_fetch_add(cnt + i1, 1u, __ATOMIC_RELAXED, __HIP_MEMORY_SCOPE_AGENT); __hip_atomic_fetch_add(cnt + i2, 1u, __ATOMIC_RELAXED, __HIP_MEMORY_SCOPE_AGENT); }
    }
}
__device__ __forceinline__ void slot_phase(Frame& F, int l) {
    PHASE_BEGIN();
    const unsigned* cnt = (unsigned*)(ws + WS_CTL) + CW_CNT + 64 * l; unsigned* cur = (unsigned*)(ws + WS_CTL) + CW_CUR + 64 * l;
    volatile LAS int* MI = (volatile LAS int*)F.MISC;
    if (tid == 0) { int acc = 0;
        for (int e = 0; e < NEXP; ++e) { const int c = (int)__hip_atomic_load(cnt + e, __ATOMIC_RELAXED, __HIP_MEMORY_SCOPE_AGENT); const int n = (c + 255) >> 8; MI[320 + e] = acc;
            for (int k = 0; k < n; ++k) MI[17 + acc + k] = e; acc += n; }
        MI[16] = acc; }
    __syncthreads();
    const int* RE = (const int*)(ws + WS_RE); int* POS = (int*)(ws + WS_POS); const bf16* XB = (const bf16*)(ws + WS_XB); bf16* XG = (bf16*)(ws + WS_XG);
    for (int m = gw; m < T; m += F.NGW) {
        int s0 = 0, s1 = 0;
        if (lane == 0) { const int e0 = RE[2 * m], e1 = RE[2 * m + 1];
            s0 = MI[320 + e0] * 256 + (int)__hip_atomic_fetch_add(cur + e0, 1u, __ATOMIC_RELAXED, __HIP_MEMORY_SCOPE_AGENT);
            s1 = MI[320 + e1] * 256 + (int)__hip_atomic_fetch_add(cur + e1, 1u, __ATOMIC_RELAXED, __HIP_MEMORY_SCOPE_AGENT);
            POS[2 * m] = s0; POS[2 * m + 1] = s1; }
        s0 = __builtin_amdgcn_readfirstlane(s0); s1 = __builtin_amdgcn_readfirstlane(s1);
        const v4u* src = (const v4u*)(XB + (size_t)m * D) + lane; const v4u a = src[0], c = src[64];
        v4u* d0 = (v4u*)(XG + (size_t)s0 * D) + lane; v4u* d1 = (v4u*)(XG + (size_t)s1 * D) + lane;
        d0[0] = a; d0[64] = c; d1[0] = a; d1[64] = c;
    }
}
__device__ __forceinline__ void lnb_phase(Frame& F, int l) {
    PHASE_BEGIN();
    float* X = (float*)(ws + WS_X); bf16* XB = (bf16*)(ws + WS_XB); const bf16* YB = (const bf16*)(ws + WS_YB);
    const float* lg_ = in_ptr(F, 7) + (size_t)(l * 2 + 1) * D; const float* lb_ = in_ptr(F, 8) + (size_t)(l * 2 + 1) * D;
    const int* POS = (const int*)(ws + WS_POS); const float* RW = (const float*)(ws + WS_RW);
    const bool last = (l == DEPTH - 1);
    for (int m = gw; m < T; m += F.NGW) {
        const int p0 = POS[2 * m], p1 = POS[2 * m + 1]; const float w0 = RW[2 * m], w1 = RW[2 * m + 1];
        f32x4* xr = (f32x4*)(X + (size_t)m * D) + lane; const v2u* y0 = (const v2u*)(YB + (size_t)p0 * D) + lane; const v2u* y1 = (const v2u*)(YB + (size_t)p1 * D) + lane;
        f32x4 v[4]; float s = 0.f;
#pragma unroll
        for (int j = 0; j < 4; ++j) { const f32x4 xv = xr[64 * j]; const v2u a = y0[64 * j], c = y1[64 * j];
            v[j].x = ALPHA * xv.x + w0 * bflo(a.x) + w1 * bflo(c.x); v[j].y = ALPHA * xv.y + w0 * bfhi(a.x) + w1 * bfhi(c.x);
            v[j].z = ALPHA * xv.z + w0 * bflo(a.y) + w1 * bflo(c.y); v[j].w = ALPHA * xv.w + w0 * bfhi(a.y) + w1 * bfhi(c.y);
            s += (v[j].x + v[j].y) + (v[j].z + v[j].w); }
        const float mean = wave_sum(s) * (1.f / D); float s2 = 0.f;
#pragma unroll
        for (int j = 0; j < 4; ++j) { v[j] = v[j] - mean; s2 += (v[j].x * v[j].x + v[j].y * v[j].y) + (v[j].z * v[j].z + v[j].w * v[j].w); }
        const float rstd = 1.f / sqrtf(wave_sum(s2) * (1.f / D) + LN_EPS);
        f32x4* outr = last ? (f32x4*)((float*)in_ptr(F, 16) + (size_t)m * D) + lane : xr; v2u* o8 = (v2u*)(XB + (size_t)m * D) + lane;
#pragma unroll
        for (int j = 0; j < 4; ++j) { const int c0 = 4 * lane + 256 * j; const f32x4 g = *(const f32x4*)(lg_ + c0), bb = *(const f32x4*)(lb_ + c0);
            v[j] = v[j] * rstd * g + bb; outr[64 * j] = v[j];
            v2u o; o.x = pk2(v[j].x, v[j].y); o.y = pk2(v[j].z, v[j].w); o8[64 * j] = o; }
    }
}

struct Args { const float* in[16]; float* out; unsigned char* ws; };
__global__ void __launch_bounds__(NWAVES * 64, 2) mega_fwd(Args args) {
    extern __shared__ __attribute__((aligned(16))) unsigned char lds[];
    Frame F;
    F.lds = (LAS unsigned char*)lds; F.MISC = (volatile LAS unsigned*)(F.lds + MISC_OFF);
    F.tid = threadIdx.x; F.lane = F.tid & 63; F.wave = __builtin_amdgcn_readfirstlane(F.tid >> 6);
    F.G = gridDim.x; F.gw = blockIdx.x * NWAVES + F.wave; F.NGW = F.G * NWAVES;
    F.ws = args.ws;
    for (int u = F.tid; u < (LDS_BYTES - MISC_OFF) / 4; u += NWAVES * 64) F.MISC[u] = 0u;
    __syncthreads();
    if (F.tid < 17) { const unsigned long long p = F.tid < 16 ? (unsigned long long)args.in[F.tid] : (unsigned long long)args.out; F.MISC[512 + 2 * F.tid] = (unsigned)p; F.MISC[513 + 2 * F.tid] = (unsigned)(p >> 32); }
    __syncthreads();
#define GRID_BAR() do { unsigned char* wsb_ = F.ws; asm volatile("" : "+s"(wsb_)); XcdBarrier bar_; bar_.bar = (unsigned*)(wsb_ + WS_CTL) + CW_BAR; bar_.x = xb_xcc_id(); bar_.st = F.MISC; xcd_barrier(bar_); } while (0)
    { XcdBarrier b0 = xcd_barrier_post((unsigned*)(F.ws + WS_CTL) + CW_BAR, F.MISC); (void)b0; }
    PG8_LAS unsigned char* ring = (PG8_LAS unsigned char*)lds;

    prologue(F); convert_weights(F, 0);
    GRID_BAR();
    { constexpr int l = 0;
        constexpr bool even = (l & 1) == 0; constexpr int j = l >> 1;
        { LAUNDER_WS(); const int Nin = even ? NQKV : NH4;
          pg8::Gemm g{(const pg8::bf16_t*)(ws + WS_XB), (const pg8::bf16_t*)(ws + WS_WIN), T, Nin, D}; pg8::StaticOrder S; S.init(T, Nin, F.G, bx);
          pg8::EpiPlain E{(pg8::bf16_t*)(ws + WS_MIX), Nin, 0xffff};
          pg8::gemm_phase<pg8::EpiPlain, pg8::StaticOrder, true, true>(ring, g, S, E); }
        GRID_BAR();
        if constexpr (even) {
            rope_phase(F); GRID_BAR();
            kmean_phase(F); GRID_BAR();
            attn_naive_phase(F); GRID_BAR();
        } else {
            hgrn_naive_phase(F, j); GRID_BAR();
            hgrn_norm_phase(F, j); GRID_BAR();
        }
        { LAUNDER_WS(); pg8::Gemm g{(const pg8::bf16_t*)(ws + WS_O), (const pg8::bf16_t*)(ws + WS_WOUT), T, D, D}; pg8::StaticOrder S; S.init(T, D, F.G, bx);
          pg8::EpiResid E{l == 0 ? in_ptr(F, 0) : (const float*)(ws + WS_X), (float*)(ws + WS_X), ALPHA};
          pg8::gemm_phase<pg8::EpiResid, pg8::StaticOrder, true, true>(ring, g, S, E); }
        GRID_BAR();
        lna_phase(F, l); GRID_BAR();
        slot_phase(F, l); GRID_BAR();
        { LAUNDER_WS(); pg8::Gemm g{(const pg8::bf16_t*)(ws + WS_XG), (const pg8::bf16_t*)(ws + WS_W13), MAX_TILES * 256, 1024, D};
          pg8::MoeOrder S{(const PG8_LAS int*)(F.lds + MISC_OFF + 64), F.G, (F.G % 8 == 0) ? (bx % 8) * (F.G / 8) + bx / 8 : bx};
          pg8::EpiSwiGlu E{(pg8::bf16_t*)(ws + WS_HB), FEXP};
          pg8::gemm_phase<pg8::EpiSwiGlu, pg8::MoeOrder, true, true>(ring, g, S, E); }
        GRID_BAR();
        { LAUNDER_WS(); pg8::Gemm g{(const pg8::bf16_t*)(ws + WS_HB), (const pg8::bf16_t*)(ws + WS_W2), MAX_TILES * 256, 1024, FEXP};
          pg8::MoeOrder S{(const PG8_LAS int*)(F.lds + MISC_OFF + 64), F.G, (F.G % 8 == 0) ? (bx % 8) * (F.G / 8) + bx / 8 : bx};
          pg8::EpiPlain E{(pg8::bf16_t*)(ws + WS_YB), D, 3};
          pg8::gemm_phase<pg8::EpiPlain, pg8::MoeOrder, true, true>(ring, g, S, E); }
        GRID_BAR();
        lnb_phase(F, l);
        if (l + 1 < DEPTH) { convert_weights(F, l + 1); GRID_BAR(); }
    }
    { constexpr int l = 1;
        constexpr bool even = (l & 1) == 0; constexpr int j = l >> 1;
        { LAUNDER_WS(); const int Nin = even ? NQKV : NH4;
          pg8::Gemm g{(const pg8::bf16_t*)(ws + WS_XB), (const pg8::bf16_t*)(ws + WS_WIN), T, Nin, D}; pg8::StaticOrder S; S.init(T, Nin, F.G, bx);
          pg8::EpiPlain E{(pg8::bf16_t*)(ws + WS_MIX), Nin, 0xffff};
          pg8::gemm_phase<pg8::EpiPlain, pg8::StaticOrder, true, true>(ring, g, S, E); }
        GRID_BAR();
        if constexpr (even) {
            rope_phase(F); GRID_BAR();
            kmean_phase(F); GRID_BAR();
            attn_naive_phase(F); GRID_BAR();
        } else {
            hgrn_naive_phase(F, j); GRID_BAR();
            hgrn_norm_phase(F, j); GRID_BAR();
        }
        { LAUNDER_WS(); pg8::Gemm g{(const pg8::bf16_t*)(ws + WS_O), (const pg8::bf16_t*)(ws + WS_WOUT), T, D, D}; pg8::StaticOrder S; S.init(T, D, F.G, bx);
          pg8::EpiResid E{l == 0 ? in_ptr(F, 0) : (const float*)(ws + WS_X), (float*)(ws + WS_X), ALPHA};
          pg8::gemm_phase<pg8::EpiResid, pg8::StaticOrder, true, true>(ring, g, S, E); }
        GRID_BAR();
        lna_phase(F, l); GRID_BAR();
        slot_phase(F, l); GRID_BAR();
        { LAUNDER_WS(); pg8::Gemm g{(const pg8::bf16_t*)(ws + WS_XG), (const pg8::bf16_t*)(ws + WS_W13), MAX_TILES * 256, 1024, D};
          pg8::MoeOrder S{(const PG8_LAS int*)(F.lds + MISC_OFF + 64), F.G, (F.G % 8 == 0) ? (bx % 8) * (F.G / 8) + bx / 8 : bx};
          pg8::EpiSwiGlu E{(pg8::bf16_t*)(ws + WS_HB), FEXP};
          pg8::gemm_phase<pg8::EpiSwiGlu, pg8::MoeOrder, true, true>(ring, g, S, E); }
        GRID_BAR();
        { LAUNDER_WS(); pg8::Gemm g{(const pg8::bf16_t*)(ws + WS_HB), (const pg8::bf16_t*)(ws + WS_W2), MAX_TILES * 256, 1024, FEXP};
          pg8::MoeOrder S{(const PG8_LAS int*)(F.lds + MISC_OFF + 64), F.G, (F.G % 8 == 0) ? (bx % 8) * (F.G / 8) + bx / 8 : bx};
          pg8::EpiPlain E{(pg8::bf16_t*)(ws + WS_YB), D, 3};
          pg8::gemm_phase<pg8::EpiPlain, pg8::MoeOrder, true, true>(ring, g, S, E); }
        GRID_BAR();
        lnb_phase(F, l);
        if (l + 1 < DEPTH) { convert_weights(F, l + 1); GRID_BAR(); }
    }
    { constexpr int l = 2;
        constexpr bool even = (l & 1) == 0; constexpr int j = l >> 1;
        { LAUNDER_WS(); const int Nin = even ? NQKV : NH4;
          pg8::Gemm g{(const pg8::bf16_t*)(ws + WS_XB), (const pg8::bf16_t*)(ws + WS_WIN), T, Nin, D}; pg8::StaticOrder S; S.init(T, Nin, F.G, bx);
          pg8::EpiPlain E{(pg8::bf16_t*)(ws + WS_MIX), Nin, 0xffff};
          pg8::gemm_phase<pg8::EpiPlain, pg8::StaticOrder, true, true>(ring, g, S, E); }
        GRID_BAR();
        if constexpr (even) {
            rope_phase(F); GRID_BAR();
            kmean_phase(F); GRID_BAR();
            attn_naive_phase(F); GRID_BAR();
        } else {
            hgrn_naive_phase(F, j); GRID_BAR();
            hgrn_norm_phase(F, j); GRID_BAR();
        }
        { LAUNDER_WS(); pg8::Gemm g{(const pg8::bf16_t*)(ws + WS_O), (const pg8::bf16_t*)(ws + WS_WOUT), T, D, D}; pg8::StaticOrder S; S.init(T, D, F.G, bx);
          pg8::EpiResid E{l == 0 ? in_ptr(F, 0) : (const float*)(ws + WS_X), (float*)(ws + WS_X), ALPHA};
          pg8::gemm_phase<pg8::EpiResid, pg8::StaticOrder, true, true>(ring, g, S, E); }
        GRID_BAR();
        lna_phase(F, l); GRID_BAR();
        slot_phase(F, l); GRID_BAR();
        { LAUNDER_WS(); pg8::Gemm g{(const pg8::bf16_t*)(ws + WS_XG), (const pg8::bf16_t*)(ws + WS_W13), MAX_TILES * 256, 1024, D};
          pg8::MoeOrder S{(const PG8_LAS int*)(F.lds + MISC_OFF + 64), F.G, (F.G % 8 == 0) ? (bx % 8) * (F.G / 8) + bx / 8 : bx};
          pg8::EpiSwiGlu E{(pg8::bf16_t*)(ws + WS_HB), FEXP};
          pg8::gemm_phase<pg8::EpiSwiGlu, pg8::MoeOrder, true, true>(ring, g, S, E); }
        GRID_BAR();
        { LAUNDER_WS(); pg8::Gemm g{(const pg8::bf16_t*)(ws + WS_HB), (const pg8::bf16_t*)(ws + WS_W2), MAX_TILES * 256, 1024, FEXP};
          pg8::MoeOrder S{(const PG8_LAS int*)(F.lds + MISC_OFF + 64), F.G, (F.G % 8 == 0) ? (bx % 8) * (F.G / 8) + bx / 8 : bx};
          pg8::EpiPlain E{(pg8::bf16_t*)(ws + WS_YB), D, 3};
          pg8::gemm_phase<pg8::EpiPlain, pg8::MoeOrder, true, true>(ring, g, S, E); }
        GRID_BAR();
        lnb_phase(F, l);
        if (l + 1 < DEPTH) { convert_weights(F, l + 1); GRID_BAR(); }
    }
    { constexpr int l = 3;
        constexpr bool even = (l & 1) == 0; constexpr int j = l >> 1;
        { LAUNDER_WS(); const int Nin = even ? NQKV : NH4;
          pg8::Gemm g{(const pg8::bf16_t*)(ws + WS_XB), (const pg8::bf16_t*)(ws + WS_WIN), T, Nin, D}; pg8::StaticOrder S; S.init(T, Nin, F.G, bx);
          pg8::EpiPlain E{(pg8::bf16_t*)(ws + WS_MIX), Nin, 0xffff};
          pg8::gemm_phase<pg8::EpiPlain, pg8::StaticOrder, true, true>(ring, g, S, E); }
        GRID_BAR();
        if constexpr (even) {
            rope_phase(F); GRID_BAR();
            kmean_phase(F); GRID_BAR();
            attn_naive_phase(F); GRID_BAR();
        } else {
            hgrn_naive_phase(F, j); GRID_BAR();
            hgrn_norm_phase(F, j); GRID_BAR();
        }
        { LAUNDER_WS(); pg8::Gemm g{(const pg8::bf16_t*)(ws + WS_O), (const pg8::bf16_t*)(ws + WS_WOUT), T, D, D}; pg8::StaticOrder S; S.init(T, D, F.G, bx);
          pg8::EpiResid E{l == 0 ? in_ptr(F, 0) : (const float*)(ws + WS_X), (float*)(ws + WS_X), ALPHA};
          pg8::gemm_phase<pg8::EpiResid, pg8::StaticOrder, true, true>(ring, g, S, E); }
        GRID_BAR();
        lna_phase(F, l); GRID_BAR();
        slot_phase(F, l); GRID_BAR();
        { LAUNDER_WS(); pg8::Gemm g{(const pg8::bf16_t*)(ws + WS_XG), (const pg8::bf16_t*)(ws + WS_W13), MAX_TILES * 256, 1024, D};
          pg8::MoeOrder S{(const PG8_LAS int*)(F.lds + MISC_OFF + 64), F.G, (F.G % 8 == 0) ? (bx % 8) * (F.G / 8) + bx / 8 : bx};
          pg8::EpiSwiGlu E{(pg8::bf16_t*)(ws + WS_HB), FEXP};
          pg8::gemm_phase<pg8::EpiSwiGlu, pg8::MoeOrder, true, true>(ring, g, S, E); }
        GRID_BAR();
        { LAUNDER_WS(); pg8::Gemm g{(const pg8::bf16_t*)(ws + WS_HB), (const pg8::bf16_t*)(ws + WS_W2), MAX_TILES * 256, 1024, FEXP};
          pg8::MoeOrder S{(const PG8_LAS int*)(F.lds + MISC_OFF + 64), F.G, (F.G % 8 == 0) ? (bx % 8) * (F.G / 8) + bx / 8 : bx};
          pg8::EpiPlain E{(pg8::bf16_t*)(ws + WS_YB), D, 3};
          pg8::gemm_phase<pg8::EpiPlain, pg8::MoeOrder, true, true>(ring, g, S, E); }
        GRID_BAR();
        lnb_phase(F, l);
        if (l + 1 < DEPTH) { convert_weights(F, l + 1); GRID_BAR(); }
    }
}

extern "C" void kernel_launch(void* const* d_in, const int* in_sizes, int n_in, void* d_out, int out_size, void* d_ws, size_t ws_size, hipStream_t stream) {
    static int grid = 0;
    if (grid == 0) {
        if (n_in != 16 || in_sizes[0] != T * D || out_size != T * D || ws_size < WS_END) { fprintf(stderr, "kernel_launch: unexpected shapes (n_in %d, in0 %d, out %d, ws %zu)\n", n_in, n_in > 0 ? in_sizes[0] : -1, out_size, ws_size); grid = -1; return; }
        int dev = 0, cus = 0, per_cu = 0;
        if (hipGetDevice(&dev) != hipSuccess || hipDeviceGetAttribute(&cus, hipDeviceAttributeMultiprocessorCount, dev) != hipSuccess) { grid = -1; return; }
        if (hipFuncSetAttribute((const void*)mega_fwd, hipFuncAttributeMaxDynamicSharedMemorySize, LDS_BYTES) != hipSuccess) { fprintf(stderr, "kernel_launch: hipFuncSetAttribute failed\n"); grid = -1; return; }
        if (hipOccupancyMaxActiveBlocksPerMultiprocessor(&per_cu, (const void*)mega_fwd, NWAVES * 64, LDS_BYTES) != hipSuccess || per_cu < 1) fprintf(stderr, "kernel_launch: occupancy query reports %d\n", per_cu);
        (void)hipGetLastError();
        grid = cus;
    }
    if (grid < 0) return;
    if (hipMemsetAsync((char*)d_ws + WS_CTL, 0, CTL_ZERO_BYTES, stream) != hipSuccess) return;
    Args a{};
    for (int i = 0; i < 16; ++i) a.in[i] = (const float*)d_in[i];
    a.out = (float*)d_out; a.ws = (unsigned char*)d_ws;
    hipLaunchKernelGGL(mega_fwd, dim3(grid), dim3(NWAVES * 64), LDS_BYTES, stream, a);
}
```

```cpp
#include <hip/hip_runtime.h>
#include <cstdio>
#include <cstdint>
#include <cmath>
namespace pg8 {
#define PG8_LAS __attribute__((address_space(3)))
typedef unsigned short bf16_t;
typedef short bf16x8 __attribute__((ext_vector_type(8)));
typedef float f32x4 __attribute__((ext_vector_type(4)));
typedef unsigned u32x4 __attribute__((ext_vector_type(4)));
constexpr int BM = 256, BK = 64, HALF = 128, HTB = HALF * BK * 2  , STAGE_BYTES = 8 * HTB, NXCD = 8, WGM = 8;

__host__ __device__ __forceinline__ int lds_byte(int r, int c) { const int st = (r >> 4) * 2 + (c >> 5), rr = r & 15, cc = c & 31, ob = rr * 64 + cc * 2; return st * 1024 + (ob ^ (((ob >> 9) & 1) << 5)); }
__host__ __device__ __forceinline__ void stage_rc(int b, int& R, int& C) { const int st = b / 1024, sb = b % 1024, swz = sb ^ (((sb >> 9) & 1) << 5); R = (st >> 1) * 16 + swz / 64; C = (st & 1) * 32 + (swz % 64) / 2; }
__host__ __device__ __forceinline__ int perm32(int rho) { const int n = rho >> 4, i = rho & 15; return 8 * (i >> 2) + 4 * n + (i & 3); }

struct Unit { int pm, pn; };
struct Gemm { const bf16_t* A; const bf16_t* Bt; int M, N, K; };

struct StaticOrder {
    int nM, nN, nwg, G, c;
    __host__ __device__ void init(int M, int N, int G_, int c_) { nM = M / BM; nN = N / BM; nwg = nM * nN; G = G_; c = c_; }
    __host__ __device__ bool next(int i, Unit& u) const {
        const long L = (long)i * G + c; if (L >= nwg) return false;
        int wgid = (int)L; { const int q = nwg / NXCD, r = nwg % NXCD, xcd = wgid % NXCD, off = wgid / NXCD; wgid = (xcd < r ? xcd * (q + 1) : r * (q + 1) + (xcd - r) * q) + off; }
        const int nig = WGM * nN, gid = wgid / nig, fm = gid * WGM, gsz = (nM - fm) < WGM ? (nM - fm) : WGM;
        u.pm = fm + ((wgid % nig) % gsz); u.pn = (wgid % nig) / gsz; return true;
    }
    __device__ __forceinline__ void a_ready(const Unit&) const {}
    __device__ __forceinline__ void done(const Unit&) const {}
};

__device__ __forceinline__ unsigned cvt_pk_bf16(float lo, float hi) { unsigned r; asm volatile("v_cvt_pk_bf16_f32 %0, %1, %2" : "=v"(r) : "v"(lo), "v"(hi)); return r; }
typedef float f32x2 __attribute__((ext_vector_type(2)));

__device__ __forceinline__ float silu_f(float a) { return a / (1.0f + __expf(-a)); }
struct EpiPlain {
    static constexpr bool PERM = true, AFTER_DRAIN = false;
    bf16_t* O; int ldc; int pn_mask;
    __device__ __forceinline__ void operator()(const f32x4 (&acc)[2][2][4][2], const Unit& u, int wr, int wc, int fr, int fq) const {
        const int row0 = u.pm * BM + wr * 64 + fr; const int col0 = (u.pn & pn_mask) * BM + wc * 32 + 8 * fq;
#pragma unroll
        for (int ai = 0; ai < 2; ++ai)
#pragma unroll
            for (int m = 0; m < 4; ++m) { bf16_t* rowp = O + (size_t)(row0 + ai * HALF + m * 16) * ldc + col0;
#pragma unroll
                for (int bj = 0; bj < 2; ++bj) { const f32x4 v0 = acc[ai][bj][m][0], v1 = acc[ai][bj][m][1];
                    u32x4 w; w.x = cvt_pk_bf16(v0[0], v0[1]); w.y = cvt_pk_bf16(v0[2], v0[3]); w.z = cvt_pk_bf16(v1[0], v1[1]); w.w = cvt_pk_bf16(v1[2], v1[3]);
                    *(u32x4*)(rowp + bj * HALF) = w; } }
    }
};
struct EpiSwiGlu {
    static constexpr bool PERM = true, AFTER_DRAIN = false;
    bf16_t* O; int ldc;
    __device__ __forceinline__ void operator()(const f32x4 (&acc)[2][2][4][2], const Unit& u, int wr, int wc, int fr, int fq) const {
        const int row0 = u.pm * BM + wr * 64 + fr; const int col0 = (u.pn & 3) * HALF + wc * 32 + 8 * fq;
#pragma unroll
        for (int ai = 0; ai < 2; ++ai)
#pragma unroll
            for (int m = 0; m < 4; ++m) { bf16_t* rowp = O + (size_t)(row0 + ai * HALF + m * 16) * ldc + col0;
                const f32x4 a0 = acc[ai][0][m][0], a1 = acc[ai][0][m][1], b0 = acc[ai][1][m][0], b1 = acc[ai][1][m][1];
                u32x4 w; w.x = cvt_pk_bf16(silu_f(a0[0]) * b0[0], silu_f(a0[1]) * b0[1]); w.y = cvt_pk_bf16(silu_f(a0[2]) * b0[2], silu_f(a0[3]) * b0[3]);
                w.z = cvt_pk_bf16(silu_f(a1[0]) * b1[0], silu_f(a1[1]) * b1[1]); w.w = cvt_pk_bf16(silu_f(a1[2]) * b1[2], silu_f(a1[3]) * b1[3]);
                *(u32x4*)rowp = w; }
    }
};
struct EpiResid {
    static constexpr bool PERM = false, AFTER_DRAIN = false;
    const float* base; float* out; float alpha;
    __device__ __forceinline__ void operator()(const f32x4 (&acc)[2][2][4][2], const Unit& u, int wr, int wc, int fr, int fq) const {
        const int row0 = u.pm * BM + wr * 64 + fr; const int col0 = u.pn * BM + wc * 32 + 4 * fq;
#pragma unroll
        for (int ai = 0; ai < 2; ++ai)
#pragma unroll
            for (int m = 0; m < 4; ++m) { const size_t off = (size_t)(row0 + ai * HALF + m * 16) * 1024 + col0;
#pragma unroll
                for (int bj = 0; bj < 2; ++bj)
#pragma unroll
                    for (int n = 0; n < 2; ++n) { const f32x4 bs = *(const f32x4*)(base + off + bj * HALF + n * 16);
                        *(f32x4*)(out + off + bj * HALF + n * 16) = bs * alpha + acc[ai][bj][m][n]; } }
    }
};
struct MoeOrder {
    const PG8_LAS int* tab; int G, vc;
    __device__ __forceinline__ bool next(int i, Unit& u) const {
        const long L = (long)i * G + vc; const int nt = __builtin_amdgcn_readfirstlane(tab[0]); if (L >= (long)nt * 4) return false;
        const int pm = (int)(L >> 2); u.pm = pm; u.pn = __builtin_amdgcn_readfirstlane(tab[1 + pm]) * 4 + (int)(L & 3); return true;
    }
    __device__ __forceinline__ void a_ready(const Unit&) const {}
    __device__ __forceinline__ void done(const Unit&) const {}
};
template <class Epi, class Sched, bool ALIGN_EPI = false, bool SP2 = false>
__device__ __forceinline__ void gemm_phase(PG8_LAS unsigned char* lds, const Gemm g, const Sched& S, const Epi& E) {
    int tid_ = threadIdx.x; asm volatile("" : "+v"(tid_));
    const int tid = tid_, wid = __builtin_amdgcn_readfirstlane(tid >> 6), lane = tid & 63, wr = wid >> 2, wc = wid & 3, fr = lane & 15, fq = lane >> 4;
    const int K = g.K, nt = K / BK;
    unsigned voffA[2], voffB[2];
#pragma unroll
    for (int i = 0; i < 2; ++i) { int R, C; stage_rc(tid * 16 + i * 8192, R, C); const int Rb = Epi::PERM ? ((R & ~31) + perm32(R & 31)) : R;
        voffA[i] = (unsigned)(R * K + C) * 2u; voffB[i] = (unsigned)(Rb * K + C) * 2u; }
    const size_t kstep = (size_t)(BK * 2);
    const size_t hstep = (size_t)HALF * K * 2;
    const size_t tstep = 2 * hstep;
    const unsigned ldsw = (unsigned)wid * 1024u;
    const int aoff = lds_byte(wr * 64 + fr, fq * 8), boff = lds_byte(wc * 32 + fr, fq * 8);
#define PG8_SA(b, h) (((b) * 2 + (h)) * HTB)
#define PG8_SB(b, h) ((4 + (b) * 2 + (h)) * HTB)
#define PG8_STAGE(bufoff, gbase, voff) do { _Pragma("unroll") for (int _i = 0; _i < 2; ++_i) \
        __builtin_amdgcn_global_load_lds((const unsigned*)((const char*)(gbase) + (voff)[_i]), (PG8_LAS unsigned*)(lds + (bufoff) + ldsw + _i * 8192), 16, 0, 0); } while (0)
#define PG8_LDA(dst, b, h) do { _Pragma("unroll") for (int m = 0; m < 4; ++m) _Pragma("unroll") for (int k = 0; k < 2; ++k) dst[m][k] = *(const PG8_LAS bf16x8*)(lds + PG8_SA(b, h) + aoff + m * 2048 + k * 1024); } while (0)
#define PG8_LDB(dst, b, h) do { _Pragma("unroll") for (int n = 0; n < 2; ++n) _Pragma("unroll") for (int k = 0; k < 2; ++k) dst[n][k] = *(const PG8_LAS bf16x8*)(lds + PG8_SB(b, h) + boff + n * 2048 + k * 1024); } while (0)
#define PG8_MMA(ai, bj, At, Bt) do { __builtin_amdgcn_s_setprio(1); _Pragma("unroll") for (int m = 0; m < 4; ++m) _Pragma("unroll") for (int n = 0; n < 2; ++n) _Pragma("unroll") for (int k = 0; k < 2; ++k) \
        acc[ai][bj][m][n] = __builtin_amdgcn_mfma_f32_16x16x32_bf16(Bt[n][k], At[m][k], acc[ai][bj][m][n], 0, 0, 0); __builtin_amdgcn_s_setprio(0); } while (0)
#define PG8_WAIT_V(n) asm volatile("s_waitcnt vmcnt(" #n ")" ::: "memory")
#define PG8_WAIT_L(n) asm volatile("s_waitcnt lgkmcnt(" #n ")" ::: "memory")
#define PG8_BAR __builtin_amdgcn_s_barrier()
#define PG8_SCHED __builtin_amdgcn_sched_barrier(0)
    Unit cur, nxt; int ui = 0;
    if (!S.next(0, cur)) return;
    f32x4 acc[2][2][4][2];
#pragma unroll
    for (int a = 0; a < 2; ++a)
#pragma unroll
        for (int b = 0; b < 2; ++b)
#pragma unroll
            for (int m = 0; m < 4; ++m)
#pragma unroll
                for (int n = 0; n < 2; ++n) acc[a][b][m][n] = (f32x4){0.f, 0.f, 0.f, 0.f};
    bf16x8 At[4][2], B0[2][2], B1[2][2];
    const char* cA = (const char*)g.A + (size_t)cur.pm * tstep; const char* cB = (const char*)g.Bt + (size_t)cur.pn * tstep;
    S.a_ready(cur);
    if constexpr (SP2) {
        PG8_STAGE(PG8_SB(0, 0), cB, voffB); PG8_STAGE(PG8_SB(0, 1), cB + hstep, voffB); PG8_STAGE(PG8_SA(0, 0), cA, voffA); PG8_STAGE(PG8_SA(0, 1), cA + hstep, voffA);
        if (wr == 1) PG8_BAR;
        PG8_WAIT_V(2); PG8_BAR;
        PG8_STAGE(PG8_SB(1, 0), cB + kstep, voffB); PG8_STAGE(PG8_SA(1, 0), cA + kstep, voffA); PG8_STAGE(PG8_SB(1, 1), cB + hstep + kstep, voffB);
        PG8_WAIT_V(6); PG8_BAR;
    } else {
        PG8_STAGE(PG8_SB(0, 0), cB, voffB); PG8_STAGE(PG8_SA(0, 0), cA, voffA); PG8_STAGE(PG8_SB(0, 1), cB + hstep, voffB); PG8_STAGE(PG8_SA(0, 1), cA + hstep, voffA);
        if (wr == 1) PG8_BAR;
        PG8_WAIT_V(4); PG8_BAR;
        PG8_STAGE(PG8_SB(1, 0), cB + kstep, voffB); PG8_STAGE(PG8_SA(1, 0), cA + kstep, voffA); PG8_STAGE(PG8_SB(1, 1), cB + hstep + kstep, voffB);
        PG8_WAIT_V(6); PG8_BAR;
    }
    for (;;) {
        const bool has_next = S.next(ui + 1, nxt);
        const char* nA = has_next ? (const char*)g.A + (size_t)nxt.pm * tstep : cA; const char* nB = has_next ? (const char*)g.Bt + (size_t)nxt.pn * tstep : cB;
        for (int t = 0; t < nt; t += 2) {
            const bool last = (t == nt - 2);
            const char* a1 = cA + (size_t)(t + 1) * kstep;
            const char* a2 = last ? nA : cA + (size_t)(t + 2) * kstep; const char* b2 = last ? nB : cB + (size_t)(t + 2) * kstep;
            const char* a3 = a2 + kstep; const char* b3 = b2 + kstep;
            if (last && has_next) S.a_ready(nxt);
            if constexpr (SP2) {
            PG8_LDB(B0, 0, 0); PG8_LDB(B1, 0, 1); PG8_SCHED; PG8_LDA(At, 0, 0); PG8_STAGE(PG8_SA(1, 1), a1 + hstep, voffA);
            PG8_WAIT_V(8); PG8_WAIT_L(0); PG8_BAR; PG8_MMA(0, 0, At, B0); PG8_MMA(0, 1, At, B1); PG8_BAR; PG8_SCHED;
            PG8_LDA(At, 0, 1); PG8_STAGE(PG8_SB(0, 0), b2, voffB); PG8_STAGE(PG8_SB(0, 1), b2 + hstep, voffB); PG8_STAGE(PG8_SA(0, 0), a2, voffA);
            PG8_WAIT_V(8); PG8_WAIT_L(0); PG8_BAR; PG8_MMA(1, 0, At, B0); PG8_MMA(1, 1, At, B1); PG8_BAR; PG8_SCHED;
            PG8_LDB(B0, 1, 0); PG8_LDB(B1, 1, 1); PG8_SCHED; PG8_LDA(At, 1, 0); PG8_STAGE(PG8_SA(0, 1), a2 + hstep, voffA);
            PG8_WAIT_V(8); PG8_WAIT_L(0); PG8_BAR; PG8_MMA(0, 0, At, B0); PG8_MMA(0, 1, At, B1); PG8_BAR; PG8_SCHED;
            PG8_LDA(At, 1, 1); PG8_STAGE(PG8_SB(1, 0), b3, voffB); PG8_STAGE(PG8_SB(1, 1), b3 + hstep, voffB); PG8_STAGE(PG8_SA(1, 0), a3, voffA);
            PG8_WAIT_V(8); PG8_WAIT_L(0); PG8_BAR; PG8_MMA(1, 0, At, B0); PG8_MMA(1, 1, At, B1); PG8_BAR; PG8_SCHED;
            } else {
            PG8_LDB(B0, 0, 0); PG8_SCHED; PG8_LDA(At, 0, 0); PG8_STAGE(PG8_SA(1, 1), a1 + hstep, voffA);
            PG8_WAIT_L(8); PG8_BAR; PG8_WAIT_L(0); PG8_MMA(0, 0, At, B0); PG8_BAR; PG8_SCHED;
            PG8_LDB(B1, 0, 1); PG8_STAGE(PG8_SB(0, 0), b2, voffB);
            PG8_BAR; PG8_WAIT_L(0); PG8_MMA(0, 1, At, B1); PG8_BAR;
            PG8_LDA(At, 0, 1); PG8_STAGE(PG8_SA(0, 0), a2, voffA);
            PG8_BAR; PG8_WAIT_L(0); PG8_MMA(1, 0, At, B0); PG8_BAR; PG8_SCHED;
            PG8_STAGE(PG8_SB(0, 1), b2 + hstep, voffB);
            PG8_WAIT_V(6); PG8_BAR; PG8_MMA(1, 1, At, B1); PG8_BAR;
            PG8_LDB(B0, 1, 0); PG8_SCHED; PG8_LDA(At, 1, 0); PG8_STAGE(PG8_SA(0, 1), a2 + hstep, voffA);
            PG8_WAIT_L(8); PG8_BAR; PG8_WAIT_L(0); PG8_MMA(0, 0, At, B0); PG8_BAR; PG8_SCHED;
            PG8_LDB(B1, 1, 1); PG8_STAGE(PG8_SB(1, 0), b3, voffB);
            PG8_BAR; PG8_WAIT_L(0); PG8_MMA(0, 1, At, B1); PG8_BAR;
            PG8_LDA(At, 1, 1); PG8_STAGE(PG8_SA(1, 0), a3, voffA);
            PG8_BAR; PG8_WAIT_L(0); PG8_MMA(1, 0, At, B0); PG8_BAR; PG8_SCHED;
            PG8_STAGE(PG8_SB(1, 1), b3 + hstep, voffB);
            PG8_WAIT_V(6); PG8_BAR; PG8_MMA(1, 1, At, B1); PG8_BAR;
            }
        }
        if constexpr (ALIGN_EPI) { if (wr == 0) PG8_BAR; }
        if constexpr (!Epi::AFTER_DRAIN) { E(acc, cur, wr, wc, fr, fq); S.done(cur); }
        if (!has_next) break;
#pragma unroll
        for (int a = 0; a < 2; ++a)
#pragma unroll
            for (int b = 0; b < 2; ++b)
#pragma unroll
                for (int m = 0; m < 4; ++m)
#pragma unroll
                    for (int n = 0; n < 2; ++n) acc[a][b][m][n] = (f32x4){0.f, 0.f, 0.f, 0.f};
        cur = nxt; cA = nA; cB = nB; ++ui;
        if constexpr (ALIGN_EPI) { if (wr == 1) PG8_BAR; }
    }
    PG8_WAIT_V(0);
    if constexpr (!ALIGN_EPI) { if (wr == 0) PG8_BAR; }
    PG8_BAR;
    if constexpr (Epi::AFTER_DRAIN) { E.fused(acc, cur, wr, wc, fr, fq, lds, wid, lane); S.done(cur); }
#undef PG8_SA
#undef PG8_SB
#undef PG8_STAGE
#undef PG8_LDA
#undef PG8_LDB
#undef PG8_MMA
#undef PG8_WAIT_V
#undef PG8_WAIT_L
#undef PG8_BAR
#undef PG8_SCHED
}
}

#define LAS __attribute__((address_space(3)))
#define XB_TMO      128
#define XB_XCNT(j)  (256  + 64 * (j))
#define XB_XSUB(j)  (1280 + 64 * (j))
#define XB_XGEN(j)  (2304 + 64 * (j))
#define XB_TOP      3328
#define XB_TOPGEN   3392
#define XCD_BAR_WORDS 3456
#define XB_SPIN_CAP (1u << 22)

__device__ __forceinline__ unsigned xb_ld(unsigned* p)              { return __hip_atomic_load(p, __ATOMIC_RELAXED, __HIP_MEMORY_SCOPE_AGENT); }
__device__ __forceinline__ unsigned xb_add(unsigned* p, unsigned v) { return __hip_atomic_fetch_add(p, v, __ATOMIC_RELAXED, __HIP_MEMORY_SCOPE_AGENT); }
__device__ __forceinline__ unsigned xb_xcc_id() { return (unsigned)__builtin_amdgcn_s_getreg((3 << 11) | 20) & 0xFu; }
#define XB_SPIN(cond, bar) do { unsigned _sp = 0; while (cond) { __builtin_amdgcn_s_sleep(1); \
    if ((++_sp & 255u) == 0u) { if (xb_ld(&(bar)[XB_TMO])) break; if (_sp > XB_SPIN_CAP) { atomicAdd(&(bar)[XB_TMO], 1u); break; } } } } while (0)

struct XcdBarrier {
    unsigned* bar; unsigned x;
    volatile LAS unsigned* st;
};

__device__ __forceinline__ XcdBarrier xcd_barrier_post(unsigned* bar, volatile LAS unsigned* st) {
    XcdBarrier b; b.bar = bar; b.x = xb_xcc_id(); b.st = st;
    if (threadIdx.x == 0) (void)xb_add(&bar[XB_XCNT(b.x)], 1u);
    return b;
}
__device__ __forceinline__ void xcd_barrier_complete(unsigned* bar, unsigned x, unsigned& nloc, unsigned& nx) {
    const unsigned G = gridDim.x * gridDim.y * gridDim.z;
    unsigned sum, cnt, mine, sp = 0u;
    for (;;) {
        sum = 0u; cnt = 0u; mine = 0u;
#pragma unroll
        for (unsigned j = 0; j < 16; ++j) { const unsigned c = xb_ld(&bar[XB_XCNT(j)]); sum += c; cnt += (c > 0u) ? 1u : 0u; mine = (j == x) ? c : mine; }
        if (sum == G) break;
        __builtin_amdgcn_s_sleep(1);
        if ((++sp & 255u) == 0u) { if (xb_ld(&bar[XB_TMO])) break; if (sp > XB_SPIN_CAP) { atomicAdd(&bar[XB_TMO], 1u); break; } }
    }
    nloc = mine > 0u ? mine : 1u; nx = cnt > 0u ? cnt : 1u;
}

__device__ __forceinline__ void xcd_barrier(const XcdBarrier& b) {
    asm volatile("s_waitcnt vmcnt(0)" ::: "memory");
    __syncthreads();
    if (threadIdx.x == 0) {
        unsigned* bar = b.bar;
        __builtin_amdgcn_s_waitcnt(0);
        unsigned nloc = b.st[0], nx = b.st[1];
        if (nloc == 0u) { xcd_barrier_complete(bar, b.x, nloc, nx); b.st[0] = nloc; b.st[1] = nx; }
        const unsigned old = xb_add(&bar[XB_XSUB(b.x)], 1u);
        const unsigned gen = old / nloc;
        if (old + 1u == (gen + 1u) * nloc) {
            __builtin_amdgcn_fence(__ATOMIC_RELEASE, "agent");
            asm volatile("s_waitcnt vmcnt(0)" ::: "memory");
            const unsigned og = xb_add(&bar[XB_TOP], 1u);
            const unsigned tg = og / nx;
            if (og + 1u == (tg + 1u) * nx) xb_add(&bar[XB_TOPGEN], 1u);
            else XB_SPIN(xb_ld(&bar[XB_TOPGEN]) == tg, bar);
            __builtin_amdgcn_fence(__ATOMIC_ACQUIRE, "agent");
            xb_add(&bar[XB_XGEN(b.x)], 1u);
            asm volatile("s_waitcnt vmcnt(0)" ::: "memory");
        } else {
            XB_SPIN(xb_ld(&bar[XB_XGEN(b.x)]) == gen, bar);
            __builtin_amdgcn_fence(__ATOMIC_ACQUIRE, "agent");
            asm volatile("s_waitcnt vmcnt(0)" ::: "memory");
        }
    }
    __syncthreads();
}

constexpr int NWAVES = 8;
constexpr int BATCH = 8, SEQ = 4096, D = 1024, T = BATCH * SEQ, DEPTH = 4;
constexpr int NQKV = 3072, NH4 = 4096, NEXP = 32, FEXP = 512;
constexpr int MAX_TILES = 288;
constexpr float ALPHA = 1.6817928305074292f;
constexpr float LN_EPS = 1e-5f, RMS_EPS = 1e-6f;
constexpr size_t MiB = 1u << 20;
constexpr size_t WS_CTL = 0, CTL_ZERO_BYTES = 1 * MiB;
constexpr size_t WS_ROPE = 1 * MiB;
constexpr size_t WS_LB = 1 * MiB + 256 * 1024;
constexpr size_t WS_KMEAN = 1 * MiB + 512 * 1024;
constexpr size_t WS_RE = 2 * MiB;
constexpr size_t WS_RW = 2 * MiB + 256 * 1024;
constexpr size_t WS_POS = 2 * MiB + 512 * 1024;
constexpr size_t WS_X = 8 * MiB;
constexpr size_t WS_XB = 136 * MiB;
constexpr size_t WS_WIN = 200 * MiB, WS_WOUT = 208 * MiB, WS_W13 = 210 * MiB, WS_W2 = 274 * MiB;
constexpr size_t WS_MIX = 306 * MiB;
constexpr size_t WS_O = 562 * MiB;
constexpr size_t WS_O32 = 626 * MiB;
constexpr size_t WS_XG = 306 * MiB, WS_HB = 450 * MiB, WS_YB = 522 * MiB;
constexpr size_t WS_END = 754 * MiB;
constexpr int CW_BAR = 4096;
constexpr int CW_CNT = 16384;
constexpr int CW_CUR = 16384 + 512;
constexpr int RING_BYTES = 131072, MISC_OFF = RING_BYTES, LDS_BYTES = RING_BYTES + 4096;

#define GAS __attribute__((address_space(1)))
typedef unsigned short bf16;
typedef unsigned v4u __attribute__((ext_vector_type(4)));
typedef unsigned v2u __attribute__((ext_vector_type(2)));
typedef float f32x4 __attribute__((ext_vector_type(4)));
#define LDS_WAIT() asm volatile("s_waitcnt lgkmcnt(0)" ::: "memory")
__device__ __forceinline__ unsigned f2bf(float f) { unsigned u = __builtin_bit_cast(unsigned, f); return (u + 0x7fffu + ((u >> 16) & 1u)) >> 16; }
__device__ __forceinline__ unsigned pk2(float lo, float hi) { return f2bf(lo) | (f2bf(hi) << 16); }
__device__ __forceinline__ float bf2f(unsigned short b) { return __builtin_bit_cast(float, (unsigned)b << 16); }
__device__ __forceinline__ float bflo(unsigned w) { return __builtin_bit_cast(float, w << 16); }
__device__ __forceinline__ float bfhi(unsigned w) { return __builtin_bit_cast(float, w & 0xffff0000u); }
__device__ __forceinline__ float wave_sum(float v) {
#pragma unroll
    for (int o = 1; o < 64; o <<= 1) v += __shfl_xor(v, o);
    return v;
}

struct Frame {
    LAS unsigned char* lds;
    volatile LAS unsigned* MISC;
    unsigned char* ws;
    int tid, lane, wave, gw, NGW, G;
};
__device__ __forceinline__ const float* in_ptr(const Frame& F, int i) {
    const unsigned lo = __builtin_amdgcn_readfirstlane(F.MISC[512 + 2 * i]), hi = __builtin_amdgcn_readfirstlane(F.MISC[513 + 2 * i]);
    return (const float*)(((unsigned long long)hi << 32) | lo);
}
#define LAUNDER_WS() unsigned char* ws = F.ws; int bx = blockIdx.x; asm volatile("" : "+s"(ws), "+s"(bx))
#define PHASE_BEGIN() unsigned char* ws = F.ws; int tid = threadIdx.x, bx = blockIdx.x; asm volatile("" : "+s"(ws), "+v"(tid), "+s"(bx)); const int lane = tid & 63, gw = bx * NWAVES + __builtin_amdgcn_readfirstlane(tid >> 6); (void)tid; (void)gw; (void)lane; (void)bx
__device__ __forceinline__ void transpose_item(const float* W, int K, int N, bf16* WT, int k0, int n0, size_t dst_row0, LAS float* scr, int lane) {
#pragma unroll 8
    for (int i = 0; i < 32; ++i) { const int kk = 2 * i + (lane >> 5); scr[kk * 33 + (lane & 31)] = W[(size_t)(k0 + kk) * N + n0 + (lane & 31)]; }
    LDS_WAIT(); asm volatile("" ::: "memory");
    const int c = lane & 7;
#pragma unroll
    for (int j = 0; j < 4; ++j) { const int n = (lane >> 3) + 8 * j; const LAS float* s = scr + (8 * c) * 33 + n;
        v4u o; o.x = pk2(s[0 * 33], s[1 * 33]); o.y = pk2(s[2 * 33], s[3 * 33]); o.z = pk2(s[4 * 33], s[5 * 33]); o.w = pk2(s[6 * 33], s[7 * 33]);
        *(v4u*)(WT + (dst_row0 + n) * (size_t)K + k0 + 8 * c) = o; }
    LDS_WAIT(); asm volatile("" ::: "memory");
}
__device__ __forceinline__ void convert_weights(Frame& F, int l) {
    PHASE_BEGIN();
    LAS float* scr = (LAS float*)(F.lds + F.wave * 16384);
    const int j = l >> 1; const bool even = (l & 1) == 0;
    const int Nin = even ? NQKV : NH4;
    const float* Win = even ? in_ptr(F, 1) + (size_t)j * D * NQKV : in_ptr(F, 3) + (size_t)j * D * NH4;
    const float* Wout = even ? in_ptr(F, 2) + (size_t)j * D * D : in_ptr(F, 4) + (size_t)j * D * D;
    const int I_in = 16 * (Nin / 32), I_out = 16 * 32, I_13 = 64 * 256, I_2 = 32 * 256;
    const int NIT = I_in + I_out + I_13 + I_2;
    for (int it = gw; it < NIT; it += F.NGW) {
        int r = it;
        if (r < I_in) { const int nb = Nin / 32, kb = r / nb, n0 = (r % nb) * 32; transpose_item(Win, D, Nin, (bf16*)(ws + WS_WIN), kb * 64, n0, (size_t)n0, scr, lane); continue; } r -= I_in;
        if (r < I_out) { const int kb = r / 32, n0 = (r % 32) * 32; transpose_item(Wout, D, D, (bf16*)(ws + WS_WOUT), kb * 64, n0, (size_t)n0, scr, lane); continue; } r -= I_out;
        if (r < I_13) { const int mat = r >> 8, e = mat >> 1, which = mat & 1, q = r & 255, kb = q >> 4, n0 = (q & 15) * 32;
            const float* W = in_ptr(F, which ? 14 : 13) + (size_t)(l * NEXP + e) * D * FEXP;
            transpose_item(W, D, FEXP, (bf16*)(ws + WS_W13), kb * 64, n0, (size_t)e * 1024 + (size_t)(n0 >> 7) * 256 + (n0 & 127) + which * 128, scr, lane); continue; } r -= I_13;
        { const int e = r >> 8, q = r & 255, kb = q >> 5, n0 = (q & 31) * 32;
            const float* W = in_ptr(F, 15) + (size_t)(l * NEXP + e) * FEXP * D;
            transpose_item(W, FEXP, D, (bf16*)(ws + WS_W2), kb * 64, n0, (size_t)e * 1024 + n0, scr, lane); }
    }
}

__device__ __forceinline__ void prologue(Frame& F) {
    PHASE_BEGIN();
    const float* x = in_ptr(F, 0); bf16* xb = (bf16*)(ws + WS_XB);
    for (int m = gw; m < T; m += F.NGW) {
        const f32x4* xr = (const f32x4*)(x + (size_t)m * D) + lane; v2u* o8 = (v2u*)(xb + (size_t)m * D) + lane;
#pragma unroll
        for (int j = 0; j < 4; ++j) { const f32x4 v = xr[64 * j]; v2u o; o.x = pk2(v.x, v.y); o.y = pk2(v.z, v.w); o8[64 * j] = o; }
    }
    float* rope = (float*)(ws + WS_ROPE);
    const int gt = gw * 64 + lane, NGT = F.NGW * 64;
    for (int idx = gt; idx < SEQ * 8; idx += NGT) { const int pos = idx >> 3, i = idx & 7;
        const float inv = powf(500000.0f, -(float)i / 8.0f); const float ang = (float)pos * inv;
        rope[pos * 16 + i] = cosf(ang); rope[pos * 16 + 8 + i] = sinf(ang); }
    float* lb = (float*)(ws + WS_LB);
    for (int idx = gt; idx < D; idx += NGT) { const float l0 = in_ptr(F, 6)[idx], l1 = in_ptr(F, 6)[D + idx];
        lb[idx] = 0.f; lb[D + idx] = 1.0f / (1.0f + expf(l0 - l1)); }
}

__device__ __forceinline__ void rope_phase(Frame& F) {
    PHASE_BEGIN();
    bf16* qkv = (bf16*)(ws + WS_MIX); const float* rope = (const float*)(ws + WS_ROPE);
    const int gt = gw * 64 + lane, NGT = F.NGW * 64;
    for (int idx = gt; idx < T * 256; idx += NGT) { const int row = idx >> 8, rh = (idx >> 3) & 31, i = idx & 7, pos = row & (SEQ - 1);
        const int col = (rh < 16 ? rh * 64 : 1536 + (rh - 16) * 64) + i;
        bf16* p = qkv + (size_t)row * NQKV + col;
        const float x1 = bf2f(p[0]), x2 = bf2f(p[8]), c = rope[pos * 16 + i], s = rope[pos * 16 + 8 + i];
        p[0] = (bf16)f2bf(x1 * c - x2 * s); p[8] = (bf16)f2bf(x2 * c + x1 * s); }
}
__device__ __forceinline__ void kmean_phase(Frame& F) {
    PHASE_BEGIN();
    const bf16* qkv = (const bf16*)(ws + WS_MIX); float* km = (float*)(ws + WS_KMEAN);
    const int gt = gw * 64 + lane, NGT = F.NGW * 64;
    for (int idx = gt; idx < BATCH * 8 * 16 * 64; idx += NGT) { const int d = idx & 63, blk = (idx >> 6) & 15, h = (idx >> 10) & 7, b = idx >> 13;
        const bf16* p = qkv + (size_t)(b * SEQ + blk * 256) * NQKV + 512 + h * 64 + d; float s = 0.f;
        for (int j = 0; j < 256; ++j) s += bf2f(p[(size_t)j * NQKV]);
        km[idx] = s * (1.0f / 256.0f); }
}

__device__ __forceinline__ void load64(const bf16* p, float (&v)[64]) {
    const v4u* q = (const v4u*)p;
#pragma unroll
    for (int i = 0; i < 8; ++i) { const v4u w = q[i];
        v[8 * i + 0] = bflo(w.x); v[8 * i + 1] = bfhi(w.x); v[8 * i + 2] = bflo(w.y); v[8 * i + 3] = bfhi(w.y);
        v[8 * i + 4] = bflo(w.z); v[8 * i + 5] = bfhi(w.z); v[8 * i + 6] = bflo(w.w); v[8 * i + 7] = bfhi(w.w); }
}
__device__ __forceinline__ void attend_key(const bf16* kp, const bf16* vp, const float (&q)[64], float (&acc)[64], float& m, float& l) {
    float kv[64]; load64(kp, kv); float s = 0.f;
#pragma unroll
    for (int d = 0; d < 64; ++d) s += q[d] * kv[d];
    s *= 0.125f;
    const float mn = fmaxf(m, s), c = __expf(m - mn), p = __expf(s - mn);
    l = l * c + p; m = mn;
    load64(vp, kv);
#pragma unroll
    for (int d = 0; d < 64; ++d) acc[d] = acc[d] * c + p * kv[d];
}
__device__ __forceinline__ void attn_naive_phase(Frame& F) {
    PHASE_BEGIN();
    const bf16* qkv = (const bf16*)(ws + WS_MIX); bf16* O = (bf16*)(ws + WS_O); const float* km = (const float*)(ws + WS_KMEAN);
    const int gt = bx * 512 + tid, NGT = F.G * 512;
    for (int item = gt; item < 16 * BATCH * SEQ; item += NGT) {
        const int t = item & (SEQ - 1), b = (item >> 12) & 7, hh = item >> 15;
        const size_t rowbase = (size_t)b * SEQ;
        float q[64], acc[64]; float m = -INFINITY, l = 0.f;
#pragma unroll
        for (int d = 0; d < 64; ++d) acc[d] = 0.f;
        if (hh < 8) {
            const int h = hh, own = t >> 8;
            load64(qkv + (rowbase + t) * NQKV + h * 64, q);
            const bf16* Kb = qkv + rowbase * NQKV + 512 + h * 64; const bf16* Vb = qkv + rowbase * NQKV + 1024 + h * 64;
            float g[16];
#pragma unroll
            for (int n = 0; n < 16; ++n) { g[n] = -INFINITY;
                if (n < own) { const float* kp = km + ((size_t)(b * 8 + h) * 16 + n) * 64; float s = 0.f;
#pragma unroll
                    for (int d = 0; d < 64; ++d) s += q[d] * kp[d];
                    g[n] = s; } }
            const int nsel = own < 3 ? own : 3; unsigned picked = 0u;
            for (int kt = own * 256; kt <= t; ++kt) attend_key(Kb + (size_t)kt * NQKV, Vb + (size_t)kt * NQKV, q, acc, m, l);
            for (int s = 0; s < nsel; ++s) { float best = -INFINITY; int bi = 0;
#pragma unroll
                for (int n = 0; n < 16; ++n) if (!((picked >> n) & 1u) && n < own && g[n] > best) { best = g[n]; bi = n; }
                picked |= 1u << bi;
                for (int kt = bi * 256; kt < bi * 256 + 256; ++kt) attend_key(Kb + (size_t)kt * NQKV, Vb + (size_t)kt * NQKV, q, acc, m, l); }
        } else {
            const int h = hh - 8;
            load64(qkv + (rowbase + t) * NQKV + 1536 + h * 64, q);
            const bf16* Kb = qkv + rowbase * NQKV + 2048 + h * 64; const bf16* Vb = qkv + rowbase * NQKV + 2560 + h * 64;
            for (int br = 0; br < 3; ++br) { const int dil = br == 0 ? 1 : (br == 1 ? 4 : 16);
                for (int n = 0; n <= 128; ++n) { const int kt = t - dil * n; if (kt < 0) break;
                    attend_key(Kb + (size_t)kt * NQKV, Vb + (size_t)kt * NQKV, q, acc, m, l); } }
        }
        const float rl = 1.0f / l; v4u* op = (v4u*)(O + (rowbase + t) * D + hh * 64);
#pragma unroll
        for (int i = 0; i < 8; ++i) { v4u w; w.x = pk2(acc[8 * i] * rl, acc[8 * i + 1] * rl); w.y = pk2(acc[8 * i + 2] * rl, acc[8 * i + 3] * rl);
            w.z = pk2(acc[8 * i + 4] * rl, acc[8 * i + 5] * rl); w.w = pk2(acc[8 * i + 6] * rl, acc[8 * i + 7] * rl); op[i] = w; }
    }
}


typedef float f32x16 __attribute__((ext_vector_type(16)));
typedef short s16x4 __attribute__((ext_vector_type(4)));
typedef short bf16x8v __attribute__((ext_vector_type(8)));
typedef float f32x2_t __attribute__((ext_vector_type(2))); typedef __bf16 bf16x2_t __attribute__((ext_vector_type(2)));
__device__ __forceinline__ unsigned cvtpk_s(float lo, float hi) { f32x2_t v = {lo, hi}; bf16x2_t b = __builtin_convertvector(v, bf16x2_t); return __builtin_bit_cast(unsigned, b); }
__device__ __forceinline__ int crow(int r, int hi) { return (r & 3) + 8 * (r >> 2) + 4 * hi; }
constexpr float ATT_C2 = 0.125f * 1.4426950408889634f;
__device__ __forceinline__ s16x4 lds_tr(LAS unsigned char* p) { typedef short v4i16_t __attribute__((ext_vector_type(4))); return __builtin_bit_cast(s16x4, __builtin_amdgcn_ds_read_tr16_b64_v4i16((LAS v4i16_t*)p)); }

template <int NS>
__device__ __forceinline__ void softmax_step(f32x16 (&p)[NS], float& m, float& l, f32x16 (&o)[2], bf16x8v (&pf)[NS][2]) {
    float mx = p[0][0];
#pragma unroll
    for (int s = 0; s < NS; ++s)
#pragma unroll
        for (int r = 0; r < 16; ++r) mx = fmaxf(mx, p[s][r]);
    mx = fmaxf(mx, __shfl_xor(mx, 32));
    const float mn = fmaxf(m, mx * ATT_C2);
    const float alpha = __builtin_amdgcn_exp2f(m - mn);
    m = mn; float sum = 0.f;
#pragma unroll
    for (int s = 0; s < NS; ++s)
#pragma unroll
        for (int r = 0; r < 16; ++r) { const float e = __builtin_amdgcn_exp2f(p[s][r] * ATT_C2 - mn); p[s][r] = e; sum += e; }
    l = l * alpha + sum;
    if (!__all(alpha == 1.0f)) {
#pragma unroll
        for (int d0 = 0; d0 < 2; ++d0)
#pragma unroll
            for (int r = 0; r < 16; ++r) o[d0][r] *= alpha;
    }
#pragma unroll
    for (int s = 0; s < NS; ++s)
#pragma unroll
        for (int k = 0; k < 2; ++k) { union { unsigned u[4]; bf16x8v v; } t;
#pragma unroll
            for (int j = 0; j < 4; ++j) t.u[j] = cvtpk_s(p[s][8 * k + 2 * j], p[s][8 * k + 2 * j + 1]);
            pf[s][k] = t.v; }
}
template <int NS>
__device__ __forceinline__ void pv_step(LAS unsigned char* vbase, const unsigned (&vb)[2], const bf16x8v (&pf)[NS][2], f32x16 (&o)[2]) {
#pragma unroll
    for (int ks = 0; ks < 2 * NS; ++ks)
#pragma unroll
        for (int d0 = 0; d0 < 2; ++d0) { const s16x4 lo = lds_tr(vbase + vb[d0] + ks * 2048), hi = lds_tr(vbase + vb[d0] + ks * 2048 + 1024);
            const bf16x8v vf = {lo[0], lo[1], lo[2], lo[3], hi[0], hi[1], hi[2], hi[3]};
            o[d0] = __builtin_amdgcn_mfma_f32_32x32x16_bf16(vf, pf[ks >> 1][ks & 1], o[d0], 0, 0, 0); }
}
__device__ __forceinline__ void store_ot(bf16* orow  , const f32x16 (&o)[2], float rl, int hi) {
#pragma unroll
    for (int d0 = 0; d0 < 2; ++d0)
#pragma unroll
        for (int rg = 0; rg < 4; ++rg) { v2u w; w.x = cvtpk_s(o[d0][4 * rg] * rl, o[d0][4 * rg + 1] * rl); w.y = cvtpk_s(o[d0][4 * rg + 2] * rl, o[d0][4 * rg + 3] * rl);
            *(v2u*)(orow + 32 * d0 + 8 * rg + 4 * hi) = w; }
}

constexpr int AL_KM = 0, AL_K = 4096, AL_V = 20480, AL_WV = 40960;
__device__ __forceinline__ void attn_fast_phase(Frame& F) {
    PHASE_BEGIN();
    const bf16* qkv = (const bf16*)(ws + WS_MIX); bf16* O = (bf16*)(ws + WS_O); const float* km = (const float*)(ws + WS_KMEAN);
    LAS unsigned char* L = F.lds;
    const int wid = __builtin_amdgcn_readfirstlane(tid >> 6), q = lane & 31, hi = lane >> 5;
    unsigned vb[2];
    { const int i = lane & 15, g1 = (lane >> 4) & 1, sw = (lane >> 3) & 1;
      const unsigned base = (unsigned)((4 * hi + (i >> 2)) * 128 + (2 * g1 + ((i >> 1) & 1)) * 16 + (i & 1) * 8);
      vb[0] = base + (unsigned)((0 ^ sw) * 64); vb[1] = base + (unsigned)((1 ^ sw) * 64); }
    for (int k4 = 0; k4 < 4; ++k4) {
        const int bh = bx >> 2, s4 = bx & 3, own = (k4 == 0) ? s4 : (k4 == 1) ? 7 - s4 : (k4 == 2) ? 8 + s4 : 15 - s4;
        if (bh >= 64) break;
        const int b = bh >> 3, h = bh & 7; const size_t rowbase = (size_t)b * SEQ;
        const int qrel = 32 * wid + q, tq = 256 * own + qrel;
        bf16x8v qr[4];
#pragma unroll
        for (int d0 = 0; d0 < 4; ++d0) qr[d0] = *(const bf16x8v*)(qkv + (rowbase + tq) * NQKV + h * 64 + 16 * d0 + 8 * hi);
        if (tid < 256) ((LAS f32x4*)(L + AL_KM))[tid] = ((const f32x4*)(km + (size_t)bh * 1024))[tid];
        const int srow = tid >> 3, sch = tid & 7;
        const bf16* kg = qkv + rowbase * NQKV + 512 + h * 64 + sch * 8 + (size_t)srow * NQKV; const bf16* vg = kg + 512;
        const unsigned kst = (unsigned)(srow * 128 + ((sch ^ ((srow >> 1) & 7)) << 4)), vst = (unsigned)(srow * 128 + ((sch ^ (((srow >> 1) & 1) << 2)) << 4));
        const int NT = 4 + 4 * own;
        v4u rk = *(const v4u*)(kg + (size_t)(256 * own) * NQKV), rv = *(const v4u*)(vg + (size_t)(256 * own) * NQKV);
        *(LAS v4u*)(L + AL_K + kst) = rk; *(LAS v4u*)(L + AL_V + vst) = rv;
        __syncthreads();
        unsigned selmask = 0u;
        { float g[16];
#pragma unroll
          for (int n = 0; n < 16; ++n) { g[n] = -INFINITY;
              if (n < own) { float s = 0.f; const LAS float* kp = (const LAS float*)(L + AL_KM) + n * 64 + 8 * hi;
#pragma unroll
                  for (int d0 = 0; d0 < 4; ++d0)
#pragma unroll
                      for (int jj = 0; jj < 8; ++jj) s += bf2f((unsigned short)qr[d0][jj]) * kp[16 * d0 + jj];
                  g[n] = s + __shfl_xor(s, 32); } }
          const int nsel = own < 3 ? own : 3;
          for (int s = 0; s < nsel; ++s) { float best = -INFINITY; int bi = 0;
#pragma unroll
              for (int n = 0; n < 16; ++n) if (!((selmask >> n) & 1u) && g[n] > best) { best = g[n]; bi = n; }
              selmask |= 1u << bi; } }
        float m = -1e30f, l = 0.f; f32x16 o[2]; o[0] = f32x16{}; o[1] = f32x16{};
        for (int idx = 0; idx < NT; ++idx) {
            const int cur = idx & 1; const bool more = idx + 1 < NT;
            if (more) { const int nx = idx + 1; const int key0 = nx < 4 ? 256 * own + 64 * nx : 256 * ((nx - 4) >> 2) + 64 * ((nx - 4) & 3);
                rk = *(const v4u*)(kg + (size_t)key0 * NQKV); rv = *(const v4u*)(vg + (size_t)key0 * NQKV); }
            bool act; int pastn = -1, jt = idx;
            if (idx < 4) act = (idx <= (wid >> 1)); else { pastn = (idx - 4) >> 2; jt = (idx - 4) & 3; act = __any((selmask >> pastn) & 1u) != 0; }
            if (act) {
                LAS unsigned char* Kt = L + AL_K + cur * 8192; LAS unsigned char* Vt = L + AL_V + cur * 8192;
                f32x16 p[2];
#pragma unroll
                for (int sub = 0; sub < 2; ++sub) { const int row = 32 * sub + q; f32x16 acc = f32x16{};
#pragma unroll
                    for (int d0 = 0; d0 < 4; ++d0) { const bf16x8v kf = *(const LAS bf16x8v*)(Kt + row * 128 + (((2 * d0 + hi) ^ ((row >> 1) & 7)) << 4));
                        acc = __builtin_amdgcn_mfma_f32_32x32x16_bf16(kf, qr[d0], acc, 0, 0, 0); }
                    p[sub] = acc; }
                if (idx < 4) {
#pragma unroll
                    for (int sub = 0; sub < 2; ++sub)
#pragma unroll
                        for (int r = 0; r < 16; ++r) if (64 * jt + 32 * sub + crow(r, hi) > qrel) p[sub][r] = -INFINITY;
                } else if (!((selmask >> pastn) & 1u)) {
#pragma unroll
                    for (int sub = 0; sub < 2; ++sub)
#pragma unroll
                        for (int r = 0; r < 16; ++r) p[sub][r] = -INFINITY;
                }
                bf16x8v pf[2][2];
                softmax_step<2>(p, m, l, o, pf);
                pv_step<2>(Vt, vb, pf, o);
            }
            if (more) { *(LAS v4u*)(L + AL_K + (cur ^ 1) * 8192 + kst) = rk; *(LAS v4u*)(L + AL_V + (cur ^ 1) * 8192 + vst) = rv; }
            __syncthreads();
        }
        { const float lt = l + __shfl_xor(l, 32); store_ot(O + (rowbase + tq) * D + h * 64, o, 1.0f / lt, hi); }
    }
    {
        LAS unsigned char* Vt = L + AL_WV + wid * 4096;
        const int vch = lane & 7, vr0 = lane >> 3;
        for (int task = gw; task < BATCH * 8 * 16 * 8; task += F.NGW) {
            const int iw = task & 7, r16 = (task >> 3) & 15, h = (task >> 7) & 7, b = task >> 10;
            const size_t rowbase = (size_t)b * SEQ; const int tlo = r16 + 512 * iw, tq = tlo + 16 * q;
            const bf16* Kb = qkv + rowbase * NQKV + 2048 + h * 64; const bf16* Vb = qkv + rowbase * NQKV + 2560 + h * 64;
            bf16x8v qr[4];
#pragma unroll
            for (int d0 = 0; d0 < 4; ++d0) qr[d0] = *(const bf16x8v*)(qkv + (rowbase + tq) * NQKV + 1536 + h * 64 + 16 * d0 + 8 * hi);
            float m = -1e30f, l = 0.f; f32x16 o[2]; o[0] = f32x16{}; o[1] = f32x16{};
            for (int br = 0; br < 3; ++br) {
                const int stride = br == 0 ? 1 : (br == 1 ? 4 : 16), W = 128 * stride, ntile = br == 0 ? 20 : (br == 1 ? 8 : 5);
                const int kbase = tlo - W;
                for (int kt = 0; kt < ntile; ++kt) {
                    const int k0 = kbase + 32 * kt * stride;
                    if (k0 + 31 * stride < 0) continue;
                    int kp = k0 + q * stride; kp = kp < 0 ? 0 : (kp > SEQ - 1 ? SEQ - 1 : kp);
                    bf16x8v kf[4];
#pragma unroll
                    for (int d0 = 0; d0 < 4; ++d0) kf[d0] = *(const bf16x8v*)(Kb + (size_t)kp * NQKV + 16 * d0 + 8 * hi);
                    v4u vv[4];
#pragma unroll
                    for (int jj = 0; jj < 4; ++jj) { int vp = k0 + (vr0 + 8 * jj) * stride; vp = vp < 0 ? 0 : (vp > SEQ - 1 ? SEQ - 1 : vp); vv[jj] = *(const v4u*)(Vb + (size_t)vp * NQKV + vch * 8); }
                    f32x16 p[1]; p[0] = f32x16{};
#pragma unroll
                    for (int d0 = 0; d0 < 4; ++d0) p[0] = __builtin_amdgcn_mfma_f32_32x32x16_bf16(kf[d0], qr[d0], p[0], 0, 0, 0);
#pragma unroll
                    for (int r = 0; r < 16; ++r) { const int pos = k0 + crow(r, hi) * stride, dist = tq - pos; if (pos < 0 || dist < 0 || dist > W) p[0][r] = -INFINITY; }
#pragma unroll
                    for (int jj = 0; jj < 4; ++jj) { const int row = vr0 + 8 * jj; *(LAS v4u*)(Vt + row * 128 + ((vch ^ (((row >> 1) & 1) << 2)) << 4)) = vv[jj]; }
                    bf16x8v pf[1][2];
                    softmax_step<1>(p, m, l, o, pf);
                    pv_step<1>(Vt, vb, pf, o);
                }
            }
            { const float lt = l + __shfl_xor(l, 32); store_ot(O + (rowbase + tq) * D + 512 + h * 64, o, 1.0f / lt, hi); }
        }
    }
}

__device__ __forceinline__ void hgrn_naive_phase(Frame& F, int j) {
    PHASE_BEGIN();
    const bf16* H = (const bf16*)(ws + WS_MIX); float* O32 = (float*)(ws + WS_O32); const float* lbp = (const float*)(ws + WS_LB) + (size_t)j * D;
    const int gtw = bx * 8 + F.wave;
    if (gtw >= 128) return;
    const int bh = gtw >> 1, b = bh >> 3, h = bh & 7, e = (gtw & 1) * 64 + lane;
    float S[128];
#pragma unroll
    for (int d = 0; d < 128; ++d) S[d] = 0.f;
    const float* lbh = lbp + h * 128;
    for (int t = 0; t < SEQ; ++t) {
        const size_t row = (size_t)b * SEQ + t;
        const v4u* qp = (const v4u*)(H + row * NH4 + h * 128); const v4u* zp = (const v4u*)(H + row * NH4 + 1024 + h * 128);
        const float v = bf2f(H[row * NH4 + 2048 + h * 128 + e]);
        float o = 0.f;
#pragma unroll
        for (int c = 0; c < 16; ++c) { const v4u qw = qp[c], zw = zp[c];
            const unsigned qa[4] = {qw.x, qw.y, qw.z, qw.w}, za[4] = {zw.x, zw.y, zw.z, zw.w};
#pragma unroll
            for (int k = 0; k < 8; ++k) { const int d = 8 * c + k;
                const float z = (k & 1) ? bfhi(za[k >> 1]) : bflo(za[k >> 1]); const float qv = (k & 1) ? bfhi(qa[k >> 1]) : bflo(qa[k >> 1]);
                const float sg = 1.0f / (1.0f + __expf(-z)); const float lbv = lbh[d];
                const float f = lbv + (1.0f - lbv) * sg, kk = (1.0f - lbv) * (1.0f - sg);
                S[d] = f * S[d] + kk * v; o += qv * S[d]; } }
        O32[row * D + h * 128 + e] = o;
    }
}
__device__ __forceinline__ void hgrn_norm_phase(Frame& F, int j) {
    PHASE_BEGIN();
    const float* O32 = (const float*)(ws + WS_O32); const bf16* H = (const bf16*)(ws + WS_MIX); bf16* O = (bf16*)(ws + WS_O);
    const float* ng = in_ptr(F, 5) + (size_t)j * 128;
    for (int m = gw; m < T; m += F.NGW) {
        const f32x4* orow = (const f32x4*)(O32 + (size_t)m * D) + lane; const v2u* grow = (const v2u*)(H + (size_t)m * NH4 + 3072) + lane; v2u* out = (v2u*)(O + (size_t)m * D) + lane;
#pragma unroll
        for (int jj = 0; jj < 4; ++jj) { const f32x4 o = orow[64 * jj]; const v2u gw = grow[64 * jj];
            float ss = (o.x * o.x + o.y * o.y) + (o.z * o.z + o.w * o.w);
#pragma unroll
            for (int s = 1; s < 32; s <<= 1) ss += __shfl_xor(ss, s);
            const float r = 1.0f / sqrtf(ss * (1.0f / 128.0f) + RMS_EPS);
            const f32x4 gn = *(const f32x4*)(ng + ((4 * lane) & 127));
            const float g0 = bflo(gw.x), g1 = bfhi(gw.x), g2 = bflo(gw.y), g3 = bfhi(gw.y);
            v2u w; w.x = pk2(o.x * r * gn.x * (g0 / (1.0f + __expf(-g0))), o.y * r * gn.y * (g1 / (1.0f + __expf(-g1))));
            w.y = pk2(o.z * r * gn.z * (g2 / (1.0f + __expf(-g2))), o.w * r * gn.w * (g3 / (1.0f + __expf(-g3))));
            out[64 * jj] = w; }
    }
}

__device__ __forceinline__ void lna_phase(Frame& F, int l) {
    PHASE_BEGIN();
    float* X = (float*)(ws + WS_X); bf16* XB = (bf16*)(ws + WS_XB);
    const float* lg_ = in_ptr(F, 7) + (size_t)(l * 2) * D; const float* lb_ = in_ptr(F, 8) + (size_t)(l * 2) * D;
    const float* wg = in_ptr(F, 9) + (size_t)l * D * 4; const float* bg = in_ptr(F, 10) + l * 4; const float* we = in_ptr(F, 11) + (size_t)l * D * 32; const float* be = in_ptr(F, 12) + l * 32;
    int* RE = (int*)(ws + WS_RE); float* RW = (float*)(ws + WS_RW); unsigned* cnt = (unsigned*)(ws + WS_CTL) + CW_CNT + 64 * l;
    for (int m = gw; m < T; m += F.NGW) {
        f32x4* xr = (f32x4*)(X + (size_t)m * D) + lane; f32x4 v[4]; float s = 0.f;
#pragma unroll
        for (int j = 0; j < 4; ++j) { v[j] = xr[64 * j]; s += (v[j].x + v[j].y) + (v[j].z + v[j].w); }
        const float mean = wave_sum(s) * (1.f / D); float s2 = 0.f;
#pragma unroll
        for (int j = 0; j < 4; ++j) { v[j] = v[j] - mean; s2 += (v[j].x * v[j].x + v[j].y * v[j].y) + (v[j].z * v[j].z + v[j].w * v[j].w); }
        const float rstd = 1.f / sqrtf(wave_sum(s2) * (1.f / D) + LN_EPS);
        v2u* o8 = (v2u*)(XB + (size_t)m * D) + lane;
        float lg[4] = {0.f, 0.f, 0.f, 0.f}; float le[32];
#pragma unroll
        for (int i = 0; i < 32; ++i) le[i] = 0.f;
#pragma unroll
        for (int j = 0; j < 4; ++j) { const int c0 = 4 * lane + 256 * j; const f32x4 g = *(const f32x4*)(lg_ + c0), bb = *(const f32x4*)(lb_ + c0);
            v[j] = v[j] * rstd * g + bb; xr[64 * j] = v[j];
            v2u o; o.x = pk2(v[j].x, v[j].y); o.y = pk2(v[j].z, v[j].w); o8[64 * j] = o;
#pragma unroll
            for (int i = 0; i < 4; ++i) { const float xv = v[j][i]; const int k = c0 + i;
                const f32x4 w4 = *(const f32x4*)(wg + (size_t)k * 4); lg[0] += xv * w4.x; lg[1] += xv * w4.y; lg[2] += xv * w4.z; lg[3] += xv * w4.w;
#pragma unroll
                for (int q = 0; q < 8; ++q) { const f32x4 w = *(const f32x4*)(we + (size_t)k * 32 + 4 * q);
                    le[4 * q] += xv * w.x; le[4 * q + 1] += xv * w.y; le[4 * q + 2] += xv * w.z; le[4 * q + 3] += xv * w.w; } } }
#pragma unroll
        for (int i = 0; i < 4; ++i) lg[i] = wave_sum(lg[i]) + bg[i];
#pragma unroll
        for (int i = 0; i < 32; ++i) le[i] = wave_sum(le[i]) + be[i];
        float best = lg[0]; int grp = 0;
#pragma unroll
        for (int i = 1; i < 4; ++i) if (lg[i] > best) { best = lg[i]; grp = i; }
        float den = 0.f;
#pragma unroll
        for (int i = 0; i < 4; ++i) den += expf(lg[i] - best);
        const float pg = 1.0f / den;
        float b1 = -INFINITY, b2 = -INFINITY; int i1 = 0, i2 = 0;
#pragma unroll
        for (int i = 0; i < 32; ++i) if ((i >> 3) == grp && le[i] > b1) { b1 = le[i]; i1 = i; }
#pragma unroll
        for (int i = 0; i < 32; ++i) if ((i >> 3) == grp && i != i1 && le[i] > b2) { b2 = le[i]; i2 = i; }
        const float e21 = expf(b2 - b1); const float w1 = pg / (1.0f + e21), w2 = pg * e21 / (1.0f + e21);
        if (lane == 0) { RE[2 * m] = i1; RE[2 * m + 1] = i2; RW[2 * m] = w1; RW[2 * m + 1] = w2;
            __hip_atomic_fetch_add(cnt + i1, 1u, __ATOMIC_RELAXED, __HIP_MEMORY_SCOPE_AGENT); __hip_atomic_fetch_add(cnt + i2, 1u, __ATOMIC_RELAXED, __HIP_MEMORY_SCOPE_AGENT); }
    }
}
__device__ __forceinline__ void slot_phase(Frame& F, int l) {
    PHASE_BEGIN();
    const unsigned* cnt = (unsigned*)(ws + WS_CTL) + CW_CNT + 64 * l; unsigned* cur = (unsigned*)(ws + WS_CTL) + CW_CUR + 64 * l;
    volatile LAS int* MI = (volatile LAS int*)F.MISC;
    if (tid == 0) { int acc = 0;
        for (int e = 0; e < NEXP; ++e) { const int c = (int)__hip_atomic_load(cnt + e, __ATOMIC_RELAXED, __HIP_MEMORY_SCOPE_AGENT); const int n = (c + 255) >> 8; MI[320 + e] = acc;
            for (int k = 0; k < n; ++k) MI[17 + acc + k] = e; acc += n; }
        MI[16] = acc; }
    __syncthreads();
    const int* RE = (const int*)(ws + WS_RE); int* POS = (int*)(ws + WS_POS); const bf16* XB = (const bf16*)(ws + WS_XB); bf16* XG = (bf16*)(ws + WS_XG);
    for (int m = gw; m < T; m += F.NGW) {
        int s0 = 0, s1 = 0;
        if (lane == 0) { const int e0 = RE[2 * m], e1 = RE[2 * m + 1];
            s0 = MI[320 + e0] * 256 + (int)__hip_atomic_fetch_add(cur + e0, 1u, __ATOMIC_RELAXED, __HIP_MEMORY_SCOPE_AGENT);
            s1 = MI[320 + e1] * 256 + (int)__hip_atomic_fetch_add(cur + e1, 1u, __ATOMIC_RELAXED, __HIP_MEMORY_SCOPE_AGENT);
            POS[2 * m] = s0; POS[2 * m + 1] = s1; }
        s0 = __builtin_amdgcn_readfirstlane(s0); s1 = __builtin_amdgcn_readfirstlane(s1);
        const v4u* src = (const v4u*)(XB + (size_t)m * D) + lane; const v4u a = src[0], c = src[64];
        v4u* d0 = (v4u*)(XG + (size_t)s0 * D) + lane; v4u* d1 = (v4u*)(XG + (size_t)s1 * D) + lane;
        d0[0] = a; d0[64] = c; d1[0] = a; d1[64] = c;
    }
}
__device__ __forceinline__ void lnb_phase(Frame& F, int l) {
    PHASE_BEGIN();
    float* X = (float*)(ws + WS_X); bf16* XB = (bf16*)(ws + WS_XB); const bf16* YB = (const bf16*)(ws + WS_YB);
    const float* lg_ = in_ptr(F, 7) + (size_t)(l * 2 + 1) * D; const float* lb_ = in_ptr(F, 8) + (size_t)(l * 2 + 1) * D;
    const int* POS = (const int*)(ws + WS_POS); const float* RW = (const float*)(ws + WS_RW);
    const bool last = (l == DEPTH - 1);
    for (int m = gw; m < T; m += F.NGW) {
        const int p0 = POS[2 * m], p1 = POS[2 * m + 1]; const float w0 = RW[2 * m], w1 = RW[2 * m + 1];
        f32x4* xr = (f32x4*)(X + (size_t)m * D) + lane; const v2u* y0 = (const v2u*)(YB + (size_t)p0 * D) + lane; const v2u* y1 = (const v2u*)(YB + (size_t)p1 * D) + lane;
        f32x4 v[4]; float s = 0.f;
#pragma unroll
        for (int j = 0; j < 4; ++j) { const f32x4 xv = xr[64 * j]; const v2u a = y0[64 * j], c = y1[64 * j];
            v[j].x = ALPHA * xv.x + w0 * bflo(a.x) + w1 * bflo(c.x); v[j].y = ALPHA * xv.y + w0 * bfhi(a.x) + w1 * bfhi(c.x);
            v[j].z = ALPHA * xv.z + w0 * bflo(a.y) + w1 * bflo(c.y); v[j].w = ALPHA * xv.w + w0 * bfhi(a.y) + w1 * bfhi(c.y);
            s += (v[j].x + v[j].y) + (v[j].z + v[j].w); }
        const float mean = wave_sum(s) * (1.f / D); float s2 = 0.f;
#pragma unroll
        for (int j = 0; j < 4; ++j) { v[j] = v[j] - mean; s2 += (v[j].x * v[j].x + v[j].y * v[j].y) + (v[j].z * v[j].z + v[j].w * v[j].w); }
        const float rstd = 1.f / sqrtf(wave_sum(s2) * (1.f / D) + LN_EPS);
        f32x4* outr = last ? (f32x4*)((float*)in_ptr(F, 16) + (size_t)m * D) + lane : xr; v2u* o8 = (v2u*)(XB + (size_t)m * D) + lane;
#pragma unroll
        for (int j = 0; j < 4; ++j) { const int c0 = 4 * lane + 256 * j; const f32x4 g = *(const f32x4*)(lg_ + c0), bb = *(const f32x4*)(lb_ + c0);
            v[j] = v[j] * rstd * g + bb; outr[64 * j] = v[j];
            v2u o; o.x = pk2(v[j].x, v[j].y); o.y = pk2(v[j].z, v[j].w); o8[64 * j] = o; }
    }
}

struct Args { const float* in[16]; float* out; unsigned char* ws; };
__global__ void __launch_bounds__(NWAVES * 64, 2) mega_fwd(Args args) {
    extern __shared__ __attribute__((aligned(16))) unsigned char lds[];
    Frame F;
    F.lds = (LAS unsigned char*)lds; F.MISC = (volatile LAS unsigned*)(F.lds + MISC_OFF);
    F.tid = threadIdx.x; F.lane = F.tid & 63; F.wave = __builtin_amdgcn_readfirstlane(F.tid >> 6);
    F.G = gridDim.x; F.gw = blockIdx.x * NWAVES + F.wave; F.NGW = F.G * NWAVES;
    F.ws = args.ws;
    for (int u = F.tid; u < (LDS_BYTES - MISC_OFF) / 4; u += NWAVES * 64) F.MISC[u] = 0u;
    __syncthreads();
    if (F.tid < 17) { const unsigned long long p = F.tid < 16 ? (unsigned long long)args.in[F.tid] : (unsigned long long)args.out; F.MISC[512 + 2 * F.tid] = (unsigned)p; F.MISC[513 + 2 * F.tid] = (unsigned)(p >> 32); }
    __syncthreads();
#define GRID_BAR() do { unsigned char* wsb_ = F.ws; asm volatile("" : "+s"(wsb_)); XcdBarrier bar_; bar_.bar = (unsigned*)(wsb_ + WS_CTL) + CW_BAR; bar_.x = xb_xcc_id(); bar_.st = F.MISC; xcd_barrier(bar_); } while (0)
    { XcdBarrier b0 = xcd_barrier_post((unsigned*)(F.ws + WS_CTL) + CW_BAR, F.MISC); (void)b0; }
    PG8_LAS unsigned char* ring = (PG8_LAS unsigned char*)lds;

    prologue(F); convert_weights(F, 0);
    GRID_BAR();
    { constexpr int l = 0;
        constexpr bool even = (l & 1) == 0; constexpr int j = l >> 1;
        { LAUNDER_WS(); const int Nin = even ? NQKV : NH4;
          pg8::Gemm g{(const pg8::bf16_t*)(ws + WS_XB), (const pg8::bf16_t*)(ws + WS_WIN), T, Nin, D}; pg8::StaticOrder S; S.init(T, Nin, F.G, bx);
          pg8::EpiPlain E{(pg8::bf16_t*)(ws + WS_MIX), Nin, 0xffff};
          pg8::gemm_phase<pg8::EpiPlain, pg8::StaticOrder, true, true>(ring, g, S, E); }
        GRID_BAR();
        if constexpr (even) {
            rope_phase(F); GRID_BAR();
            kmean_phase(F); GRID_BAR();
            attn_fast_phase(F); GRID_BAR();
        } else {
            hgrn_naive_phase(F, j); GRID_BAR();
            hgrn_norm_phase(F, j); GRID_BAR();
        }
        { LAUNDER_WS(); pg8::Gemm g{(const pg8::bf16_t*)(ws + WS_O), (const pg8::bf16_t*)(ws + WS_WOUT), T, D, D}; pg8::StaticOrder S; S.init(T, D, F.G, bx);
          pg8::EpiResid E{l == 0 ? in_ptr(F, 0) : (const float*)(ws + WS_X), (float*)(ws + WS_X), ALPHA};
          pg8::gemm_phase<pg8::EpiResid, pg8::StaticOrder, true, true>(ring, g, S, E); }
        GRID_BAR();
        lna_phase(F, l); GRID_BAR();
        slot_phase(F, l); GRID_BAR();
        { LAUNDER_WS(); pg8::Gemm g{(const pg8::bf16_t*)(ws + WS_XG), (const pg8::bf16_t*)(ws + WS_W13), MAX_TILES * 256, 1024, D};
          pg8::MoeOrder S{(const PG8_LAS int*)(F.lds + MISC_OFF + 64), F.G, (F.G % 8 == 0) ? (bx % 8) * (F.G / 8) + bx / 8 : bx};
          pg8::EpiSwiGlu E{(pg8::bf16_t*)(ws + WS_HB), FEXP};
          pg8::gemm_phase<pg8::EpiSwiGlu, pg8::MoeOrder, true, true>(ring, g, S, E); }
        GRID_BAR();
        { LAUNDER_WS(); pg8::Gemm g{(const pg8::bf16_t*)(ws + WS_HB), (const pg8::bf16_t*)(ws + WS_W2), MAX_TILES * 256, 1024, FEXP};
          pg8::MoeOrder S{(const PG8_LAS int*)(F.lds + MISC_OFF + 64), F.G, (F.G % 8 == 0) ? (bx % 8) * (F.G / 8) + bx / 8 : bx};
          pg8::EpiPlain E{(pg8::bf16_t*)(ws + WS_YB), D, 3};
          pg8::gemm_phase<pg8::EpiPlain, pg8::MoeOrder, true, true>(ring, g, S, E); }
        GRID_BAR();
        lnb_phase(F, l);
        if (l + 1 < DEPTH) { convert_weights(F, l + 1); GRID_BAR(); }
    }
    { constexpr int l = 1;
        constexpr bool even = (l & 1) == 0; constexpr int j = l >> 1;
        { LAUNDER_WS(); const int Nin = even ? NQKV : NH4;
          pg8::Gemm g{(const pg8::bf16_t*)(ws + WS_XB), (const pg8::bf16_t*)(ws + WS_WIN), T, Nin, D}; pg8::StaticOrder S; S.init(T, Nin, F.G, bx);
          pg8::EpiPlain E{(pg8::bf16_t*)(ws + WS_MIX), Nin, 0xffff};
          pg8::gemm_phase<pg8::EpiPlain, pg8::StaticOrder, true, true>(ring, g, S, E); }
        GRID_BAR();
        if constexpr (even) {
            rope_phase(F); GRID_BAR();
            kmean_phase(F); GRID_BAR();
            attn_fast_phase(F); GRID_BAR();
        } else {
            hgrn_naive_phase(F, j); GRID_BAR();
            hgrn_norm_phase(F, j); GRID_BAR();
        }
        { LAUNDER_WS(); pg8::Gemm g{(const pg8::bf16_t*)(ws + WS_O), (const pg8::bf16_t*)(ws + WS_WOUT), T, D, D}; pg8::StaticOrder S; S.init(T, D, F.G, bx);
          pg8::EpiResid E{l == 0 ? in_ptr(F, 0) : (const float*)(ws + WS_X), (float*)(ws + WS_X), ALPHA};
          pg8::gemm_phase<pg8::EpiResid, pg8::StaticOrder, true, true>(ring, g, S, E); }
        GRID_BAR();
        lna_phase(F, l); GRID_BAR();
        slot_phase(F, l); GRID_BAR();
        { LAUNDER_WS(); pg8::Gemm g{(const pg8::bf16_t*)(ws + WS_XG), (const pg8::bf16_t*)(ws + WS_W13), MAX_TILES * 256, 1024, D};
          pg8::MoeOrder S{(const PG8_LAS int*)(F.lds + MISC_OFF + 64), F.G, (F.G % 8 == 0) ? (bx % 8) * (F.G / 8) + bx / 8 : bx};
          pg8::EpiSwiGlu E{(pg8::bf16_t*)(ws + WS_HB), FEXP};
          pg8::gemm_phase<pg8::EpiSwiGlu, pg8::MoeOrder, true, true>(ring, g, S, E); }
        GRID_BAR();
        { LAUNDER_WS(); pg8::Gemm g{(const pg8::bf16_t*)(ws + WS_HB), (const pg8::bf16_t*)(ws + WS_W2), MAX_TILES * 256, 1024, FEXP};
          pg8::MoeOrder S{(const PG8_LAS int*)(F.lds + MISC_OFF + 64), F.G, (F.G % 8 == 0) ? (bx % 8) * (F.G / 8) + bx / 8 : bx};
          pg8::EpiPlain E{(pg8::bf16_t*)(ws + WS_YB), D, 3};
          pg8::gemm_phase<pg8::EpiPlain, pg8::MoeOrder, true, true>(ring, g, S, E); }
        GRID_BAR();
        lnb_phase(F, l);
        if (l + 1 < DEPTH) { convert_weights(F, l + 1); GRID_BAR(); }
    }
    { constexpr int l = 2;
        constexpr bool even = (l & 1) == 0; constexpr int j = l >> 1;
        { LAUNDER_WS(); const int Nin = even ? NQKV : NH4;
          pg8::Gemm g{(const pg8::bf16_t*)(ws + WS_XB), (const pg8::bf16_t*)(ws + WS_WIN), T, Nin, D}; pg8::StaticOrder S; S.init(T, Nin, F.G, bx);
          pg8::EpiPlain E{(pg8::bf16_t*)(ws + WS_MIX), Nin, 0xffff};
          pg8::gemm_phase<pg8::EpiPlain, pg8::StaticOrder, true, true>(ring, g, S, E); }
        GRID_BAR();
        if constexpr (even) {
            rope_phase(F); GRID_BAR();
            kmean_phase(F); GRID_BAR();
            attn_fast_phase(F); GRID_BAR();
        } else {
            hgrn_naive_phase(F, j); GRID_BAR();
            hgrn_norm_phase(F, j); GRID_BAR();
        }
        { LAUNDER_WS(); pg8::Gemm g{(const pg8::bf16_t*)(ws + WS_O), (const pg8::bf16_t*)(ws + WS_WOUT), T, D, D}; pg8::StaticOrder S; S.init(T, D, F.G, bx);
          pg8::EpiResid E{l == 0 ? in_ptr(F, 0) : (const float*)(ws + WS_X), (float*)(ws + WS_X), ALPHA};
          pg8::gemm_phase<pg8::EpiResid, pg8::StaticOrder, true, true>(ring, g, S, E); }
        GRID_BAR();
        lna_phase(F, l); GRID_BAR();
        slot_phase(F, l); GRID_BAR();
        { LAUNDER_WS(); pg8::Gemm g{(const pg8::bf16_t*)(ws + WS_XG), (const pg8::bf16_t*)(ws + WS_W13), MAX_TILES * 256, 1024, D};
          pg8::MoeOrder S{(const PG8_LAS int*)(F.lds + MISC_OFF + 64), F.G, (F.G % 8 == 0) ? (bx % 8) * (F.G / 8) + bx / 8 : bx};
          pg8::EpiSwiGlu E{(pg8::bf16_t*)(ws + WS_HB), FEXP};
          pg8::gemm_phase<pg8::EpiSwiGlu, pg8::MoeOrder, true, true>(ring, g, S, E); }
        GRID_BAR();
        { LAUNDER_WS(); pg8::Gemm g{(const pg8::bf16_t*)(ws + WS_HB), (const pg8::bf16_t*)(ws + WS_W2), MAX_TILES * 256, 1024, FEXP};
          pg8::MoeOrder S{(const PG8_LAS int*)(F.lds + MISC_OFF + 64), F.G, (F.G % 8 == 0) ? (bx % 8) * (F.G / 8) + bx / 8 : bx};
          pg8::EpiPlain E{(pg8::bf16_t*)(ws + WS_YB), D, 3};
          pg8::gemm_phase<pg8::EpiPlain, pg8::MoeOrder, true, true>(ring, g, S, E); }
        GRID_BAR();
        lnb_phase(F, l);
        if (l + 1 < DEPTH) { convert_weights(F, l + 1); GRID_BAR(); }
    }
    { constexpr int l = 3;
        constexpr bool even = (l & 1) == 0; constexpr int j = l >> 1;
        { LAUNDER_WS(); const int Nin = even ? NQKV : NH4;
          pg8::Gemm g{(const pg8::bf16_t*)(ws + WS_XB), (const pg8::bf16_t*)(ws + WS_WIN), T, Nin, D}; pg8::StaticOrder S; S.init(T, Nin, F.G, bx);
          pg8::EpiPlain E{(pg8::bf16_t*)(ws + WS_MIX), Nin, 0xffff};
          pg8::gemm_phase<pg8::EpiPlain, pg8::StaticOrder, true, true>(ring, g, S, E); }
        GRID_BAR();
        if constexpr (even) {
            rope_phase(F); GRID_BAR();
            kmean_phase(F); GRID_BAR();
            attn_fast_phase(F); GRID_BAR();
        } else {
            hgrn_naive_phase(F, j); GRID_BAR();
            hgrn_norm_phase(F, j); GRID_BAR();
        }
        { LAUNDER_WS(); pg8::Gemm g{(const pg8::bf16_t*)(ws + WS_O), (const pg8::bf16_t*)(ws + WS_WOUT), T, D, D}; pg8::StaticOrder S; S.init(T, D, F.G, bx);
          pg8::EpiResid E{l == 0 ? in_ptr(F, 0) : (const float*)(ws + WS_X), (float*)(ws + WS_X), ALPHA};
          pg8::gemm_phase<pg8::EpiResid, pg8::StaticOrder, true, true>(ring, g, S, E); }
        GRID_BAR();
        lna_phase(F, l); GRID_BAR();
        slot_phase(F, l); GRID_BAR();
        { LAUNDER_WS(); pg8::Gemm g{(const pg8::bf16_t*)(ws + WS_XG), (const pg8::bf16_t*)(ws + WS_W13), MAX_TILES * 256, 1024, D};
          pg8::MoeOrder S{(const PG8_LAS int*)(F.lds + MISC_OFF + 64), F.G, (F.G % 8 == 0) ? (bx % 8) * (F.G / 8) + bx / 8 : bx};
          pg8::EpiSwiGlu E{(pg8::bf16_t*)(ws + WS_HB), FEXP};
          pg8::gemm_phase<pg8::EpiSwiGlu, pg8::MoeOrder, true, true>(ring, g, S, E); }
        GRID_BAR();
        { LAUNDER_WS(); pg8::Gemm g{(const pg8::bf16_t*)(ws + WS_HB), (const pg8::bf16_t*)(ws + WS_W2), MAX_TILES * 256, 1024, FEXP};
          pg8::MoeOrder S{(const PG8_LAS int*)(F.lds + MISC_OFF + 64), F.G, (F.G % 8 == 0) ? (bx % 8) * (F.G / 8) + bx / 8 : bx};
          pg8::EpiPlain E{(pg8::bf16_t*)(ws + WS_YB), D, 3};
          pg8::gemm_phase<pg8::EpiPlain, pg8::MoeOrder, true, true>(ring, g, S, E); }
        GRID_BAR();
        lnb_phase(F, l);
        if (l + 1 < DEPTH) { convert_weights(F, l + 1); GRID_BAR(); }
    }
}

extern "C" void kernel_launch(void* const* d_in, const int* in_sizes, int n_in, void* d_out, int out_size, void* d_ws, size_t ws_size, hipStream_t stream) {
    static int grid = 0;
    if (grid == 0) {
        if (n_in != 16 || in_sizes[0] != T * D || out_size != T * D || ws_size < WS_END) { fprintf(stderr, "kernel_launch: unexpected shapes (n_in %d, in0 %d, out %d, ws %zu)\n", n_in, n_in > 0 ? in_sizes[0] : -1, out_size, ws_size); grid = -1; return; }
        int dev = 0, cus = 0, per_cu = 0;
        if (hipGetDevice(&dev) != hipSuccess || hipDeviceGetAttribute(&cus, hipDeviceAttributeMultiprocessorCount, dev) != hipSuccess) { grid = -1; return; }
        if (hipFuncSetAttribute((const void*)mega_fwd, hipFuncAttributeMaxDynamicSharedMemorySize, LDS_BYTES) != hipSuccess) { fprintf(stderr, "kernel_launch: hipFuncSetAttribute failed\n"); grid = -1; return; }
        if (hipOccupancyMaxActiveBlocksPerMultiprocessor(&per_cu, (const void*)mega_fwd, NWAVES * 64, LDS_BYTES) != hipSuccess || per_cu < 1) fprintf(stderr, "kernel_launch: occupancy query reports %d\n", per_cu);
        (void)hipGetLastError();
        grid = cus;
    }
    if (grid < 0) return;
    if (hipMemsetAsync((char*)d_ws + WS_CTL, 0, CTL_ZERO_BYTES, stream) != hipSuccess) return;
    Args a{};
    for (int i = 0; i < 16; ++i) a.in[i] = (const float*)d_in[i];
    a.out = (float*)d_out; a.ws = (unsigned char*)d_ws;
    hipLaunchKernelGGL(mega_fwd, dim3(grid), dim3(NWAVES * 64), LDS_BYTES, stream, a);
}
```

```cpp
#include <hip/hip_runtime.h>
#include <cstdio>
#include <cstdint>
#include <cmath>
namespace pg8 {
#define PG8_LAS __attribute__((address_space(3)))
typedef unsigned short bf16_t;
typedef short bf16x8 __attribute__((ext_vector_type(8)));
typedef float f32x4 __attribute__((ext_vector_type(4)));
typedef unsigned u32x4 __attribute__((ext_vector_type(4)));
constexpr int BM = 256, BK = 64, HALF = 128, HTB = HALF * BK * 2  , STAGE_BYTES = 8 * HTB, NXCD = 8, WGM = 8;

__host__ __device__ __forceinline__ int lds_byte(int r, int c) { const int st = (r >> 4) * 2 + (c >> 5), rr = r & 15, cc = c & 31, ob = rr * 64 + cc * 2; return st * 1024 + (ob ^ (((ob >> 9) & 1) << 5)); }
__host__ __device__ __forceinline__ void stage_rc(int b, int& R, int& C) { const int st = b / 1024, sb = b % 1024, swz = sb ^ (((sb >> 9) & 1) << 5); R = (st >> 1) * 16 + swz / 64; C = (st & 1) * 32 + (swz % 64) / 2; }
__host__ __device__ __forceinline__ int perm32(int rho) { const int n = rho >> 4, i = rho & 15; return 8 * (i >> 2) + 4 * n + (i & 3); }

struct Unit { int pm, pn; };
struct Gemm { const bf16_t* A; const bf16_t* Bt; int M, N, K; };

struct StaticOrder {
    int nM, nN, nwg, G, c;
    __host__ __device__ void init(int M, int N, int G_, int c_) { nM = M / BM; nN = N / BM; nwg = nM * nN; G = G_; c = c_; }
    __host__ __device__ bool next(int i, Unit& u) const {
        const long L = (long)i * G + c; if (L >= nwg) return false;
        int wgid = (int)L; { const int q = nwg / NXCD, r = nwg % NXCD, xcd = wgid % NXCD, off = wgid / NXCD; wgid = (xcd < r ? xcd * (q + 1) : r * (q + 1) + (xcd - r) * q) + off; }
        const int nig = WGM * nN, gid = wgid / nig, fm = gid * WGM, gsz = (nM - fm) < WGM ? (nM - fm) : WGM;
        u.pm = fm + ((wgid % nig) % gsz); u.pn = (wgid % nig) / gsz; return true;
    }
    __device__ __forceinline__ void a_ready(const Unit&) const {}
    __device__ __forceinline__ void done(const Unit&) const {}
};

__device__ __forceinline__ unsigned cvt_pk_bf16(float lo, float hi) { unsigned r; asm volatile("v_cvt_pk_bf16_f32 %0, %1, %2" : "=v"(r) : "v"(lo), "v"(hi)); return r; }
typedef float f32x2 __attribute__((ext_vector_type(2)));

__device__ __forceinline__ float silu_f(float a) { return a / (1.0f + __expf(-a)); }
struct EpiPlain {
    static constexpr bool PERM = true, AFTER_DRAIN = false;
    bf16_t* O; int ldc; int pn_mask;
    __device__ __forceinline__ void operator()(const f32x4 (&acc)[2][2][4][2], const Unit& u, int wr, int wc, int fr, int fq) const {
        const int row0 = u.pm * BM + wr * 64 + fr; const int col0 = (u.pn & pn_mask) * BM + wc * 32 + 8 * fq;
#pragma unroll
        for (int ai = 0; ai < 2; ++ai)
#pragma unroll
            for (int m = 0; m < 4; ++m) { bf16_t* rowp = O + (size_t)(row0 + ai * HALF + m * 16) * ldc + col0;
#pragma unroll
                for (int bj = 0; bj < 2; ++bj) { const f32x4 v0 = acc[ai][bj][m][0], v1 = acc[ai][bj][m][1];
                    u32x4 w; w.x = cvt_pk_bf16(v0[0], v0[1]); w.y = cvt_pk_bf16(v0[2], v0[3]); w.z = cvt_pk_bf16(v1[0], v1[1]); w.w = cvt_pk_bf16(v1[2], v1[3]);
                    *(u32x4*)(rowp + bj * HALF) = w; } }
    }
};
struct EpiSwiGlu {
    static constexpr bool PERM = true, AFTER_DRAIN = false;
    bf16_t* O; int ldc;
    __device__ __forceinline__ void operator()(const f32x4 (&acc)[2][2][4][2], const Unit& u, int wr, int wc, int fr, int fq) const {
        const int row0 = u.pm * BM + wr * 64 + fr; const int col0 = (u.pn & 3) * HALF + wc * 32 + 8 * fq;
#pragma unroll
        for (int ai = 0; ai < 2; ++ai)
#pragma unroll
            for (int m = 0; m < 4; ++m) { bf16_t* rowp = O + (size_t)(row0 + ai * HALF + m * 16) * ldc + col0;
                const f32x4 a0 = acc[ai][0][m][0], a1 = acc[ai][0][m][1], b0 = acc[ai][1][m][0], b1 = acc[ai][1][m][1];
                u32x4 w; w.x = cvt_pk_bf16(silu_f(a0[0]) * b0[0], silu_f(a0[1]) * b0[1]); w.y = cvt_pk_bf16(silu_f(a0[2]) * b0[2], silu_f(a0[3]) * b0[3]);
                w.z = cvt_pk_bf16(silu_f(a1[0]) * b1[0], silu_f(a1[1]) * b1[1]); w.w = cvt_pk_bf16(silu_f(a1[2]) * b1[2], silu_f(a1[3]) * b1[3]);
                *(u32x4*)rowp = w; }
    }
};
struct EpiResid {
    static constexpr bool PERM = false, AFTER_DRAIN = false;
    const float* base; float* out; float alpha;
    __device__ __forceinline__ void operator()(const f32x4 (&acc)[2][2][4][2], const Unit& u, int wr, int wc, int fr, int fq) const {
        const int row0 = u.pm * BM + wr * 64 + fr; const int col0 = u.pn * BM + wc * 32 + 4 * fq;
#pragma unroll
        for (int ai = 0; ai < 2; ++ai)
#pragma unroll
            for (int m = 0; m < 4; ++m) { const size_t off = (size_t)(row0 + ai * HALF + m * 16) * 1024 + col0;
#pragma unroll
                for (int bj = 0; bj < 2; ++bj)
#pragma unroll
                    for (int n = 0; n < 2; ++n) { const f32x4 bs = *(const f32x4*)(base + off + bj * HALF + n * 16);
                        *(f32x4*)(out + off + bj * HALF + n * 16) = bs * alpha + acc[ai][bj][m][n]; } }
    }
};
struct MoeOrder {
    const PG8_LAS int* tab; int G, vc;
    __device__ __forceinline__ bool next(int i, Unit& u) const {
        const long L = (long)i * G + vc; const int nt = __builtin_amdgcn_readfirstlane(tab[0]); if (L >= (long)nt * 4) return false;
        const int pm = (int)(L >> 2); u.pm = pm; u.pn = __builtin_amdgcn_readfirstlane(tab[1 + pm]) * 4 + (int)(L & 3); return true;
    }
    __device__ __forceinline__ void a_ready(const Unit&) const {}
    __device__ __forceinline__ void done(const Unit&) const {}
};
template <class Epi, class Sched, bool ALIGN_EPI = false, bool SP2 = false>
__device__ __forceinline__ void gemm_phase(PG8_LAS unsigned char* lds, const Gemm g, const Sched& S, const Epi& E) {
    int tid_ = threadIdx.x; asm volatile("" : "+v"(tid_));
    const int tid = tid_, wid = __builtin_amdgcn_readfirstlane(tid >> 6), lane = tid & 63, wr = wid >> 2, wc = wid & 3, fr = lane & 15, fq = lane >> 4;
    const int K = g.K, nt = K / BK;
    unsigned voffA[2], voffB[2];
#pragma unroll
    for (int i = 0; i < 2; ++i) { int R, C; stage_rc(tid * 16 + i * 8192, R, C); const int Rb = Epi::PERM ? ((R & ~31) + perm32(R & 31)) : R;
        voffA[i] = (unsigned)(R * K + C) * 2u; voffB[i] = (unsigned)(Rb * K + C) * 2u; }
    const size_t kstep = (size_t)(BK * 2);
    const size_t hstep = (size_t)HALF * K * 2;
    const size_t tstep = 2 * hstep;
    const unsigned ldsw = (unsigned)wid * 1024u;
    const int aoff = lds_byte(wr * 64 + fr, fq * 8), boff = lds_byte(wc * 32 + fr, fq * 8);
#define PG8_SA(b, h) (((b) * 2 + (h)) * HTB)
#define PG8_SB(b, h) ((4 + (b) * 2 + (h)) * HTB)
#define PG8_STAGE(bufoff, gbase, voff) do { _Pragma("unroll") for (int _i = 0; _i < 2; ++_i) \
        __builtin_amdgcn_global_load_lds((const unsigned*)((const char*)(gbase) + (voff)[_i]), (PG8_LAS unsigned*)(lds + (bufoff) + ldsw + _i * 8192), 16, 0, 0); } while (0)
#define PG8_LDA(dst, b, h) do { _Pragma("unroll") for (int m = 0; m < 4; ++m) _Pragma("unroll") for (int k = 0; k < 2; ++k) dst[m][k] = *(const PG8_LAS bf16x8*)(lds + PG8_SA(b, h) + aoff + m * 2048 + k * 1024); } while (0)
#define PG8_LDB(dst, b, h) do { _Pragma("unroll") for (int n = 0; n < 2; ++n) _Pragma("unroll") for (int k = 0; k < 2; ++k) dst[n][k] = *(const PG8_LAS bf16x8*)(lds + PG8_SB(b, h) + boff + n * 2048 + k * 1024); } while (0)
#define PG8_MMA(ai, bj, At, Bt) do { __builtin_amdgcn_s_setprio(1); _Pragma("unroll") for (int m = 0; m < 4; ++m) _Pragma("unroll") for (int n = 0; n < 2; ++n) _Pragma("unroll") for (int k = 0; k < 2; ++k) \
        acc[ai][bj][m][n] = __builtin_amdgcn_mfma_f32_16x16x32_bf16(Bt[n][k], At[m][k], acc[ai][bj][m][n], 0, 0, 0); __builtin_amdgcn_s_setprio(0); } while (0)
#define PG8_WAIT_V(n) asm volatile("s_waitcnt vmcnt(" #n ")" ::: "memory")
#define PG8_WAIT_L(n) asm volatile("s_waitcnt lgkmcnt(" #n ")" ::: "memory")
#define PG8_BAR __builtin_amdgcn_s_barrier()
#define PG8_SCHED __builtin_amdgcn_sched_barrier(0)
    Unit cur, nxt; int ui = 0;
    if (!S.next(0, cur)) return;
    f32x4 acc[2][2][4][2];
#pragma unroll
    for (int a = 0; a < 2; ++a)
#pragma unroll
        for (int b = 0; b < 2; ++b)
#pragma unroll
            for (int m = 0; m < 4; ++m)
#pragma unroll
                for (int n = 0; n < 2; ++n) acc[a][b][m][n] = (f32x4){0.f, 0.f, 0.f, 0.f};
    bf16x8 At[4][2], B0[2][2], B1[2][2];
    const char* cA = (const char*)g.A + (size_t)cur.pm * tstep; const char* cB = (const char*)g.Bt + (size_t)cur.pn * tstep;
    S.a_ready(cur);
    if constexpr (SP2) {
        PG8_STAGE(PG8_SB(0, 0), cB, voffB); PG8_STAGE(PG8_SB(0, 1), cB + hstep, voffB); PG8_STAGE(PG8_SA(0, 0), cA, voffA); PG8_STAGE(PG8_SA(0, 1), cA + hstep, voffA);
        if (wr == 1) PG8_BAR;
        PG8_WAIT_V(2); PG8_BAR;
        PG8_STAGE(PG8_SB(1, 0), cB + kstep, voffB); PG8_STAGE(PG8_SA(1, 0), cA + kstep, voffA); PG8_STAGE(PG8_SB(1, 1), cB + hstep + kstep, voffB);
        PG8_WAIT_V(6); PG8_BAR;
    } else {
        PG8_STAGE(PG8_SB(0, 0), cB, voffB); PG8_STAGE(PG8_SA(0, 0), cA, voffA); PG8_STAGE(PG8_SB(0, 1), cB + hstep, voffB); PG8_STAGE(PG8_SA(0, 1), cA + hstep, voffA);
        if (wr == 1) PG8_BAR;
        PG8_WAIT_V(4); PG8_BAR;
        PG8_STAGE(PG8_SB(1, 0), cB + kstep, voffB); PG8_STAGE(PG8_SA(1, 0), cA + kstep, voffA); PG8_STAGE(PG8_SB(1, 1), cB + hstep + kstep, voffB);
        PG8_WAIT_V(6); PG8_BAR;
    }
    for (;;) {
        const bool has_next = S.next(ui + 1, nxt);
        const char* nA = has_next ? (const char*)g.A + (size_t)nxt.pm * tstep : cA; const char* nB = has_next ? (const char*)g.Bt + (size_t)nxt.pn * tstep : cB;
        for (int t = 0; t < nt; t += 2) {
            const bool last = (t == nt - 2);
            const char* a1 = cA + (size_t)(t + 1) * kstep;
            const char* a2 = last ? nA : cA + (size_t)(t + 2) * kstep; const char* b2 = last ? nB : cB + (size_t)(t + 2) * kstep;
            const char* a3 = a2 + kstep; const char* b3 = b2 + kstep;
            if (last && has_next) S.a_ready(nxt);
            if constexpr (SP2) {
            PG8_LDB(B0, 0, 0); PG8_LDB(B1, 0, 1); PG8_SCHED; PG8_LDA(At, 0, 0); PG8_STAGE(PG8_SA(1, 1), a1 + hstep, voffA);
            PG8_WAIT_V(8); PG8_WAIT_L(0); PG8_BAR; PG8_MMA(0, 0, At, B0); PG8_MMA(0, 1, At, B1); PG8_BAR; PG8_SCHED;
            PG8_LDA(At, 0, 1); PG8_STAGE(PG8_SB(0, 0), b2, voffB); PG8_STAGE(PG8_SB(0, 1), b2 + hstep, voffB); PG8_STAGE(PG8_SA(0, 0), a2, voffA);
            PG8_WAIT_V(8); PG8_WAIT_L(0); PG8_BAR; PG8_MMA(1, 0, At, B0); PG8_MMA(1, 1, At, B1); PG8_BAR; PG8_SCHED;
            PG8_LDB(B0, 1, 0); PG8_LDB(B1, 1, 1); PG8_SCHED; PG8_LDA(At, 1, 0); PG8_STAGE(PG8_SA(0, 1), a2 + hstep, voffA);
            PG8_WAIT_V(8); PG8_WAIT_L(0); PG8_BAR; PG8_MMA(0, 0, At, B0); PG8_MMA(0, 1, At, B1); PG8_BAR; PG8_SCHED;
            PG8_LDA(At, 1, 1); PG8_STAGE(PG8_SB(1, 0), b3, voffB); PG8_STAGE(PG8_SB(1, 1), b3 + hstep, voffB); PG8_STAGE(PG8_SA(1, 0), a3, voffA);
            PG8_WAIT_V(8); PG8_WAIT_L(0); PG8_BAR; PG8_MMA(1, 0, At, B0); PG8_MMA(1, 1, At, B1); PG8_BAR; PG8_SCHED;
            } else {
            PG8_LDB(B0, 0, 0); PG8_SCHED; PG8_LDA(At, 0, 0); PG8_STAGE(PG8_SA(1, 1), a1 + hstep, voffA);
            PG8_WAIT_L(8); PG8_BAR; PG8_WAIT_L(0); PG8_MMA(0, 0, At, B0); PG8_BAR; PG8_SCHED;
            PG8_LDB(B1, 0, 1); PG8_STAGE(PG8_SB(0, 0), b2, voffB);
            PG8_BAR; PG8_WAIT_L(0); PG8_MMA(0, 1, At, B1); PG8_BAR;
            PG8_LDA(At, 0, 1); PG8_STAGE(PG8_SA(0, 0), a2, voffA);
            PG8_BAR; PG8_WAIT_L(0); PG8_MMA(1, 0, At, B0); PG8_BAR; PG8_SCHED;
            PG8_STAGE(PG8_SB(0, 1), b2 + hstep, voffB);
            PG8_WAIT_V(6); PG8_BAR; PG8_MMA(1, 1, At, B1); PG8_BAR;
            PG8_LDB(B0, 1, 0); PG8_SCHED; PG8_LDA(At, 1, 0); PG8_STAGE(PG8_SA(0, 1), a2 + hstep, voffA);
            PG8_WAIT_L(8); PG8_BAR; PG8_WAIT_L(0); PG8_MMA(0, 0, At, B0); PG8_BAR; PG8_SCHED;
            PG8_LDB(B1, 1, 1); PG8_STAGE(PG8_SB(1, 0), b3, voffB);
            PG8_BAR; PG8_WAIT_L(0); PG8_MMA(0, 1, At, B1); PG8_BAR;
            PG8_LDA(At, 1, 1); PG8_STAGE(PG8_SA(1, 0), a3, voffA);
            PG8_BAR; PG8_WAIT_L(0); PG8_MMA(1, 0, At, B0); PG8_BAR; PG8_SCHED;
            PG8_STAGE(PG8_SB(1, 1), b3 + hstep, voffB);
            PG8_WAIT_V(6); PG8_BAR; PG8_MMA(1, 1, At, B1); PG8_BAR;
            }
        }
        if constexpr (ALIGN_EPI) { if (wr == 0) PG8_BAR; }
        if constexpr (!Epi::AFTER_DRAIN) { E(acc, cur, wr, wc, fr, fq); S.done(cur); }
        if (!has_next) break;
#pragma unroll
        for (int a = 0; a < 2; ++a)
#pragma unroll
            for (int b = 0; b < 2; ++b)
#pragma unroll
                for (int m = 0; m < 4; ++m)
#pragma unroll
                    for (int n = 0; n < 2; ++n) acc[a][b][m][n] = (f32x4){0.f, 0.f, 0.f, 0.f};
        cur = nxt; cA = nA; cB = nB; ++ui;
        if constexpr (ALIGN_EPI) { if (wr == 1) PG8_BAR; }
    }
    PG8_WAIT_V(0);
    if constexpr (!ALIGN_EPI) { if (wr == 0) PG8_BAR; }
    PG8_BAR;
    if constexpr (Epi::AFTER_DRAIN) { E.fused(acc, cur, wr, wc, fr, fq, lds, wid, lane); S.done(cur); }
#undef PG8_SA
#undef PG8_SB
#undef PG8_STAGE
#undef PG8_LDA
#undef PG8_LDB
#undef PG8_MMA
#undef PG8_WAIT_V
#undef PG8_WAIT_L
#undef PG8_BAR
#undef PG8_SCHED
}
}

#define LAS __attribute__((address_space(3)))
#define XB_TMO      128
#define XB_XCNT(j)  (256  + 64 * (j))
#define XB_XSUB(j)  (1280 + 64 * (j))
#define XB_XGEN(j)  (2304 + 64 * (j))
#define XB_TOP      3328
#define XB_TOPGEN   3392
#define XCD_BAR_WORDS 3456
#define XB_SPIN_CAP (1u << 22)

__device__ __forceinline__ unsigned xb_ld(unsigned* p)              { return __hip_atomic_load(p, __ATOMIC_RELAXED, __HIP_MEMORY_SCOPE_AGENT); }
__device__ __forceinline__ unsigned xb_add(unsigned* p, unsigned v) { return __hip_atomic_fetch_add(p, v, __ATOMIC_RELAXED, __HIP_MEMORY_SCOPE_AGENT); }
__device__ __forceinline__ unsigned xb_xcc_id() { return (unsigned)__builtin_amdgcn_s_getreg((3 << 11) | 20) & 0xFu; }
#define XB_SPIN(cond, bar) do { unsigned _sp = 0; while (cond) { __builtin_amdgcn_s_sleep(1); \
    if ((++_sp & 255u) == 0u) { if (xb_ld(&(bar)[XB_TMO])) break; if (_sp > XB_SPIN_CAP) { atomicAdd(&(bar)[XB_TMO], 1u); break; } } } } while (0)

struct XcdBarrier {
    unsigned* bar; unsigned x;
    volatile LAS unsigned* st;
};

__device__ __forceinline__ XcdBarrier xcd_barrier_post(unsigned* bar, volatile LAS unsigned* st) {
    XcdBarrier b; b.bar = bar; b.x = xb_xcc_id(); b.st = st;
    if (threadIdx.x == 0) (void)xb_add(&bar[XB_XCNT(b.x)], 1u);
    return b;
}
__device__ __forceinline__ void xcd_barrier_complete(unsigned* bar, unsigned x, unsigned& nloc, unsigned& nx) {
    const unsigned G = gridDim.x * gridDim.y * gridDim.z;
    unsigned sum, cnt, mine, sp = 0u;
    for (;;) {
        sum = 0u; cnt = 0u; mine = 0u;
#pragma unroll
        for (unsigned j = 0; j < 16; ++j) { const unsigned c = xb_ld(&bar[XB_XCNT(j)]); sum += c; cnt += (c > 0u) ? 1u : 0u; mine = (j == x) ? c : mine; }
        if (sum == G) break;
        __builtin_amdgcn_s_sleep(1);
        if ((++sp & 255u) == 0u) { if (xb_ld(&bar[XB_TMO])) break; if (sp > XB_SPIN_CAP) { atomicAdd(&bar[XB_TMO], 1u); break; } }
    }
    nloc = mine > 0u ? mine : 1u; nx = cnt > 0u ? cnt : 1u;
}

__device__ __forceinline__ void xcd_barrier(const XcdBarrier& b) {
    asm volatile("s_waitcnt vmcnt(0)" ::: "memory");
    __syncthreads();
    if (threadIdx.x == 0) {
        unsigned* bar = b.bar;
        __builtin_amdgcn_s_waitcnt(0);
        unsigned nloc = b.st[0], nx = b.st[1];
        if (nloc == 0u) { xcd_barrier_complete(bar, b.x, nloc, nx); b.st[0] = nloc; b.st[1] = nx; }
        const unsigned old = xb_add(&bar[XB_XSUB(b.x)], 1u);
        const unsigned gen = old / nloc;
        if (old + 1u == (gen + 1u) * nloc) {
            __builtin_amdgcn_fence(__ATOMIC_RELEASE, "agent");
            asm volatile("s_waitcnt vmcnt(0)" ::: "memory");
            const unsigned og = xb_add(&bar[XB_TOP], 1u);
            const unsigned tg = og / nx;
            if (og + 1u == (tg + 1u) * nx) xb_add(&bar[XB_TOPGEN], 1u);
            else XB_SPIN(xb_ld(&bar[XB_TOPGEN]) == tg, bar);
            __builtin_amdgcn_fence(__ATOMIC_ACQUIRE, "agent");
            xb_add(&bar[XB_XGEN(b.x)], 1u);
            asm volatile("s_waitcnt vmcnt(0)" ::: "memory");
        } else {
            XB_SPIN(xb_ld(&bar[XB_XGEN(b.x)]) == gen, bar);
            __builtin_amdgcn_fence(__ATOMIC_ACQUIRE, "agent");
            asm volatile("s_waitcnt vmcnt(0)" ::: "memory");
        }
    }
    __syncthreads();
}

constexpr int NWAVES = 8;
constexpr int BATCH = 8, SEQ = 4096, D = 1024, T = BATCH * SEQ, DEPTH = 4;
constexpr int NQKV = 3072, NH4 = 4096, NEXP = 32, FEXP = 512;
constexpr int MAX_TILES = 288;
constexpr float ALPHA = 1.6817928305074292f;
constexpr float LN_EPS = 1e-5f, RMS_EPS = 1e-6f;
constexpr size_t MiB = 1u << 20;
constexpr size_t WS_CTL = 0, CTL_ZERO_BYTES = 1 * MiB;
constexpr size_t WS_ROPE = 1 * MiB;
constexpr size_t WS_LB = 1 * MiB + 256 * 1024;
constexpr size_t WS_KMEAN = 1 * MiB + 512 * 1024;
constexpr size_t WS_RE = 2 * MiB;
constexpr size_t WS_RW = 2 * MiB + 256 * 1024;
constexpr size_t WS_POS = 2 * MiB + 512 * 1024;
constexpr size_t WS_X = 8 * MiB;
constexpr size_t WS_XB = 136 * MiB;
constexpr size_t WS_WIN = 200 * MiB, WS_WOUT = 208 * MiB, WS_W13 = 210 * MiB, WS_W2 = 274 * MiB;
constexpr size_t WS_MIX = 306 * MiB;
constexpr size_t WS_O = 562 * MiB;
constexpr size_t WS_QF = 626 * MiB, WS_KF = 690 * MiB, WS_VF = 754 * MiB;
constexpr size_t WS_INTRA = 818 * MiB, WS_INTER = 882 * MiB;
constexpr size_t WS_DEC = 946 * MiB;
constexpr size_t WS_XG = 306 * MiB, WS_HB = 450 * MiB, WS_YB = 522 * MiB;
constexpr size_t WS_END = 950 * MiB;
constexpr int CW_BAR = 4096;
constexpr int CW_CNT = 16384;
constexpr int CW_CUR = 16384 + 512;
constexpr int RING_BYTES = 131072, LDS_BYTES = 163840, MISC_OFF = LDS_BYTES - 4096;

#define GAS __attribute__((address_space(1)))
typedef unsigned short bf16;
typedef unsigned v4u __attribute__((ext_vector_type(4)));
typedef unsigned v2u __attribute__((ext_vector_type(2)));
typedef float f32x4 __attribute__((ext_vector_type(4)));
#define LDS_WAIT() asm volatile("s_waitcnt lgkmcnt(0)" ::: "memory")
__device__ __forceinline__ unsigned f2bf(float f) { unsigned u = __builtin_bit_cast(unsigned, f); return (u + 0x7fffu + ((u >> 16) & 1u)) >> 16; }
__device__ __forceinline__ unsigned pk2(float lo, float hi) { return f2bf(lo) | (f2bf(hi) << 16); }
__device__ __forceinline__ float bf2f(unsigned short b) { return __builtin_bit_cast(float, (unsigned)b << 16); }
__device__ __forceinline__ float bflo(unsigned w) { return __builtin_bit_cast(float, w << 16); }
__device__ __forceinline__ float bfhi(unsigned w) { return __builtin_bit_cast(float, w & 0xffff0000u); }
__device__ __forceinline__ float wave_sum(float v) {
#pragma unroll
    for (int o = 1; o < 64; o <<= 1) v += __shfl_xor(v, o);
    return v;
}

struct Frame {
    LAS unsigned char* lds;
    volatile LAS unsigned* MISC;
    unsigned char* ws;
    int tid, lane, wave, gw, NGW, G;
};
__device__ __forceinline__ const float* in_ptr(const Frame& F, int i) {
    const unsigned lo = __builtin_amdgcn_readfirstlane(F.MISC[512 + 2 * i]), hi = __builtin_amdgcn_readfirstlane(F.MISC[513 + 2 * i]);
    return (const float*)(((unsigned long long)hi << 32) | lo);
}
#define LAUNDER_WS() unsigned char* ws = F.ws; int bx = blockIdx.x; asm volatile("" : "+s"(ws), "+s"(bx))
#define PHASE_BEGIN() unsigned char* ws = F.ws; int tid = threadIdx.x, bx = blockIdx.x; asm volatile("" : "+s"(ws), "+v"(tid), "+s"(bx)); const int lane = tid & 63, gw = bx * NWAVES + __builtin_amdgcn_readfirstlane(tid >> 6); (void)tid; (void)gw; (void)lane; (void)bx
__device__ __forceinline__ void transpose_item(const float* W, int K, int N, bf16* WT, int k0, int n0, size_t dst_row0, LAS float* scr, int lane) {
#pragma unroll 8
    for (int i = 0; i < 32; ++i) { const int kk = 2 * i + (lane >> 5); scr[kk * 33 + (lane & 31)] = W[(size_t)(k0 + kk) * N + n0 + (lane & 31)]; }
    LDS_WAIT(); asm volatile("" ::: "memory");
    const int c = lane & 7;
#pragma unroll
    for (int j = 0; j < 4; ++j) { const int n = (lane >> 3) + 8 * j; const LAS float* s = scr + (8 * c) * 33 + n;
        v4u o; o.x = pk2(s[0 * 33], s[1 * 33]); o.y = pk2(s[2 * 33], s[3 * 33]); o.z = pk2(s[4 * 33], s[5 * 33]); o.w = pk2(s[6 * 33], s[7 * 33]);
        *(v4u*)(WT + (dst_row0 + n) * (size_t)K + k0 + 8 * c) = o; }
    LDS_WAIT(); asm volatile("" ::: "memory");
}
__device__ __forceinline__ void convert_weights(Frame& F, int l) {
    PHASE_BEGIN();
    LAS float* scr = (LAS float*)(F.lds + F.wave * 16384);
    const int j = l >> 1; const bool even = (l & 1) == 0;
    const int Nin = even ? NQKV : NH4;
    const float* Win = even ? in_ptr(F, 1) + (size_t)j * D * NQKV : in_ptr(F, 3) + (size_t)j * D * NH4;
    const float* Wout = even ? in_ptr(F, 2) + (size_t)j * D * D : in_ptr(F, 4) + (size_t)j * D * D;
    const int I_in = 16 * (Nin / 32), I_out = 16 * 32, I_13 = 64 * 256, I_2 = 32 * 256;
    const int NIT = I_in + I_out + I_13 + I_2;
    for (int it = gw; it < NIT; it += F.NGW) {
        int r = it;
        if (r < I_in) { const int nb = Nin / 32, kb = r / nb, n0 = (r % nb) * 32; transpose_item(Win, D, Nin, (bf16*)(ws + WS_WIN), kb * 64, n0, (size_t)n0, scr, lane); continue; } r -= I_in;
        if (r < I_out) { const int kb = r / 32, n0 = (r % 32) * 32; transpose_item(Wout, D, D, (bf16*)(ws + WS_WOUT), kb * 64, n0, (size_t)n0, scr, lane); continue; } r -= I_out;
        if (r < I_13) { const int mat = r >> 8, e = mat >> 1, which = mat & 1, q = r & 255, kb = q >> 4, n0 = (q & 15) * 32;
            const float* W = in_ptr(F, which ? 14 : 13) + (size_t)(l * NEXP + e) * D * FEXP;
            transpose_item(W, D, FEXP, (bf16*)(ws + WS_W13), kb * 64, n0, (size_t)e * 1024 + (size_t)(n0 >> 7) * 256 + (n0 & 127) + which * 128, scr, lane); continue; } r -= I_13;
        { const int e = r >> 8, q = r & 255, kb = q >> 5, n0 = (q & 31) * 32;
            const float* W = in_ptr(F, 15) + (size_t)(l * NEXP + e) * FEXP * D;
            transpose_item(W, FEXP, D, (bf16*)(ws + WS_W2), kb * 64, n0, (size_t)e * 1024 + n0, scr, lane); }
    }
}

__device__ __forceinline__ void prologue(Frame& F) {
    PHASE_BEGIN();
    const float* x = in_ptr(F, 0); bf16* xb = (bf16*)(ws + WS_XB);
    for (int m = gw; m < T; m += F.NGW) {
        const f32x4* xr = (const f32x4*)(x + (size_t)m * D) + lane; v2u* o8 = (v2u*)(xb + (size_t)m * D) + lane;
#pragma unroll
        for (int j = 0; j < 4; ++j) { const f32x4 v = xr[64 * j]; v2u o; o.x = pk2(v.x, v.y); o.y = pk2(v.z, v.w); o8[64 * j] = o; }
    }
    float* rope = (float*)(ws + WS_ROPE);
    const int gt = gw * 64 + lane, NGT = F.NGW * 64;
    for (int idx = gt; idx < SEQ * 8; idx += NGT) { const int pos = idx >> 3, i = idx & 7;
        const float inv = powf(500000.0f, -(float)i / 8.0f); const float ang = (float)pos * inv;
        rope[pos * 16 + i] = cosf(ang); rope[pos * 16 + 8 + i] = sinf(ang); }
    float* lb = (float*)(ws + WS_LB);
    for (int idx = gt; idx < D; idx += NGT) { const float l0 = in_ptr(F, 6)[idx], l1 = in_ptr(F, 6)[D + idx];
        lb[idx] = 0.f; lb[D + idx] = 1.0f / (1.0f + expf(l0 - l1)); }
}

__device__ __forceinline__ void rope_phase(Frame& F) {
    PHASE_BEGIN();
    bf16* qkv = (bf16*)(ws + WS_MIX); const float* rope = (const float*)(ws + WS_ROPE);
    const int gt = gw * 64 + lane, NGT = F.NGW * 64;
    for (int idx = gt; idx < T * 256; idx += NGT) { const int row = idx >> 8, rh = (idx >> 3) & 31, i = idx & 7, pos = row & (SEQ - 1);
        const int col = (rh < 16 ? rh * 64 : 1536 + (rh - 16) * 64) + i;
        bf16* p = qkv + (size_t)row * NQKV + col;
        const float x1 = bf2f(p[0]), x2 = bf2f(p[8]), c = rope[pos * 16 + i], s = rope[pos * 16 + 8 + i];
        p[0] = (bf16)f2bf(x1 * c - x2 * s); p[8] = (bf16)f2bf(x2 * c + x1 * s); }
}
__device__ __forceinline__ void kmean_phase(Frame& F) {
    PHASE_BEGIN();
    const bf16* qkv = (const bf16*)(ws + WS_MIX); float* km = (float*)(ws + WS_KMEAN);
    const int gt = gw * 64 + lane, NGT = F.NGW * 64;
    for (int idx = gt; idx < BATCH * 8 * 16 * 64; idx += NGT) { const int d = idx & 63, blk = (idx >> 6) & 15, h = (idx >> 10) & 7, b = idx >> 13;
        const bf16* p = qkv + (size_t)(b * SEQ + blk * 256) * NQKV + 512 + h * 64 + d; float s = 0.f;
        for (int j = 0; j < 256; ++j) s += bf2f(p[(size_t)j * NQKV]);
        km[idx] = s * (1.0f / 256.0f); }
}


typedef float f32x16 __attribute__((ext_vector_type(16)));
typedef short s16x4 __attribute__((ext_vector_type(4)));
typedef short bf16x8v __attribute__((ext_vector_type(8)));
typedef float f32x2_t __attribute__((ext_vector_type(2))); typedef __bf16 bf16x2_t __attribute__((ext_vector_type(2)));
__device__ __forceinline__ unsigned cvtpk_s(float lo, float hi) { f32x2_t v = {lo, hi}; bf16x2_t b = __builtin_convertvector(v, bf16x2_t); return __builtin_bit_cast(unsigned, b); }
__device__ __forceinline__ int crow(int r, int hi) { return (r & 3) + 8 * (r >> 2) + 4 * hi; }
constexpr float ATT_C2 = 0.125f * 1.4426950408889634f;
__device__ __forceinline__ s16x4 lds_tr(LAS unsigned char* p) { typedef short v4i16_t __attribute__((ext_vector_type(4))); return __builtin_bit_cast(s16x4, __builtin_amdgcn_ds_read_tr16_b64_v4i16((LAS v4i16_t*)p)); }

template <int NS>
__device__ __forceinline__ void softmax_step(f32x16 (&p)[NS], float& m, float& l, f32x16 (&o)[2], bf16x8v (&pf)[NS][2]) {
    float mx = p[0][0];
#pragma unroll
    for (int s = 0; s < NS; ++s)
#pragma unroll
        for (int r = 0; r < 16; ++r) mx = fmaxf(mx, p[s][r]);
    mx = fmaxf(mx, __shfl_xor(mx, 32));
    const float mn = fmaxf(m, mx * ATT_C2);
    const float alpha = __builtin_amdgcn_exp2f(m - mn);
    m = mn; float sum = 0.f;
#pragma unroll
    for (int s = 0; s < NS; ++s)
#pragma unroll
        for (int r = 0; r < 16; ++r) { const float e = __builtin_amdgcn_exp2f(p[s][r] * ATT_C2 - mn); p[s][r] = e; sum += e; }
    l = l * alpha + sum;
    if (!__all(alpha == 1.0f)) {
#pragma unroll
        for (int d0 = 0; d0 < 2; ++d0)
#pragma unroll
            for (int r = 0; r < 16; ++r) o[d0][r] *= alpha;
    }
#pragma unroll
    for (int s = 0; s < NS; ++s)
#pragma unroll
        for (int k = 0; k < 2; ++k) { union { unsigned u[4]; bf16x8v v; } t;
#pragma unroll
            for (int j = 0; j < 4; ++j) t.u[j] = cvtpk_s(p[s][8 * k + 2 * j], p[s][8 * k + 2 * j + 1]);
            pf[s][k] = t.v; }
}
template <int NS>
__device__ __forceinline__ void pv_step(LAS unsigned char* vbase, const unsigned (&vb)[2], const bf16x8v (&pf)[NS][2], f32x16 (&o)[2]) {
#pragma unroll
    for (int ks = 0; ks < 2 * NS; ++ks)
#pragma unroll
        for (int d0 = 0; d0 < 2; ++d0) { const s16x4 lo = lds_tr(vbase + vb[d0] + ks * 2048), hi = lds_tr(vbase + vb[d0] + ks * 2048 + 1024);
            const bf16x8v vf = {lo[0], lo[1], lo[2], lo[3], hi[0], hi[1], hi[2], hi[3]};
            o[d0] = __builtin_amdgcn_mfma_f32_32x32x16_bf16(vf, pf[ks >> 1][ks & 1], o[d0], 0, 0, 0); }
}
__device__ __forceinline__ void store_ot(bf16* orow  , const f32x16 (&o)[2], float rl, int hi) {
#pragma unroll
    for (int d0 = 0; d0 < 2; ++d0)
#pragma unroll
        for (int rg = 0; rg < 4; ++rg) { v2u w; w.x = cvtpk_s(o[d0][4 * rg] * rl, o[d0][4 * rg + 1] * rl); w.y = cvtpk_s(o[d0][4 * rg + 2] * rl, o[d0][4 * rg + 3] * rl);
            *(v2u*)(orow + 32 * d0 + 8 * rg + 4 * hi) = w; }
}

constexpr int AL_KM = 0, AL_K = 4096, AL_V = 20480, AL_WV = 40960;
__device__ __forceinline__ void attn_fast_phase(Frame& F) {
    PHASE_BEGIN();
    const bf16* qkv = (const bf16*)(ws + WS_MIX); bf16* O = (bf16*)(ws + WS_O); const float* km = (const float*)(ws + WS_KMEAN);
    LAS unsigned char* L = F.lds;
    const int wid = __builtin_amdgcn_readfirstlane(tid >> 6), q = lane & 31, hi = lane >> 5;
    unsigned vb[2];
    { const int i = lane & 15, g1 = (lane >> 4) & 1, sw = (lane >> 3) & 1;
      const unsigned base = (unsigned)((4 * hi + (i >> 2)) * 128 + (2 * g1 + ((i >> 1) & 1)) * 16 + (i & 1) * 8);
      vb[0] = base + (unsigned)((0 ^ sw) * 64); vb[1] = base + (unsigned)((1 ^ sw) * 64); }
    for (int k4 = 0; k4 < 4; ++k4) {
        const int bh = bx >> 2, s4 = bx & 3, own = (k4 == 0) ? s4 : (k4 == 1) ? 7 - s4 : (k4 == 2) ? 8 + s4 : 15 - s4;
        if (bh >= 64) break;
        const int b = bh >> 3, h = bh & 7; const size_t rowbase = (size_t)b * SEQ;
        const int qrel = 32 * wid + q, tq = 256 * own + qrel;
        bf16x8v qr[4];
#pragma unroll
        for (int d0 = 0; d0 < 4; ++d0) qr[d0] = *(const bf16x8v*)(qkv + (rowbase + tq) * NQKV + h * 64 + 16 * d0 + 8 * hi);
        if (tid < 256) ((LAS f32x4*)(L + AL_KM))[tid] = ((const f32x4*)(km + (size_t)bh * 1024))[tid];
        const int srow = tid >> 3, sch = tid & 7;
        const bf16* kg = qkv + rowbase * NQKV + 512 + h * 64 + sch * 8 + (size_t)srow * NQKV; const bf16* vg = kg + 512;
        const unsigned kst = (unsigned)(srow * 128 + ((sch ^ ((srow >> 1) & 7)) << 4)), vst = (unsigned)(srow * 128 + ((sch ^ (((srow >> 1) & 1) << 2)) << 4));
        const int NT = 4 + 4 * own;
        v4u rk = *(const v4u*)(kg + (size_t)(256 * own) * NQKV), rv = *(const v4u*)(vg + (size_t)(256 * own) * NQKV);
        *(LAS v4u*)(L + AL_K + kst) = rk; *(LAS v4u*)(L + AL_V + vst) = rv;
        __syncthreads();
        unsigned selmask = 0u;
        { float g[16];
#pragma unroll
          for (int n = 0; n < 16; ++n) { g[n] = -INFINITY;
              if (n < own) { float s = 0.f; const LAS float* kp = (const LAS float*)(L + AL_KM) + n * 64 + 8 * hi;
#pragma unroll
                  for (int d0 = 0; d0 < 4; ++d0)
#pragma unroll
                      for (int jj = 0; jj < 8; ++jj) s += bf2f((unsigned short)qr[d0][jj]) * kp[16 * d0 + jj];
                  g[n] = s + __shfl_xor(s, 32); } }
          const int nsel = own < 3 ? own : 3;
          for (int s = 0; s < nsel; ++s) { float best = -INFINITY; int bi = 0;
#pragma unroll
              for (int n = 0; n < 16; ++n) if (!((selmask >> n) & 1u) && g[n] > best) { best = g[n]; bi = n; }
              selmask |= 1u << bi; } }
        float m = -1e30f, l = 0.f; f32x16 o[2]; o[0] = f32x16{}; o[1] = f32x16{};
        for (int idx = 0; idx < NT; ++idx) {
            const int cur = idx & 1; const bool more = idx + 1 < NT;
            if (more) { const int nx = idx + 1; const int key0 = nx < 4 ? 256 * own + 64 * nx : 256 * ((nx - 4) >> 2) + 64 * ((nx - 4) & 3);
                rk = *(const v4u*)(kg + (size_t)key0 * NQKV); rv = *(const v4u*)(vg + (size_t)key0 * NQKV); }
            bool act; int pastn = -1, jt = idx;
            if (idx < 4) act = (idx <= (wid >> 1)); else { pastn = (idx - 4) >> 2; jt = (idx - 4) & 3; act = __any((selmask >> pastn) & 1u) != 0; }
            if (act) {
                LAS unsigned char* Kt = L + AL_K + cur * 8192; LAS unsigned char* Vt = L + AL_V + cur * 8192;
                f32x16 p[2];
#pragma unroll
                for (int sub = 0; sub < 2; ++sub) { const int row = 32 * sub + q; f32x16 acc = f32x16{};
#pragma unroll
                    for (int d0 = 0; d0 < 4; ++d0) { const bf16x8v kf = *(const LAS bf16x8v*)(Kt + row * 128 + (((2 * d0 + hi) ^ ((row >> 1) & 7)) << 4));
                        acc = __builtin_amdgcn_mfma_f32_32x32x16_bf16(kf, qr[d0], acc, 0, 0, 0); }
                    p[sub] = acc; }
                if (idx < 4) {
#pragma unroll
                    for (int sub = 0; sub < 2; ++sub)
#pragma unroll
                        for (int r = 0; r < 16; ++r) if (64 * jt + 32 * sub + crow(r, hi) > qrel) p[sub][r] = -INFINITY;
                } else if (!((selmask >> pastn) & 1u)) {
#pragma unroll
                    for (int sub = 0; sub < 2; ++sub)
#pragma unroll
                        for (int r = 0; r < 16; ++r) p[sub][r] = -INFINITY;
                }
                bf16x8v pf[2][2];
                softmax_step<2>(p, m, l, o, pf);
                pv_step<2>(Vt, vb, pf, o);
            }
            if (more) { *(LAS v4u*)(L + AL_K + (cur ^ 1) * 8192 + kst) = rk; *(LAS v4u*)(L + AL_V + (cur ^ 1) * 8192 + vst) = rv; }
            __syncthreads();
        }
        { const float lt = l + __shfl_xor(l, 32); store_ot(O + (rowbase + tq) * D + h * 64, o, 1.0f / lt, hi); }
    }
    {
        LAS unsigned char* Vt = L + AL_WV + wid * 4096;
        const int vch = lane & 7, vr0 = lane >> 3;
        for (int task = gw; task < BATCH * 8 * 16 * 8; task += F.NGW) {
            const int iw = task & 7, r16 = (task >> 3) & 15, h = (task >> 7) & 7, b = task >> 10;
            const size_t rowbase = (size_t)b * SEQ; const int tlo = r16 + 512 * iw, tq = tlo + 16 * q;
            const bf16* Kb = qkv + rowbase * NQKV + 2048 + h * 64; const bf16* Vb = qkv + rowbase * NQKV + 2560 + h * 64;
            bf16x8v qr[4];
#pragma unroll
            for (int d0 = 0; d0 < 4; ++d0) qr[d0] = *(const bf16x8v*)(qkv + (rowbase + tq) * NQKV + 1536 + h * 64 + 16 * d0 + 8 * hi);
            float m = -1e30f, l = 0.f; f32x16 o[2]; o[0] = f32x16{}; o[1] = f32x16{};
            for (int br = 0; br < 3; ++br) {
                const int stride = br == 0 ? 1 : (br == 1 ? 4 : 16), W = 128 * stride, ntile = br == 0 ? 20 : (br == 1 ? 8 : 5);
                const int kbase = tlo - W;
                for (int kt = 0; kt < ntile; ++kt) {
                    const int k0 = kbase + 32 * kt * stride;
                    if (k0 + 31 * stride < 0) continue;
                    int kp = k0 + q * stride; kp = kp < 0 ? 0 : (kp > SEQ - 1 ? SEQ - 1 : kp);
                    bf16x8v kf[4];
#pragma unroll
                    for (int d0 = 0; d0 < 4; ++d0) kf[d0] = *(const bf16x8v*)(Kb + (size_t)kp * NQKV + 16 * d0 + 8 * hi);
                    v4u vv[4];
#pragma unroll
                    for (int jj = 0; jj < 4; ++jj) { int vp = k0 + (vr0 + 8 * jj) * stride; vp = vp < 0 ? 0 : (vp > SEQ - 1 ? SEQ - 1 : vp); vv[jj] = *(const v4u*)(Vb + (size_t)vp * NQKV + vch * 8); }
                    f32x16 p[1]; p[0] = f32x16{};
#pragma unroll
                    for (int d0 = 0; d0 < 4; ++d0) p[0] = __builtin_amdgcn_mfma_f32_32x32x16_bf16(kf[d0], qr[d0], p[0], 0, 0, 0);
#pragma unroll
                    for (int r = 0; r < 16; ++r) { const int pos = k0 + crow(r, hi) * stride, dist = tq - pos; if (pos < 0 || dist < 0 || dist > W) p[0][r] = -INFINITY; }
#pragma unroll
                    for (int jj = 0; jj < 4; ++jj) { const int row = vr0 + 8 * jj; *(LAS v4u*)(Vt + row * 128 + ((vch ^ (((row >> 1) & 1) << 2)) << 4)) = vv[jj]; }
                    bf16x8v pf[1][2];
                    softmax_step<1>(p, m, l, o, pf);
                    pv_step<1>(Vt, vb, pf, o);
                }
            }
            { const float lt = l + __shfl_xor(l, 32); store_ot(O + (rowbase + tq) * D + 512 + h * 64, o, 1.0f / lt, hi); }
        }
    }
}


constexpr int HL_QS = 0, HL_KS = 17408, HL_KT = 34816, HL_VT = 53248, HL_SEG = 71680;
__device__ __forceinline__ void hgrn_h1_phase(Frame& F, int j) {
    PHASE_BEGIN();
    const bf16* H = (const bf16*)(ws + WS_MIX); const float* lbp = (const float*)(ws + WS_LB) + (size_t)j * D;
    bf16* INTRA = (bf16*)(ws + WS_INTRA); unsigned char* QF = ws + WS_QF; unsigned char* KF = ws + WS_KF; unsigned char* VF = ws + WS_VF; float* DEC = (float*)(ws + WS_DEC);
    LAS unsigned char* L = F.lds;
    const int wid = __builtin_amdgcn_readfirstlane(tid >> 6), q = lane & 31, hi = lane >> 5;
    const int d = tid & 127, tq4 = tid >> 7;
    for (int unit = bx; unit < BATCH * 8 * 64; unit += F.G) {
        const int c = unit & 63, bh = unit >> 6, b = bh >> 3, h = bh & 7;
        const size_t row0 = (size_t)b * SEQ + 64 * c;
        const float lbv = lbp[h * 128 + d];
        const bf16* hp = H + (row0 + 16 * tq4) * NH4 + h * 128 + d;
        unsigned short rq[16], rz[16], rv[16];
#pragma unroll
        for (int k = 0; k < 16; ++k) { rq[k] = hp[(size_t)k * NH4]; rz[k] = hp[(size_t)k * NH4 + 1024]; rv[k] = hp[(size_t)k * NH4 + 2048]; }
        float bb[16], kk[16]; float run = 0.f;
#pragma unroll
        for (int k = 0; k < 16; ++k) { const float z = bf2f(rz[k]); const float sg = 1.0f / (1.0f + __expf(-z)); const float f = lbv + (1.0f - lbv) * sg;
            kk[k] = (1.0f - lbv) * (1.0f - sg); run += logf(f); bb[k] = run; }
        ((LAS float*)(L + HL_SEG))[tq4 * 128 + d] = run;
        { v4u w0, w1; w0.x = rv[0] | ((unsigned)rv[1] << 16); w0.y = rv[2] | ((unsigned)rv[3] << 16); w0.z = rv[4] | ((unsigned)rv[5] << 16); w0.w = rv[6] | ((unsigned)rv[7] << 16);
          w1.x = rv[8] | ((unsigned)rv[9] << 16); w1.y = rv[10] | ((unsigned)rv[11] << 16); w1.z = rv[12] | ((unsigned)rv[13] << 16); w1.w = rv[14] | ((unsigned)rv[15] << 16);
          *(LAS v4u*)(L + HL_VT + d * 144 + tq4 * 32) = w0; *(LAS v4u*)(L + HL_VT + d * 144 + tq4 * 32 + 16) = w1; }
        __syncthreads();
        { const LAS float* sg_ = (const LAS float*)(L + HL_SEG) + d; const float s0 = sg_[0], s1 = sg_[128], s2 = sg_[256], s3 = sg_[384];
          const float pre = (tq4 > 0 ? s0 : 0.f) + (tq4 > 1 ? s1 : 0.f) + (tq4 > 2 ? s2 : 0.f); const float bref = s0 + s1, blast = (s0 + s1) + (s2 + s3);
          unsigned kt[8];
#pragma unroll
          for (int k = 0; k < 16; ++k) { const float bk = pre + bb[k]; const float e1 = __expf(bk - bref), e2 = __expf(bref - bk), e3 = __expf(blast - bk);
              const int t = 16 * tq4 + k;
              *(LAS unsigned short*)(L + HL_QS + t * 272 + d * 2) = (unsigned short)f2bf(bf2f(rq[k]) * e1);
              *(LAS unsigned short*)(L + HL_KS + t * 272 + d * 2) = (unsigned short)f2bf(kk[k] * e2);
              const unsigned kb = f2bf(kk[k] * e3); if (k & 1) kt[k >> 1] |= kb << 16; else kt[k >> 1] = kb; }
          { v4u w0, w1; w0.x = kt[0]; w0.y = kt[1]; w0.z = kt[2]; w0.w = kt[3]; w1.x = kt[4]; w1.y = kt[5]; w1.z = kt[6]; w1.w = kt[7];
            *(LAS v4u*)(L + HL_KT + d * 144 + tq4 * 32) = w0; *(LAS v4u*)(L + HL_KT + d * 144 + tq4 * 32 + 16) = w1; }
          if (tq4 == 0) { DEC[(size_t)unit * 256 + d] = __expf(blast); DEC[(size_t)unit * 256 + 128 + d] = __expf(bref); } }
        __syncthreads();
        { const int et = wid & 3, ti = wid >> 2; f32x16 intra = f32x16{};
          for (int tj = 0; tj <= ti; ++tj) { f32x16 acc = f32x16{};
#pragma unroll
              for (int s = 0; s < 8; ++s) { const bf16x8v kf = *(const LAS bf16x8v*)(L + HL_KS + (32 * tj + q) * 272 + (16 * s + 8 * hi) * 2), qf = *(const LAS bf16x8v*)(L + HL_QS + (32 * ti + q) * 272 + (16 * s + 8 * hi) * 2);
                  acc = __builtin_amdgcn_mfma_f32_32x32x16_bf16(kf, qf, acc, 0, 0, 0); }
              if (tj == ti) {
#pragma unroll
                  for (int r = 0; r < 16; ++r) if (crow(r, hi) > q) acc[r] = 0.f;
              }
#pragma unroll
              for (int s2 = 0; s2 < 2; ++s2) { union { unsigned u[4]; bf16x8v v; } pk;
#pragma unroll
                  for (int jj = 0; jj < 4; ++jj) pk.u[jj] = cvtpk_s(acc[8 * s2 + 2 * jj], acc[8 * s2 + 2 * jj + 1]);
                  const LAS unsigned char* vp = L + HL_VT + (32 * et + q) * 144 + (32 * tj + 16 * s2 + 4 * hi) * 2;
                  union { v2u u2[2]; bf16x8v v; } vf; vf.u2[0] = *(const LAS v2u*)vp; vf.u2[1] = *(const LAS v2u*)(vp + 16);
                  intra = __builtin_amdgcn_mfma_f32_32x32x16_bf16(vf.v, pk.v, intra, 0, 0, 0); } }
          bf16* op = INTRA + (row0 + 32 * ti + q) * D + h * 128 + 32 * et;
#pragma unroll
          for (int rg = 0; rg < 4; ++rg) { v2u w; w.x = cvtpk_s(intra[4 * rg], intra[4 * rg + 1]); w.y = cvtpk_s(intra[4 * rg + 2], intra[4 * rg + 3]); *(v2u*)(op + 8 * rg + 4 * hi) = w; } }
#pragma unroll
        for (int k6 = 0; k6 < 6; ++k6) { const int fi = wid + 8 * k6; v4u w;
            if (fi < 16) { const int ti = fi >> 3, Ts = fi & 7;
                const LAS unsigned char* p = L + HL_QS + (32 * ti + q) * 272 + (16 * Ts + 4 * hi) * 2; const v2u a = *(const LAS v2u*)p, c2 = *(const LAS v2u*)(p + 16);
                w.x = a.x; w.y = a.y; w.z = c2.x; w.w = c2.y; *(v4u*)(QF + ((size_t)unit * 16 + fi) * 1024 + lane * 16) = w; }
            else if (fi < 32) { const int f2 = fi - 16, T4 = f2 >> 2, s = f2 & 3;
                w = *(const LAS v4u*)(L + HL_KT + (32 * T4 + q) * 144 + (16 * s + 8 * hi) * 2); *(v4u*)(KF + ((size_t)unit * 16 + f2) * 1024 + lane * 16) = w; }
            else { const int f2 = fi - 32, es = f2 >> 2, s = f2 & 3;
                w = *(const LAS v4u*)(L + HL_VT + (32 * es + q) * 144 + (16 * s + 8 * hi) * 2); *(v4u*)(VF + ((size_t)unit * 16 + f2) * 1024 + lane * 16) = w; } }
        __syncthreads();
    }
}

constexpr int SL_FB = 0, SL_FBSZ = 37888  , SL_PB = 2 * SL_FBSZ, SL_PBSZ = 4 * 2 * 4608;
__device__ __forceinline__ void hgrn_h2_phase(Frame& F) {
    PHASE_BEGIN();
    if (bx >= 256) return;
    const unsigned char* QF = ws + WS_QF; const unsigned char* KF = ws + WS_KF; const unsigned char* VF = ws + WS_VF; const unsigned char* DEC = ws + WS_DEC; bf16* INTER = (bf16*)(ws + WS_INTER);
    LAS unsigned char* L = F.lds;
    const int wid = __builtin_amdgcn_readfirstlane(tid >> 6), q = lane & 31, hi = lane >> 5;
    const int bh = bx >> 2, es = bx & 3, b = bh >> 3, h = bh & 7;
    f32x16 S = f32x16{};
    v4u pq0, pq1, pk0, pk1, pv = {0u, 0u, 0u, 0u}, pd = {0u, 0u, 0u, 0u};
#define H2_LOAD(cc) do { const size_t uc = (size_t)bh * 64 + (cc); pq0 = *(const v4u*)(QF + uc * 16384 + tid * 16); pq1 = *(const v4u*)(QF + uc * 16384 + 8192 + tid * 16); \
        pk0 = *(const v4u*)(KF + uc * 16384 + tid * 16); pk1 = *(const v4u*)(KF + uc * 16384 + 8192 + tid * 16); \
        if (tid < 256) pv = *(const v4u*)(VF + uc * 16384 + es * 4096 + tid * 16); if (tid < 64) pd = *(const v4u*)(DEC + uc * 1024 + tid * 16); } while (0)
#define H2_STORE(bufi) do { LAS unsigned char* fb = L + SL_FB + (bufi) * SL_FBSZ; *(LAS v4u*)(fb + tid * 16) = pq0; *(LAS v4u*)(fb + 8192 + tid * 16) = pq1; \
        *(LAS v4u*)(fb + 16384 + tid * 16) = pk0; *(LAS v4u*)(fb + 24576 + tid * 16) = pk1; if (tid < 256) *(LAS v4u*)(fb + 32768 + tid * 16) = pv; if (tid < 64) *(LAS v4u*)(fb + 36864 + tid * 16) = pd; } while (0)
#define H2_REDUCE(cc) do { const LAS unsigned char* pb = L + SL_PB + ((cc) & 1) * SL_PBSZ; const int rti = tid >> 8, ri = (tid >> 3) & 31, e4 = tid & 7; f32x4 a = {0.f, 0.f, 0.f, 0.f}; \
        _Pragma("unroll") for (int T4 = 0; T4 < 4; ++T4) a += *(const LAS f32x4*)(pb + (T4 * 2 + rti) * 4608 + ri * 144 + e4 * 16); \
        v2u w; w.x = cvtpk_s(a.x, a.y); w.y = cvtpk_s(a.z, a.w); *(v2u*)(INTER + ((size_t)b * SEQ + 64 * (cc) + 32 * rti + ri) * D + h * 128 + 32 * es + 4 * e4) = w; } while (0)
    H2_LOAD(0); H2_STORE(0);
    __syncthreads();
    for (int c = 0; c < 64; ++c) {
        if (c + 1 < 64) H2_LOAD(c + 1);
        if (wid < 4) {
            const LAS unsigned char* fb = L + SL_FB + (c & 1) * SL_FBSZ; const int T4 = wid;
            const LAS float* decp = (const LAS float*)(fb + 36864) + 32 * T4 + 4 * hi;
            bf16x8v sop[2];
#pragma unroll
            for (int s = 0; s < 2; ++s) { union { unsigned u[4]; bf16x8v v; } pk;
#pragma unroll
                for (int g2 = 0; g2 < 2; ++g2) { const f32x4 rf = *(const LAS f32x4*)(decp + 128 + 8 * (2 * s + g2)); const int r0 = 8 * s + 4 * g2;
                    pk.u[2 * g2] = cvtpk_s(S[r0] * rf.x, S[r0 + 1] * rf.y); pk.u[2 * g2 + 1] = cvtpk_s(S[r0 + 2] * rf.z, S[r0 + 3] * rf.w); }
                sop[s] = pk.v; }
            LAS unsigned char* pb = L + SL_PB + (c & 1) * SL_PBSZ;
#pragma unroll
            for (int ti = 0; ti < 2; ++ti) { f32x16 acc = f32x16{};
#pragma unroll
                for (int s = 0; s < 2; ++s) { const bf16x8v qf = *(const LAS bf16x8v*)(fb + (ti * 8 + 2 * T4 + s) * 1024 + lane * 16);
                    acc = __builtin_amdgcn_mfma_f32_32x32x16_bf16(sop[s], qf, acc, 0, 0, 0); }
#pragma unroll
                for (int rg = 0; rg < 4; ++rg) { f32x4 o4 = {acc[4 * rg], acc[4 * rg + 1], acc[4 * rg + 2], acc[4 * rg + 3]};
                    *(LAS f32x4*)(pb + (T4 * 2 + ti) * 4608 + q * 144 + (8 * rg + 4 * hi) * 4) = o4; } }
#pragma unroll
            for (int rg = 0; rg < 4; ++rg) { const f32x4 df = *(const LAS f32x4*)(decp + 8 * rg); S[4 * rg] *= df.x; S[4 * rg + 1] *= df.y; S[4 * rg + 2] *= df.z; S[4 * rg + 3] *= df.w; }
#pragma unroll
            for (int s = 0; s < 4; ++s) { const bf16x8v kf = *(const LAS bf16x8v*)(fb + 16384 + (T4 * 4 + s) * 1024 + lane * 16), vf = *(const LAS bf16x8v*)(fb + 32768 + s * 1024 + lane * 16);
                S = __builtin_amdgcn_mfma_f32_32x32x16_bf16(kf, vf, S, 0, 0, 0); }
        }
        if (c > 0) H2_REDUCE(c - 1);
        if (c + 1 < 64) H2_STORE((c + 1) & 1);
        __syncthreads();
    }
    H2_REDUCE(63);
#undef H2_LOAD
#undef H2_STORE
#undef H2_REDUCE
}
__device__ __forceinline__ void hgrn_norm2_phase(Frame& F, int j) {
    PHASE_BEGIN();
    const bf16* INTRA = (const bf16*)(ws + WS_INTRA); const bf16* INTER = (const bf16*)(ws + WS_INTER); const bf16* H = (const bf16*)(ws + WS_MIX); bf16* O = (bf16*)(ws + WS_O);
    const float* ng = in_ptr(F, 5) + (size_t)j * 128;
    for (int m = gw; m < T; m += F.NGW) {
        const v2u* ia = (const v2u*)(INTRA + (size_t)m * D) + lane; const v2u* ib = (const v2u*)(INTER + (size_t)m * D) + lane; const v2u* grow = (const v2u*)(H + (size_t)m * NH4 + 3072) + lane; v2u* out = (v2u*)(O + (size_t)m * D) + lane;
#pragma unroll
        for (int jj = 0; jj < 4; ++jj) { const v2u a = ia[64 * jj], c2 = ib[64 * jj], gw2 = grow[64 * jj];
            const float o0 = bflo(a.x) + bflo(c2.x), o1 = bfhi(a.x) + bfhi(c2.x), o2 = bflo(a.y) + bflo(c2.y), o3 = bfhi(a.y) + bfhi(c2.y);
            float ss = (o0 * o0 + o1 * o1) + (o2 * o2 + o3 * o3);
#pragma unroll
            for (int s = 1; s < 32; s <<= 1) ss += __shfl_xor(ss, s);
            const float r = 1.0f / sqrtf(ss * (1.0f / 128.0f) + RMS_EPS);
            const f32x4 gn = *(const f32x4*)(ng + ((4 * lane) & 127));
            const float g0 = bflo(gw2.x), g1 = bfhi(gw2.x), g2 = bflo(gw2.y), g3 = bfhi(gw2.y);
            v2u w; w.x = pk2(o0 * r * gn.x * (g0 / (1.0f + __expf(-g0))), o1 * r * gn.y * (g1 / (1.0f + __expf(-g1))));
            w.y = pk2(o2 * r * gn.z * (g2 / (1.0f + __expf(-g2))), o3 * r * gn.w * (g3 / (1.0f + __expf(-g3))));
            out[64 * jj] = w; }
    }
}

__device__ __forceinline__ void lna_phase(Frame& F, int l) {
    PHASE_BEGIN();
    float* X = (float*)(ws + WS_X); bf16* XB = (bf16*)(ws + WS_XB);
    const float* lg_ = in_ptr(F, 7) + (size_t)(l * 2) * D; const float* lb_ = in_ptr(F, 8) + (size_t)(l * 2) * D;
    const float* wg = in_ptr(F, 9) + (size_t)l * D * 4; const float* bg = in_ptr(F, 10) + l * 4; const float* we = in_ptr(F, 11) + (size_t)l * D * 32; const float* be = in_ptr(F, 12) + l * 32;
    int* RE = (int*)(ws + WS_RE); float* RW = (float*)(ws + WS_RW); unsigned* cnt = (unsigned*)(ws + WS_CTL) + CW_CNT + 64 * l;
    for (int m = gw; m < T; m += F.NGW) {
        f32x4* xr = (f32x4*)(X + (size_t)m * D) + lane; f32x4 v[4]; float s = 0.f;
#pragma unroll
        for (int j = 0; j < 4; ++j) { v[j] = xr[64 * j]; s += (v[j].x + v[j].y) + (v[j].z + v[j].w); }
        const float mean = wave_sum(s) * (1.f / D); float s2 = 0.f;
#pragma unroll
        for (int j = 0; j < 4; ++j) { v[j] = v[j] - mean; s2 += (v[j].x * v[j].x + v[j].y * v[j].y) + (v[j].z * v[j].z + v[j].w * v[j].w); }
        const float rstd = 1.f / sqrtf(wave_sum(s2) * (1.f / D) + LN_EPS);
        v2u* o8 = (v2u*)(XB + (size_t)m * D) + lane;
        float lg[4] = {0.f, 0.f, 0.f, 0.f}; float le[32];
#pragma unroll
        for (int i = 0; i < 32; ++i) le[i] = 0.f;
#pragma unroll
        for (int j = 0; j < 4; ++j) { const int c0 = 4 * lane + 256 * j; const f32x4 g = *(const f32x4*)(lg_ + c0), bb = *(const f32x4*)(lb_ + c0);
            v[j] = v[j] * rstd * g + bb; xr[64 * j] = v[j];
            v2u o; o.x = pk2(v[j].x, v[j].y); o.y = pk2(v[j].z, v[j].w); o8[64 * j] = o;
#pragma unroll
            for (int i = 0; i < 4; ++i) { const float xv = v[j][i]; const int k = c0 + i;
                const f32x4 w4 = *(const f32x4*)(wg + (size_t)k * 4); lg[0] += xv * w4.x; lg[1] += xv * w4.y; lg[2] += xv * w4.z; lg[3] += xv * w4.w;
#pragma unroll
                for (int q = 0; q < 8; ++q) { const f32x4 w = *(const f32x4*)(we + (size_t)k * 32 + 4 * q);
                    le[4 * q] += xv * w.x; le[4 * q + 1] += xv * w.y; le[4 * q + 2] += xv * w.z; le[4 * q + 3] += xv * w.w; } } }
#pragma unroll
        for (int i = 0; i < 4; ++i) lg[i] = wave_sum(lg[i]) + bg[i];
#pragma unroll
        for (int i = 0; i < 32; ++i) le[i] = wave_sum(le[i]) + be[i];
        float best = lg[0]; int grp = 0;
#pragma unroll
        for (int i = 1; i < 4; ++i) if (lg[i] > best) { best = lg[i]; grp = i; }
        float den = 0.f;
#pragma unroll
        for (int i = 0; i < 4; ++i) den += expf(lg[i] - best);
        const float pg = 1.0f / den;
        float b1 = -INFINITY, b2 = -INFINITY; int i1 = 0, i2 = 0;
#pragma unroll
        for (int i = 0; i < 32; ++i) if ((i >> 3) == grp && le[i] > b1) { b1 = le[i]; i1 = i; }
#pragma unroll
        for (int i = 0; i < 32; ++i) if ((i >> 3) == grp && i != i1 && le[i] > b2) { b2 = le[i]; i2 = i; }
        const float e21 = expf(b2 - b1); const float w1 = pg / (1.0f + e21), w2 = pg * e21 / (1.0f + e21);
        if (lane == 0) { RE[2 * m] = i1; RE[2 * m + 1] = i2; RW[2 * m] = w1; RW[2 * m + 1] = w2;
            __hip_atomic_fetch_add(cnt + i1, 1u, __ATOMIC_RELAXED, __HIP_MEMORY_SCOPE_AGENT); __hip_atomic_fetch_add(cnt + i2, 1u, __ATOMIC_RELAXED, __HIP_MEMORY_SCOPE_AGENT); }
    }
}
__device__ __forceinline__ void slot_phase(Frame& F, int l) {
    PHASE_BEGIN();
    const unsigned* cnt = (unsigned*)(ws + WS_CTL) + CW_CNT + 64 * l; unsigned* cur = (unsigned*)(ws + WS_CTL) + CW_CUR + 64 * l;
    volatile LAS int* MI = (volatile LAS int*)F.MISC;
    if (tid == 0) { int acc = 0;
        for (int e = 0; e < NEXP; ++e) { const int c = (int)__hip_atomic_load(cnt + e, __ATOMIC_RELAXED, __HIP_MEMORY_SCOPE_AGENT); const int n = (c + 255) >> 8; MI[320 + e] = acc;
            for (int k = 0; k < n; ++k) MI[17 + acc + k] = e; acc += n; }
        MI[16] = acc; }
    __syncthreads();
    const int* RE = (const int*)(ws + WS_RE); int* POS = (int*)(ws + WS_POS); const bf16* XB = (const bf16*)(ws + WS_XB); bf16* XG = (bf16*)(ws + WS_XG);
    for (int m = gw; m < T; m += F.NGW) {
        int s0 = 0, s1 = 0;
        if (lane == 0) { const int e0 = RE[2 * m], e1 = RE[2 * m + 1];
            s0 = MI[320 + e0] * 256 + (int)__hip_atomic_fetch_add(cur + e0, 1u, __ATOMIC_RELAXED, __HIP_MEMORY_SCOPE_AGENT);
            s1 = MI[320 + e1] * 256 + (int)__hip_atomic_fetch_add(cur + e1, 1u, __ATOMIC_RELAXED, __HIP_MEMORY_SCOPE_AGENT);
            POS[2 * m] = s0; POS[2 * m + 1] = s1; }
        s0 = __builtin_amdgcn_readfirstlane(s0); s1 = __builtin_amdgcn_readfirstlane(s1);
        const v4u* src = (const v4u*)(XB + (size_t)m * D) + lane; const v4u a = src[0], c = src[64];
        v4u* d0 = (v4u*)(XG + (size_t)s0 * D) + lane; v4u* d1 = (v4u*)(XG + (size_t)s1 * D) + lane;
        d0[0] = a; d0[64] = c; d1[0] = a; d1[64] = c;
    }
}
__device__ __forceinline__ void lnb_phase(Frame& F, int l) {
    PHASE_BEGIN();
    float* X = (float*)(ws + WS_X); bf16* XB = (bf16*)(ws + WS_XB); const bf16* YB = (const bf16*)(ws + WS_YB);
    const float* lg_ = in_ptr(F, 7) + (size_t)(l * 2 + 1) * D; const float* lb_ = in_ptr(F, 8) + (size_t)(l * 2 + 1) * D;
    const int* POS = (const int*)(ws + WS_POS); const float* RW = (const float*)(ws + WS_RW);
    const bool last = (l == DEPTH - 1);
    for (int m = gw; m < T; m += F.NGW) {
        const int p0 = POS[2 * m], p1 = POS[2 * m + 1]; const float w0 = RW[2 * m], w1 = RW[2 * m + 1];
        f32x4* xr = (f32x4*)(X + (size_t)m * D) + lane; const v2u* y0 = (const v2u*)(YB + (size_t)p0 * D) + lane; const v2u* y1 = (const v2u*)(YB + (size_t)p1 * D) + lane;
        f32x4 v[4]; float s = 0.f;
#pragma unroll
        for (int j = 0; j < 4; ++j) { const f32x4 xv = xr[64 * j]; const v2u a = y0[64 * j], c = y1[64 * j];
            v[j].x = ALPHA * xv.x + w0 * bflo(a.x) + w1 * bflo(c.x); v[j].y = ALPHA * xv.y + w0 * bfhi(a.x) + w1 * bfhi(c.x);
            v[j].z = ALPHA * xv.z + w0 * bflo(a.y) + w1 * bflo(c.y); v[j].w = ALPHA * xv.w + w0 * bfhi(a.y) + w1 * bfhi(c.y);
            s += (v[j].x + v[j].y) + (v[j].z + v[j].w); }
        const float mean = wave_sum(s) * (1.f / D); float s2 = 0.f;
#pragma unroll
        for (int j = 0; j < 4; ++j) { v[j] = v[j] - mean; s2 += (v[j].x * v[j].x + v[j].y * v[j].y) + (v[j].z * v[j].z + v[j].w * v[j].w); }
        const float rstd = 1.f / sqrtf(wave_sum(s2) * (1.f / D) + LN_EPS);
        f32x4* outr = last ? (f32x4*)((float*)in_ptr(F, 16) + (size_t)m * D) + lane : xr; v2u* o8 = (v2u*)(XB + (size_t)m * D) + lane;
#pragma unroll
        for (int j = 0; j < 4; ++j) { const int c0 = 4 * lane + 256 * j; const f32x4 g = *(const f32x4*)(lg_ + c0), bb = *(const f32x4*)(lb_ + c0);
            v[j] = v[j] * rstd * g + bb; outr[64 * j] = v[j];
            v2u o; o.x = pk2(v[j].x, v[j].y); o.y = pk2(v[j].z, v[j].w); o8[64 * j] = o; }
    }
}

struct Args { const float* in[16]; float* out; unsigned char* ws; };
__global__ void __launch_bounds__(NWAVES * 64, 2) mega_fwd(Args args) {
    extern __shared__ __attribute__((aligned(16))) unsigned char lds[];
    Frame F;
    F.lds = (LAS unsigned char*)lds; F.MISC = (volatile LAS unsigned*)(F.lds + MISC_OFF);
    F.tid = threadIdx.x; F.lane = F.tid & 63; F.wave = __builtin_amdgcn_readfirstlane(F.tid >> 6);
    F.G = gridDim.x; F.gw = blockIdx.x * NWAVES + F.wave; F.NGW = F.G * NWAVES;
    F.ws = args.ws;
    for (int u = F.tid; u < (LDS_BYTES - MISC_OFF) / 4; u += NWAVES * 64) F.MISC[u] = 0u;
    __syncthreads();
    if (F.tid < 17) { const unsigned long long p = F.tid < 16 ? (unsigned long long)args.in[F.tid] : (unsigned long long)args.out; F.MISC[512 + 2 * F.tid] = (unsigned)p; F.MISC[513 + 2 * F.tid] = (unsigned)(p >> 32); }
    __syncthreads();
#define GRID_BAR() do { unsigned char* wsb_ = F.ws; asm volatile("" : "+s"(wsb_)); XcdBarrier bar_; bar_.bar = (unsigned*)(wsb_ + WS_CTL) + CW_BAR; bar_.x = xb_xcc_id(); bar_.st = F.MISC; xcd_barrier(bar_); } while (0)
    { XcdBarrier b0 = xcd_barrier_post((unsigned*)(F.ws + WS_CTL) + CW_BAR, F.MISC); (void)b0; }
    PG8_LAS unsigned char* ring = (PG8_LAS unsigned char*)lds;

    prologue(F); convert_weights(F, 0);
    GRID_BAR();
    { constexpr int l = 0;
        constexpr bool even = (l & 1) == 0; constexpr int j = l >> 1;
        { LAUNDER_WS(); const int Nin = even ? NQKV : NH4;
          pg8::Gemm g{(const pg8::bf16_t*)(ws + WS_XB), (const pg8::bf16_t*)(ws + WS_WIN), T, Nin, D}; pg8::StaticOrder S; S.init(T, Nin, F.G, bx);
          pg8::EpiPlain E{(pg8::bf16_t*)(ws + WS_MIX), Nin, 0xffff};
          pg8::gemm_phase<pg8::EpiPlain, pg8::StaticOrder, true, true>(ring, g, S, E); }
        GRID_BAR();
        if constexpr (even) {
            rope_phase(F); GRID_BAR();
            kmean_phase(F); GRID_BAR();
            attn_fast_phase(F); GRID_BAR();
        } else {
            hgrn_h1_phase(F, j); GRID_BAR();
            hgrn_h2_phase(F); GRID_BAR();
            hgrn_norm2_phase(F, j); GRID_BAR();
        }
        { LAUNDER_WS(); pg8::Gemm g{(const pg8::bf16_t*)(ws + WS_O), (const pg8::bf16_t*)(ws + WS_WOUT), T, D, D}; pg8::StaticOrder S; S.init(T, D, F.G, bx);
          pg8::EpiResid E{l == 0 ? in_ptr(F, 0) : (const float*)(ws + WS_X), (float*)(ws + WS_X), ALPHA};
          pg8::gemm_phase<pg8::EpiResid, pg8::StaticOrder, true, true>(ring, g, S, E); }
        GRID_BAR();
        lna_phase(F, l); GRID_BAR();
        slot_phase(F, l); GRID_BAR();
        { LAUNDER_WS(); pg8::Gemm g{(const pg8::bf16_t*)(ws + WS_XG), (const pg8::bf16_t*)(ws + WS_W13), MAX_TILES * 256, 1024, D};
          pg8::MoeOrder S{(const PG8_LAS int*)(F.lds + MISC_OFF + 64), F.G, (F.G % 8 == 0) ? (bx % 8) * (F.G / 8) + bx / 8 : bx};
          pg8::EpiSwiGlu E{(pg8::bf16_t*)(ws + WS_HB), FEXP};
          pg8::gemm_phase<pg8::EpiSwiGlu, pg8::MoeOrder, true, true>(ring, g, S, E); }
        GRID_BAR();
        { LAUNDER_WS(); pg8::Gemm g{(const pg8::bf16_t*)(ws + WS_HB), (const pg8::bf16_t*)(ws + WS_W2), MAX_TILES * 256, 1024, FEXP};
          pg8::MoeOrder S{(const PG8_LAS int*)(F.lds + MISC_OFF + 64), F.G, (F.G % 8 == 0) ? (bx % 8) * (F.G / 8) + bx / 8 : bx};
          pg8::EpiPlain E{(pg8::bf16_t*)(ws + WS_YB), D, 3};
          pg8::gemm_phase<pg8::EpiPlain, pg8::MoeOrder, true, true>(ring, g, S, E); }
        GRID_BAR();
        lnb_phase(F, l);
        if (l + 1 < DEPTH) { convert_weights(F, l + 1); GRID_BAR(); }
    }
    { constexpr int l = 1;
        constexpr bool even = (l & 1) == 0; constexpr int j = l >> 1;
        { LAUNDER_WS(); const int Nin = even ? NQKV : NH4;
          pg8::Gemm g{(const pg8::bf16_t*)(ws + WS_XB), (const pg8::bf16_t*)(ws + WS_WIN), T, Nin, D}; pg8::StaticOrder S; S.init(T, Nin, F.G, bx);
          pg8::EpiPlain E{(pg8::bf16_t*)(ws + WS_MIX), Nin, 0xffff};
          pg8::gemm_phase<pg8::EpiPlain, pg8::StaticOrder, true, true>(ring, g, S, E); }
        GRID_BAR();
        if constexpr (even) {
            rope_phase(F); GRID_BAR();
            kmean_phase(F); GRID_BAR();
            attn_fast_phase(F); GRID_BAR();
        } else {
            hgrn_h1_phase(F, j); GRID_BAR();
            hgrn_h2_phase(F); GRID_BAR();
            hgrn_norm2_phase(F, j); GRID_BAR();
        }
        { LAUNDER_WS(); pg8::Gemm g{(const pg8::bf16_t*)(ws + WS_O), (const pg8::bf16_t*)(ws + WS_WOUT), T, D, D}; pg8::StaticOrder S; S.init(T, D, F.G, bx);
          pg8::EpiResid E{l == 0 ? in_ptr(F, 0) : (const float*)(ws + WS_X), (float*)(ws + WS_X), ALPHA};
          pg8::gemm_phase<pg8::EpiResid, pg8::StaticOrder, true, true>(ring, g, S, E); }
        GRID_BAR();
        lna_phase(F, l); GRID_BAR();
        slot_phase(F, l); GRID_BAR();
        { LAUNDER_WS(); pg8::Gemm g{(const pg8::bf16_t*)(ws + WS_XG), (const pg8::bf16_t*)(ws + WS_W13), MAX_TILES * 256, 1024, D};
          pg8::MoeOrder S{(const PG8_LAS int*)(F.lds + MISC_OFF + 64), F.G, (F.G % 8 == 0) ? (bx % 8) * (F.G / 8) + bx / 8 : bx};
          pg8::EpiSwiGlu E{(pg8::bf16_t*)(ws + WS_HB), FEXP};
          pg8::gemm_phase<pg8::EpiSwiGlu, pg8::MoeOrder, true, true>(ring, g, S, E); }
        GRID_BAR();
        { LAUNDER_WS(); pg8::Gemm g{(const pg8::bf16_t*)(ws + WS_HB), (const pg8::bf16_t*)(ws + WS_W2), MAX_TILES * 256, 1024, FEXP};
          pg8::MoeOrder S{(const PG8_LAS int*)(F.lds + MISC_OFF + 64), F.G, (F.G % 8 == 0) ? (bx % 8) * (F.G / 8) + bx / 8 : bx};
          pg8::EpiPlain E{(pg8::bf16_t*)(ws + WS_YB), D, 3};
          pg8::gemm_phase<pg8::EpiPlain, pg8::MoeOrder, true, true>(ring, g, S, E); }
        GRID_BAR();
        lnb_phase(F, l);
        if (l + 1 < DEPTH) { convert_weights(F, l + 1); GRID_BAR(); }
    }
    { constexpr int l = 2;
        constexpr bool even = (l & 1) == 0; constexpr int j = l >> 1;
        { LAUNDER_WS(); const int Nin = even ? NQKV : NH4;
          pg8::Gemm g{(const pg8::bf16_t*)(ws + WS_XB), (const pg8::bf16_t*)(ws + WS_WIN), T, Nin, D}; pg8::StaticOrder S; S.init(T, Nin, F.G, bx);
          pg8::EpiPlain E{(pg8::bf16_t*)(ws + WS_MIX), Nin, 0xffff};
          pg8::gemm_phase<pg8::EpiPlain, pg8::StaticOrder, true, true>(ring, g, S, E); }
        GRID_BAR();
        if constexpr (even) {
            rope_phase(F); GRID_BAR();
            kmean_phase(F); GRID_BAR();
            attn_fast_phase(F); GRID_BAR();
        } else {
            hgrn_h1_phase(F, j); GRID_BAR();
            hgrn_h2_phase(F); GRID_BAR();
            hgrn_norm2_phase(F, j); GRID_BAR();
        }
        { LAUNDER_WS(); pg8::Gemm g{(const pg8::bf16_t*)(ws + WS_O), (const pg8::bf16_t*)(ws + WS_WOUT), T, D, D}; pg8::StaticOrder S; S.init(T, D, F.G, bx);
          pg8::EpiResid E{l == 0 ? in_ptr(F, 0) : (const float*)(ws + WS_X), (float*)(ws + WS_X), ALPHA};
          pg8::gemm_phase<pg8::EpiResid, pg8::StaticOrder, true, true>(ring, g, S, E); }
        GRID_BAR();
        lna_phase(F, l); GRID_BAR();
        slot_phase(F, l); GRID_BAR();
        { LAUNDER_WS(); pg8::Gemm g{(const pg8::bf16_t*)(ws + WS_XG), (const pg8::bf16_t*)(ws + WS_W13), MAX_TILES * 256, 1024, D};
          pg8::MoeOrder S{(const PG8_LAS int*)(F.lds + MISC_OFF + 64), F.G, (F.G % 8 == 0) ? (bx % 8) * (F.G / 8) + bx / 8 : bx};
          pg8::EpiSwiGlu E{(pg8::bf16_t*)(ws + WS_HB), FEXP};
          pg8::gemm_phase<pg8::EpiSwiGlu, pg8::MoeOrder, true, true>(ring, g, S, E); }
        GRID_BAR();
        { LAUNDER_WS(); pg8::Gemm g{(const pg8::bf16_t*)(ws + WS_HB), (const pg8::bf16_t*)(ws + WS_W2), MAX_TILES * 256, 1024, FEXP};
          pg8::MoeOrder S{(const PG8_LAS int*)(F.lds + MISC_OFF + 64), F.G, (F.G % 8 == 0) ? (bx % 8) * (F.G / 8) + bx / 8 : bx};
          pg8::EpiPlain E{(pg8::bf16_t*)(ws + WS_YB), D, 3};
          pg8::gemm_phase<pg8::EpiPlain, pg8::MoeOrder, true, true>(ring, g, S, E); }
        GRID_BAR();
        lnb_phase(F, l);
        if (l + 1 < DEPTH) { convert_weights(F, l + 1); GRID_BAR(); }
    }
    { constexpr int l = 3;
        constexpr bool even = (l & 1) == 0; constexpr int j = l >> 1;
        { LAUNDER_WS(); const int Nin = even ? NQKV : NH4;
          pg8::Gemm g{(const pg8::bf16_t*)(ws + WS_XB), (const pg8::bf16_t*)(ws + WS_WIN), T, Nin, D}; pg8::StaticOrder S; S.init(T, Nin, F.G, bx);
          pg8::EpiPlain E{(pg8::bf16_t*)(ws + WS_MIX), Nin, 0xffff};
          pg8::gemm_phase<pg8::EpiPlain, pg8::StaticOrder, true, true>(ring, g, S, E); }
        GRID_BAR();
        if constexpr (even) {
            rope_phase(F); GRID_BAR();
            kmean_phase(F); GRID_BAR();
            attn_fast_phase(F); GRID_BAR();
        } else {
            hgrn_h1_phase(F, j); GRID_BAR();
            hgrn_h2_phase(F); GRID_BAR();
            hgrn_norm2_phase(F, j); GRID_BAR();
        }
        { LAUNDER_WS(); pg8::Gemm g{(const pg8::bf16_t*)(ws + WS_O), (const pg8::bf16_t*)(ws + WS_WOUT), T, D, D}; pg8::StaticOrder S; S.init(T, D, F.G, bx);
          pg8::EpiResid E{l == 0 ? in_ptr(F, 0) : (const float*)(ws + WS_X), (float*)(ws + WS_X), ALPHA};
          pg8::gemm_phase<pg8::EpiResid, pg8::StaticOrder, true, true>(ring, g, S, E); }
        GRID_BAR();
        lna_phase(F, l); GRID_BAR();
        slot_phase(F, l); GRID_BAR();
        { LAUNDER_WS(); pg8::Gemm g{(const pg8::bf16_t*)(ws + WS_XG), (const pg8::bf16_t*)(ws + WS_W13), MAX_TILES * 256, 1024, D};
          pg8::MoeOrder S{(const PG8_LAS int*)(F.lds + MISC_OFF + 64), F.G, (F.G % 8 == 0) ? (bx % 8) * (F.G / 8) + bx / 8 : bx};
          pg8::EpiSwiGlu E{(pg8::bf16_t*)(ws + WS_HB), FEXP};
          pg8::gemm_phase<pg8::EpiSwiGlu, pg8::MoeOrder, true, true>(ring, g, S, E); }
        GRID_BAR();
        { LAUNDER_WS(); pg8::Gemm g{(const pg8::bf16_t*)(ws + WS_HB), (const pg8::bf16_t*)(ws + WS_W2), MAX_TILES * 256, 1024, FEXP};
          pg8::MoeOrder S{(const PG8_LAS int*)(F.lds + MISC_OFF + 64), F.G, (F.G % 8 == 0) ? (bx % 8) * (F.G / 8) + bx / 8 : bx};
          pg8::EpiPlain E{(pg8::bf16_t*)(ws + WS_YB), D, 3};
          pg8::gemm_phase<pg8::EpiPlain, pg8::MoeOrder, true, true>(ring, g, S, E); }
        GRID_BAR();
        lnb_phase(F, l);
        if (l + 1 < DEPTH) { convert_weights(F, l + 1); GRID_BAR(); }
    }
}

extern "C" void kernel_launch(void* const* d_in, const int* in_sizes, int n_in, void* d_out, int out_size, void* d_ws, size_t ws_size, hipStream_t stream) {
    static int grid = 0;
    if (grid == 0) {
        if (n_in != 16 || in_sizes[0] != T * D || out_size != T * D || ws_size < WS_END) { fprintf(stderr, "kernel_launch: unexpected shapes (n_in %d, in0 %d, out %d, ws %zu)\n", n_in, n_in > 0 ? in_sizes[0] : -1, out_size, ws_size); grid = -1; return; }
        int dev = 0, cus = 0, per_cu = 0;
        if (hipGetDevice(&dev) != hipSuccess || hipDeviceGetAttribute(&cus, hipDeviceAttributeMultiprocessorCount, dev) != hipSuccess) { grid = -1; return; }
        if (hipFuncSetAttribute((const void*)mega_fwd, hipFuncAttributeMaxDynamicSharedMemorySize, LDS_BYTES) != hipSuccess) { fprintf(stderr, "kernel_launch: hipFuncSetAttribute failed\n"); grid = -1; return; }
        if (hipOccupancyMaxActiveBlocksPerMultiprocessor(&per_cu, (const void*)mega_fwd, NWAVES * 64, LDS_BYTES) != hipSuccess || per_cu < 1) fprintf(stderr, "kernel_launch: occupancy query reports %d\n", per_cu);
        (void)hipGetLastError();
        grid = cus;
    }
    if (grid < 0) return;
    if (hipMemsetAsync((char*)d_ws + WS_CTL, 0, CTL_ZERO_BYTES, stream) != hipSuccess) return;
    Args a{};
    for (int i = 0; i < 16; ++i) a.in[i] = (const float*)d_in[i];
    a.out = (float*)d_out; a.ws = (unsigned char*)d_ws;
    hipLaunchKernelGGL(mega_fwd, dim3(grid), dim3(NWAVES * 64), LDS_BYTES, stream, a);
}
```

```cpp
#include <hip/hip_runtime.h>
#include <cstdio>
#include <cstdint>
#include <cmath>
namespace pg8 {
#define PG8_LAS __attribute__((address_space(3)))
typedef unsigned short bf16_t;
typedef short bf16x8 __attribute__((ext_vector_type(8)));
typedef float f32x4 __attribute__((ext_vector_type(4)));
typedef unsigned u32x4 __attribute__((ext_vector_type(4)));
constexpr int BM = 256, BK = 64, HALF = 128, HTB = HALF * BK * 2  , STAGE_BYTES = 8 * HTB, NXCD = 8, WGM = 8;

__host__ __device__ __forceinline__ int lds_byte(int r, int c) { const int st = (r >> 4) * 2 + (c >> 5), rr = r & 15, cc = c & 31, ob = rr * 64 + cc * 2; return st * 1024 + (ob ^ (((ob >> 9) & 1) << 5)); }
__host__ __device__ __forceinline__ void stage_rc(int b, int& R, int& C) { const int st = b / 1024, sb = b % 1024, swz = sb ^ (((sb >> 9) & 1) << 5); R = (st >> 1) * 16 + swz / 64; C = (st & 1) * 32 + (swz % 64) / 2; }
__host__ __device__ __forceinline__ int perm32(int rho) { const int n = rho >> 4, i = rho & 15; return 8 * (i >> 2) + 4 * n + (i & 3); }

struct Unit { int pm, pn; };
struct Gemm { const bf16_t* A; const bf16_t* Bt; int M, N, K; };

struct StaticOrder {
    int nM, nN, nwg, G, c;
    __host__ __device__ void init(int M, int N, int G_, int c_) { nM = M / BM; nN = N / BM; nwg = nM * nN; G = G_; c = c_; }
    __host__ __device__ bool next(int i, Unit& u) const {
        const long L = (long)i * G + c; if (L >= nwg) return false;
        int wgid = (int)L; { const int q = nwg / NXCD, r = nwg % NXCD, xcd = wgid % NXCD, off = wgid / NXCD; wgid = (xcd < r ? xcd * (q + 1) : r * (q + 1) + (xcd - r) * q) + off; }
        const int nig = WGM * nN, gid = wgid / nig, fm = gid * WGM, gsz = (nM - fm) < WGM ? (nM - fm) : WGM;
        u.pm = fm + ((wgid % nig) % gsz); u.pn = (wgid % nig) / gsz; return true;
    }
    __device__ __forceinline__ void a_ready(const Unit&) const {}
    __device__ __forceinline__ void done(const Unit&) const {}
};

__device__ __forceinline__ unsigned cvt_pk_bf16(float lo, float hi) { unsigned r; asm volatile("v_cvt_pk_bf16_f32 %0, %1, %2" : "=v"(r) : "v"(lo), "v"(hi)); return r; }
typedef float f32x2 __attribute__((ext_vector_type(2)));

__device__ __forceinline__ float silu_f(float a) { return a * __builtin_amdgcn_rcpf(1.0f + __expf(-a)); }
struct EpiPlain {
    static constexpr bool PERM = true, AFTER_DRAIN = false;
    bf16_t* O; int ldc; int pn_mask;
    __device__ __forceinline__ void operator()(const f32x4 (&acc)[2][2][4][2], const Unit& u, int wr, int wc, int fr, int fq) const {
        const int row0 = u.pm * BM + wr * 64 + fr; const int col0 = (u.pn & pn_mask) * BM + wc * 32 + 8 * fq;
#pragma unroll
        for (int ai = 0; ai < 2; ++ai)
#pragma unroll
            for (int m = 0; m < 4; ++m) { bf16_t* rowp = O + (size_t)(row0 + ai * HALF + m * 16) * ldc + col0;
#pragma unroll
                for (int bj = 0; bj < 2; ++bj) { const f32x4 v0 = acc[ai][bj][m][0], v1 = acc[ai][bj][m][1];
                    u32x4 w; w.x = cvt_pk_bf16(v0[0], v0[1]); w.y = cvt_pk_bf16(v0[2], v0[3]); w.z = cvt_pk_bf16(v1[0], v1[1]); w.w = cvt_pk_bf16(v1[2], v1[3]);
                    *(u32x4*)(rowp + bj * HALF) = w; } }
    }
};

struct EpiQKV {
    static constexpr bool PERM = true, AFTER_DRAIN = false;
    bf16_t* O; const float* rope; float* kmean;
    __device__ __forceinline__ void operator()(const f32x4 (&acc)[2][2][4][2], const Unit& u, int wr, int wc, int fr, int fq) const {
        const int row0 = u.pm * BM + wr * 64 + fr; const int col0 = u.pn * BM + wc * 32 + 8 * fq;
        const bool roped = (u.pn < 4) || (u.pn >= 6 && u.pn < 10); const bool iska = (u.pn == 2) || (u.pn == 3);
        const bool rl = ((wc & 1) == 0) && (fq < 2); const float sgn = fq == 0 ? -1.0f : 1.0f;
        f32x4 cs[2][2]; cs[0][0] = cs[0][1] = cs[1][0] = cs[1][1] = (f32x4){0.f, 0.f, 0.f, 0.f};
#pragma unroll
        for (int ai = 0; ai < 2; ++ai)
#pragma unroll
            for (int m = 0; m < 4; ++m) { const int row = row0 + ai * HALF + m * 16; bf16_t* rowp = O + (size_t)row * 3072 + col0;
                f32x4 c0 = {1.f, 1.f, 1.f, 1.f}, c1 = c0, s0 = {0.f, 0.f, 0.f, 0.f}, s1 = s0;
                if (roped && rl) { const float* rp = rope + (size_t)(row & 4095) * 16; c0 = *(const f32x4*)rp; c1 = *(const f32x4*)(rp + 4); s0 = *(const f32x4*)(rp + 8) * sgn; s1 = *(const f32x4*)(rp + 12) * sgn; }
#pragma unroll
                for (int bj = 0; bj < 2; ++bj) { f32x4 v0 = acc[ai][bj][m][0], v1 = acc[ai][bj][m][1];
                    if (roped) { f32x4 p0, p1;
#pragma unroll
                        for (int k = 0; k < 4; ++k) { p0[k] = __shfl_xor(v0[k], 16); p1[k] = __shfl_xor(v1[k], 16); }
                        v0 = v0 * c0 + p0 * s0; v1 = v1 * c1 + p1 * s1; }
                    if (iska) { cs[bj][0] += v0; cs[bj][1] += v1; }
                    u32x4 w; w.x = cvt_pk_bf16(v0[0], v0[1]); w.y = cvt_pk_bf16(v0[2], v0[3]); w.z = cvt_pk_bf16(v1[0], v1[1]); w.w = cvt_pk_bf16(v1[2], v1[3]);
                    *(u32x4*)(rowp + bj * HALF) = w; } }
        if (iska) {
#pragma unroll
            for (int bj = 0; bj < 2; ++bj)
#pragma unroll
                for (int n = 0; n < 2; ++n)
#pragma unroll
                    for (int k = 0; k < 4; ++k) { float v = cs[bj][n][k];
                        v += __shfl_xor(v, 1); v += __shfl_xor(v, 2); v += __shfl_xor(v, 4); v += __shfl_xor(v, 8);
                        if (fr == 0) { const int head = (u.pn - 2) * 4 + bj * 2 + (wc >> 1), dim = (wc & 1) * 32 + 8 * fq + 4 * n + k;
                            __hip_atomic_fetch_add(kmean + (((size_t)(u.pm >> 4) * 8 + head) * 16 + (u.pm & 15)) * 64 + dim, v * (1.0f / 256.0f), __ATOMIC_RELAXED, __HIP_MEMORY_SCOPE_AGENT); } }
        }
    }
};

struct EpiHeadMajor {
    static constexpr bool PERM = true, AFTER_DRAIN = false;
    bf16_t* O;
    __device__ __forceinline__ void operator()(const f32x4 (&acc)[2][2][4][2], const Unit& u, int wr, int wc, int fr, int fq) const {
        const int row0 = u.pm * BM + wr * 64 + fr; const int which = u.pn >> 2, b = (u.pm * BM) >> 12;
#pragma unroll
        for (int ai = 0; ai < 2; ++ai)
#pragma unroll
            for (int m = 0; m < 4; ++m) { const int t = (row0 + ai * HALF + m * 16) & 4095;
#pragma unroll
                for (int bj = 0; bj < 2; ++bj) { const int head = (u.pn & 3) * 2 + bj; const f32x4 v0 = acc[ai][bj][m][0], v1 = acc[ai][bj][m][1];
                    u32x4 w; w.x = cvt_pk_bf16(v0[0], v0[1]); w.y = cvt_pk_bf16(v0[2], v0[3]); w.z = cvt_pk_bf16(v1[0], v1[1]); w.w = cvt_pk_bf16(v1[2], v1[3]);
                    *(u32x4*)(O + ((((size_t)which * 8 + b) * 8 + head) * 4096 + t) * 128 + wc * 32 + 8 * fq) = w; } }
    }
};
struct EpiSwiGlu {
    static constexpr bool PERM = true, AFTER_DRAIN = false;
    bf16_t* O; int ldc;
    __device__ __forceinline__ void operator()(const f32x4 (&acc)[2][2][4][2], const Unit& u, int wr, int wc, int fr, int fq) const {
        const int row0 = u.pm * BM + wr * 64 + fr; const int col0 = (u.pn & 3) * HALF + wc * 32 + 8 * fq;
#pragma unroll
        for (int ai = 0; ai < 2; ++ai)
#pragma unroll
            for (int m = 0; m < 4; ++m) { bf16_t* rowp = O + (size_t)(row0 + ai * HALF + m * 16) * ldc + col0;
                const f32x4 a0 = acc[ai][0][m][0], a1 = acc[ai][0][m][1], b0 = acc[ai][1][m][0], b1 = acc[ai][1][m][1];
                u32x4 w; w.x = cvt_pk_bf16(silu_f(a0[0]) * b0[0], silu_f(a0[1]) * b0[1]); w.y = cvt_pk_bf16(silu_f(a0[2]) * b0[2], silu_f(a0[3]) * b0[3]);
                w.z = cvt_pk_bf16(silu_f(a1[0]) * b1[0], silu_f(a1[1]) * b1[1]); w.w = cvt_pk_bf16(silu_f(a1[2]) * b1[2], silu_f(a1[3]) * b1[3]);
                *(u32x4*)rowp = w; }
    }
};
struct EpiResid {
    static constexpr bool PERM = false, AFTER_DRAIN = false;
    const float* base; float* out; float alpha;
    __device__ __forceinline__ void operator()(const f32x4 (&acc)[2][2][4][2], const Unit& u, int wr, int wc, int fr, int fq) const {
        const int row0 = u.pm * BM + wr * 64 + fr; const int col0 = u.pn * BM + wc * 32 + 4 * fq;
#pragma unroll
        for (int ai = 0; ai < 2; ++ai)
#pragma unroll
            for (int m = 0; m < 4; ++m) { const size_t off = (size_t)(row0 + ai * HALF + m * 16) * 1024 + col0;
#pragma unroll
                for (int bj = 0; bj < 2; ++bj)
#pragma unroll
                    for (int n = 0; n < 2; ++n) { const f32x4 bs = *(const f32x4*)(base + off + bj * HALF + n * 16);
                        *(f32x4*)(out + off + bj * HALF + n * 16) = bs * alpha + acc[ai][bj][m][n]; } }
    }
};
struct MoeOrder {
    const PG8_LAS int* tab; int G, vc;
    __device__ __forceinline__ bool next(int i, Unit& u) const {
        const long L = (long)i * G + vc; const int nt = __builtin_amdgcn_readfirstlane(tab[0]); if (L >= (long)nt * 4) return false;
        const int pm = (int)(L >> 2); u.pm = pm; u.pn = __builtin_amdgcn_readfirstlane(tab[1 + pm]) * 4 + (int)(L & 3); return true;
    }
    __device__ __forceinline__ void a_ready(const Unit&) const {}
    __device__ __forceinline__ void done(const Unit&) const {}
};
template <bool F16> __device__ __forceinline__ f32x4 mma16(bf16x8 a, bf16x8 b, f32x4 c) {
    if constexpr (F16) { typedef _Float16 f16x8_t __attribute__((ext_vector_type(8))); return __builtin_amdgcn_mfma_f32_16x16x32_f16(__builtin_bit_cast(f16x8_t, a), __builtin_bit_cast(f16x8_t, b), c, 0, 0, 0); }
    else return __builtin_amdgcn_mfma_f32_16x16x32_bf16(a, b, c, 0, 0, 0);
}
template <class Epi, class Sched, bool ALIGN_EPI = false, bool SP2 = false, bool F16 = false>
__device__ __forceinline__ void gemm_phase(PG8_LAS unsigned char* lds, const Gemm g, const Sched& S, const Epi& E) {
    int tid_ = threadIdx.x; asm volatile("" : "+v"(tid_));
    const int tid = tid_, wid = __builtin_amdgcn_readfirstlane(tid >> 6), lane = tid & 63, wr = wid >> 2, wc = wid & 3, fr = lane & 15, fq = lane >> 4;
    const int K = g.K, nt = K / BK;
    unsigned voffA[2], voffB[2];
#pragma unroll
    for (int i = 0; i < 2; ++i) { int R, C; stage_rc(tid * 16 + i * 8192, R, C); const int Rb = Epi::PERM ? ((R & ~31) + perm32(R & 31)) : R;
        voffA[i] = (unsigned)(R * K + C) * 2u; voffB[i] = (unsigned)(Rb * K + C) * 2u; }
    const size_t kstep = (size_t)(BK * 2);
    const size_t hstep = (size_t)HALF * K * 2;
    const size_t tstep = 2 * hstep;
    const unsigned ldsw = (unsigned)wid * 1024u;
    const int aoff = lds_byte(wr * 64 + fr, fq * 8), boff = lds_byte(wc * 32 + fr, fq * 8);
#define PG8_SA(b, h) (((b) * 2 + (h)) * HTB)
#define PG8_SB(b, h) ((4 + (b) * 2 + (h)) * HTB)
#define PG8_STAGE(bufoff, gbase, voff) do { _Pragma("unroll") for (int _i = 0; _i < 2; ++_i) \
        __builtin_amdgcn_global_load_lds((const unsigned*)((const char*)(gbase) + (voff)[_i]), (PG8_LAS unsigned*)(lds + (bufoff) + ldsw + _i * 8192), 16, 0, 0); } while (0)
#define PG8_LDA(dst, b, h) do { _Pragma("unroll") for (int m = 0; m < 4; ++m) _Pragma("unroll") for (int k = 0; k < 2; ++k) dst[m][k] = *(const PG8_LAS bf16x8*)(lds + PG8_SA(b, h) + aoff + m * 2048 + k * 1024); } while (0)
#define PG8_LDB(dst, b, h) do { _Pragma("unroll") for (int n = 0; n < 2; ++n) _Pragma("unroll") for (int k = 0; k < 2; ++k) dst[n][k] = *(const PG8_LAS bf16x8*)(lds + PG8_SB(b, h) + boff + n * 2048 + k * 1024); } while (0)
#define PG8_MMA(ai, bj, At, Bt) do { __builtin_amdgcn_s_setprio(1); _Pragma("unroll") for (int m = 0; m < 4; ++m) _Pragma("unroll") for (int n = 0; n < 2; ++n) _Pragma("unroll") for (int k = 0; k < 2; ++k) \
        acc[ai][bj][m][n] = mma16<F16>(Bt[n][k], At[m][k], acc[ai][bj][m][n]); __builtin_amdgcn_s_setprio(0); } while (0)
#define PG8_WAIT_V(n) asm volatile("s_waitcnt vmcnt(" #n ")" ::: "memory")
#define PG8_WAIT_L(n) asm volatile("s_waitcnt lgkmcnt(" #n ")" ::: "memory")
#define PG8_BAR __builtin_amdgcn_s_barrier()
#define PG8_SCHED __builtin_amdgcn_sched_barrier(0)
    Unit cur, nxt; int ui = 0;
    if (!S.next(0, cur)) return;
    f32x4 acc[2][2][4][2];
#pragma unroll
    for (int a = 0; a < 2; ++a)
#pragma unroll
        for (int b = 0; b < 2; ++b)
#pragma unroll
            for (int m = 0; m < 4; ++m)
#pragma unroll
                for (int n = 0; n < 2; ++n) acc[a][b][m][n] = (f32x4){0.f, 0.f, 0.f, 0.f};
    bf16x8 At[4][2], B0[2][2], B1[2][2];
    const char* cA = (const char*)g.A + (size_t)cur.pm * tstep; const char* cB = (const char*)g.Bt + (size_t)cur.pn * tstep;
    S.a_ready(cur);
    if constexpr (SP2) {
        PG8_STAGE(PG8_SB(0, 0), cB, voffB); PG8_STAGE(PG8_SB(0, 1), cB + hstep, voffB); PG8_STAGE(PG8_SA(0, 0), cA, voffA); PG8_STAGE(PG8_SA(0, 1), cA + hstep, voffA);
        if (wr == 1) PG8_BAR;
        PG8_WAIT_V(2); PG8_BAR;
        PG8_STAGE(PG8_SB(1, 0), cB + kstep, voffB); PG8_STAGE(PG8_SA(1, 0), cA + kstep, voffA); PG8_STAGE(PG8_SB(1, 1), cB + hstep + kstep, voffB);
        PG8_WAIT_V(6); PG8_BAR;
    } else {
        PG8_STAGE(PG8_SB(0, 0), cB, voffB); PG8_STAGE(PG8_SA(0, 0), cA, voffA); PG8_STAGE(PG8_SB(0, 1), cB + hstep, voffB); PG8_STAGE(PG8_SA(0, 1), cA + hstep, voffA);
        if (wr == 1) PG8_BAR;
        PG8_WAIT_V(4); PG8_BAR;
        PG8_STAGE(PG8_SB(1, 0), cB + kstep, voffB); PG8_STAGE(PG8_SA(1, 0), cA + kstep, voffA); PG8_STAGE(PG8_SB(1, 1), cB + hstep + kstep, voffB);
        PG8_WAIT_V(6); PG8_BAR;
    }
    for (;;) {
        const bool has_next = S.next(ui + 1, nxt);
        const char* nA = has_next ? (const char*)g.A + (size_t)nxt.pm * tstep : cA; const char* nB = has_next ? (const char*)g.Bt + (size_t)nxt.pn * tstep : cB;
        for (int t = 0; t < nt; t += 2) {
            const bool last = (t == nt - 2);
            const char* a1 = cA + (size_t)(t + 1) * kstep;
            const char* a2 = last ? nA : cA + (size_t)(t + 2) * kstep; const char* b2 = last ? nB : cB + (size_t)(t + 2) * kstep;
            const char* a3 = a2 + kstep; const char* b3 = b2 + kstep;
            if (last && has_next) S.a_ready(nxt);
            if constexpr (SP2) {
            PG8_LDB(B0, 0, 0); PG8_LDB(B1, 0, 1); PG8_SCHED; PG8_LDA(At, 0, 0); PG8_STAGE(PG8_SA(1, 1), a1 + hstep, voffA);
            PG8_WAIT_V(8); PG8_WAIT_L(0); PG8_BAR; PG8_MMA(0, 0, At, B0); PG8_MMA(0, 1, At, B1); PG8_BAR; PG8_SCHED;
            PG8_LDA(At, 0, 1); PG8_STAGE(PG8_SB(0, 0), b2, voffB); PG8_STAGE(PG8_SB(0, 1), b2 + hstep, voffB); PG8_STAGE(PG8_SA(0, 0), a2, voffA);
            PG8_WAIT_V(8); PG8_WAIT_L(0); PG8_BAR; PG8_MMA(1, 0, At, B0); PG8_MMA(1, 1, At, B1); PG8_BAR; PG8_SCHED;
            PG8_LDB(B0, 1, 0); PG8_LDB(B1, 1, 1); PG8_SCHED; PG8_LDA(At, 1, 0); PG8_STAGE(PG8_SA(0, 1), a2 + hstep, voffA);
            PG8_WAIT_V(8); PG8_WAIT_L(0); PG8_BAR; PG8_MMA(0, 0, At, B0); PG8_MMA(0, 1, At, B1); PG8_BAR; PG8_SCHED;
            PG8_LDA(At, 1, 1); PG8_STAGE(PG8_SB(1, 0), b3, voffB); PG8_STAGE(PG8_SB(1, 1), b3 + hstep, voffB); PG8_STAGE(PG8_SA(1, 0), a3, voffA);
            PG8_WAIT_V(8); PG8_WAIT_L(0); PG8_BAR; PG8_MMA(1, 0, At, B0); PG8_MMA(1, 1, At, B1); PG8_BAR; PG8_SCHED;
            } else {
            PG8_LDB(B0, 0, 0); PG8_SCHED; PG8_LDA(At, 0, 0); PG8_STAGE(PG8_SA(1, 1), a1 + hstep, voffA);
            PG8_WAIT_L(8); PG8_BAR; PG8_WAIT_L(0); PG8_MMA(0, 0, At, B0); PG8_BAR; PG8_SCHED;
            PG8_LDB(B1, 0, 1); PG8_STAGE(PG8_SB(0, 0), b2, voffB);
            PG8_BAR; PG8_WAIT_L(0); PG8_MMA(0, 1, At, B1); PG8_BAR;
            PG8_LDA(At, 0, 1); PG8_STAGE(PG8_SA(0, 0), a2, voffA);
            PG8_BAR; PG8_WAIT_L(0); PG8_MMA(1, 0, At, B0); PG8_BAR; PG8_SCHED;
            PG8_STAGE(PG8_SB(0, 1), b2 + hstep, voffB);
            PG8_WAIT_V(6); PG8_BAR; PG8_MMA(1, 1, At, B1); PG8_BAR;
            PG8_LDB(B0, 1, 0); PG8_SCHED; PG8_LDA(At, 1, 0); PG8_STAGE(PG8_SA(0, 1), a2 + hstep, voffA);
            PG8_WAIT_L(8); PG8_BAR; PG8_WAIT_L(0); PG8_MMA(0, 0, At, B0); PG8_BAR; PG8_SCHED;
            PG8_LDB(B1, 1, 1); PG8_STAGE(PG8_SB(1, 0), b3, voffB);
            PG8_BAR; PG8_WAIT_L(0); PG8_MMA(0, 1, At, B1); PG8_BAR;
            PG8_LDA(At, 1, 1); PG8_STAGE(PG8_SA(1, 0), a3, voffA);
            PG8_BAR; PG8_WAIT_L(0); PG8_MMA(1, 0, At, B0); PG8_BAR; PG8_SCHED;
            PG8_STAGE(PG8_SB(1, 1), b3 + hstep, voffB);
            PG8_WAIT_V(6); PG8_BAR; PG8_MMA(1, 1, At, B1); PG8_BAR;
            }
        }
        if constexpr (ALIGN_EPI) { if (wr == 0) PG8_BAR; }
        if constexpr (!Epi::AFTER_DRAIN) { E(acc, cur, wr, wc, fr, fq); S.done(cur); }
        if (!has_next) break;
#pragma unroll
        for (int a = 0; a < 2; ++a)
#pragma unroll
            for (int b = 0; b < 2; ++b)
#pragma unroll
                for (int m = 0; m < 4; ++m)
#pragma unroll
                    for (int n = 0; n < 2; ++n) acc[a][b][m][n] = (f32x4){0.f, 0.f, 0.f, 0.f};
        cur = nxt; cA = nA; cB = nB; ++ui;
        if constexpr (ALIGN_EPI) { if (wr == 1) PG8_BAR; }
    }
    PG8_WAIT_V(0);
    if constexpr (!ALIGN_EPI) { if (wr == 0) PG8_BAR; }
    PG8_BAR;
    if constexpr (Epi::AFTER_DRAIN) { E.fused(acc, cur, wr, wc, fr, fq, lds, wid, lane); S.done(cur); }
}
template <class Epi, class Sched, bool F16 = false>
__device__ __forceinline__ void gemm_phase_gather(PG8_LAS unsigned char* lds, const Gemm g, const Sched& S, const Epi& E, const PG8_LAS int* tokl) {
    constexpr bool ALIGN_EPI = true, SP2 = true;
    int tid_ = threadIdx.x; asm volatile("" : "+v"(tid_));
    const int tid = tid_, wid = __builtin_amdgcn_readfirstlane(tid >> 6), lane = tid & 63, wr = wid >> 2, wc = wid & 3, fr = lane & 15, fq = lane >> 4;
    const int K = g.K, nt = K / BK;
    unsigned voffB[2]; int Ra[2], Ca[2];
#pragma unroll
    for (int i = 0; i < 2; ++i) { int R, C; stage_rc(tid * 16 + i * 8192, R, C); const int Rb = Epi::PERM ? ((R & ~31) + perm32(R & 31)) : R;
        Ra[i] = R; Ca[i] = C; voffB[i] = (unsigned)(Rb * K + C) * 2u; }
    unsigned vA0[2], vA1[2], vN0[2], vN1[2];
#define PG8_TOKOFF(ui_, V0, V1) do { _Pragma("unroll") for (int i = 0; i < 2; ++i) { const int t0_ = tokl[(ui_) * 256 + Ra[i]], t1_ = tokl[(ui_) * 256 + 128 + Ra[i]]; \
        V0[i] = ((unsigned)t0_ * (unsigned)K + (unsigned)Ca[i]) * 2u; V1[i] = ((unsigned)t1_ * (unsigned)K + (unsigned)Ca[i]) * 2u; } } while (0)
    const size_t kstep = (size_t)(BK * 2);
    const size_t hstep = (size_t)HALF * K * 2;
    const size_t tstep = 2 * hstep;
    const unsigned ldsw = (unsigned)wid * 1024u;
    const int aoff = lds_byte(wr * 64 + fr, fq * 8), boff = lds_byte(wc * 32 + fr, fq * 8);
#define PG8_SA(b, h) (((b) * 2 + (h)) * HTB)
#define PG8_SB(b, h) ((4 + (b) * 2 + (h)) * HTB)
#define PG8_STAGE(bufoff, gbase, voff) do { _Pragma("unroll") for (int _i = 0; _i < 2; ++_i) \
        __builtin_amdgcn_global_load_lds((const unsigned*)((const char*)(gbase) + (voff)[_i]), (PG8_LAS unsigned*)(lds + (bufoff) + ldsw + _i * 8192), 16, 0, 0); } while (0)
#define PG8_LDA(dst, b, h) do { _Pragma("unroll") for (int m = 0; m < 4; ++m) _Pragma("unroll") for (int k = 0; k < 2; ++k) dst[m][k] = *(const PG8_LAS bf16x8*)(lds + PG8_SA(b, h) + aoff + m * 2048 + k * 1024); } while (0)
#define PG8_LDB(dst, b, h) do { _Pragma("unroll") for (int n = 0; n < 2; ++n) _Pragma("unroll") for (int k = 0; k < 2; ++k) dst[n][k] = *(const PG8_LAS bf16x8*)(lds + PG8_SB(b, h) + boff + n * 2048 + k * 1024); } while (0)
#define PG8_MMA(ai, bj, At, Bt) do { __builtin_amdgcn_s_setprio(1); _Pragma("unroll") for (int m = 0; m < 4; ++m) _Pragma("unroll") for (int n = 0; n < 2; ++n) _Pragma("unroll") for (int k = 0; k < 2; ++k) \
        acc[ai][bj][m][n] = mma16<F16>(Bt[n][k], At[m][k], acc[ai][bj][m][n]); __builtin_amdgcn_s_setprio(0); } while (0)
#define PG8_WAIT_V(n) asm volatile("s_waitcnt vmcnt(" #n ")" ::: "memory")
#define PG8_WAIT_L(n) asm volatile("s_waitcnt lgkmcnt(" #n ")" ::: "memory")
#define PG8_BAR __builtin_amdgcn_s_barrier()
#define PG8_SCHED __builtin_amdgcn_sched_barrier(0)
    Unit cur, nxt; int ui = 0;
    if (!S.next(0, cur)) return;
    f32x4 acc[2][2][4][2];
#pragma unroll
    for (int a = 0; a < 2; ++a)
#pragma unroll
        for (int b = 0; b < 2; ++b)
#pragma unroll
            for (int m = 0; m < 4; ++m)
#pragma unroll
                for (int n = 0; n < 2; ++n) acc[a][b][m][n] = (f32x4){0.f, 0.f, 0.f, 0.f};
    bf16x8 At[4][2], B0[2][2], B1[2][2];
    const char* cA = (const char*)g.A; PG8_TOKOFF(0, vA0, vA1); const char* cB = (const char*)g.Bt + (size_t)cur.pn * tstep;
    S.a_ready(cur);
    if constexpr (SP2) {
        PG8_STAGE(PG8_SB(0, 0), cB, voffB); PG8_STAGE(PG8_SB(0, 1), cB + hstep, voffB); PG8_STAGE(PG8_SA(0, 0), cA, vA0); PG8_STAGE(PG8_SA(0, 1), cA, vA1);
        if (wr == 1) PG8_BAR;
        PG8_WAIT_V(2); PG8_BAR;
        PG8_STAGE(PG8_SB(1, 0), cB + kstep, voffB); PG8_STAGE(PG8_SA(1, 0), cA + kstep, vA0); PG8_STAGE(PG8_SB(1, 1), cB + hstep + kstep, voffB);
        PG8_WAIT_V(6); PG8_BAR;
    } else {
        PG8_STAGE(PG8_SB(0, 0), cB, voffB); PG8_STAGE(PG8_SA(0, 0), cA, vA0); PG8_STAGE(PG8_SB(0, 1), cB + hstep, voffB); PG8_STAGE(PG8_SA(0, 1), cA, vA1);
        if (wr == 1) PG8_BAR;
        PG8_WAIT_V(4); PG8_BAR;
        PG8_STAGE(PG8_SB(1, 0), cB + kstep, voffB); PG8_STAGE(PG8_SA(1, 0), cA + kstep, vA0); PG8_STAGE(PG8_SB(1, 1), cB + hstep + kstep, voffB);
        PG8_WAIT_V(6); PG8_BAR;
    }
    for (;;) {
        const bool has_next = S.next(ui + 1, nxt);
        if (has_next) PG8_TOKOFF(ui + 1, vN0, vN1); else { vN0[0] = vA0[0]; vN0[1] = vA0[1]; vN1[0] = vA1[0]; vN1[1] = vA1[1]; }
        const char* nA = cA; const char* nB = has_next ? (const char*)g.Bt + (size_t)nxt.pn * tstep : cB;
        for (int t = 0; t < nt; t += 2) {
            const bool last = (t == nt - 2);
            const char* a1 = cA + (size_t)(t + 1) * kstep;
            const char* a2 = last ? nA : cA + (size_t)(t + 2) * kstep; const char* b2 = last ? nB : cB + (size_t)(t + 2) * kstep;
            const char* a3 = a2 + kstep; const char* b3 = b2 + kstep;
            unsigned v20[2], v21[2];
#pragma unroll
            for (int i = 0; i < 2; ++i) { v20[i] = last ? vN0[i] : vA0[i]; v21[i] = last ? vN1[i] : vA1[i]; }
            if (last && has_next) S.a_ready(nxt);
            if constexpr (SP2) {
            PG8_LDB(B0, 0, 0); PG8_LDB(B1, 0, 1); PG8_SCHED; PG8_LDA(At, 0, 0); PG8_STAGE(PG8_SA(1, 1), a1, vA1);
            PG8_WAIT_V(8); PG8_WAIT_L(0); PG8_BAR; PG8_MMA(0, 0, At, B0); PG8_MMA(0, 1, At, B1); PG8_BAR; PG8_SCHED;
            PG8_LDA(At, 0, 1); PG8_STAGE(PG8_SB(0, 0), b2, voffB); PG8_STAGE(PG8_SB(0, 1), b2 + hstep, voffB); PG8_STAGE(PG8_SA(0, 0), a2, v20);
            PG8_WAIT_V(8); PG8_WAIT_L(0); PG8_BAR; PG8_MMA(1, 0, At, B0); PG8_MMA(1, 1, At, B1); PG8_BAR; PG8_SCHED;
            PG8_LDB(B0, 1, 0); PG8_LDB(B1, 1, 1); PG8_SCHED; PG8_LDA(At, 1, 0); PG8_STAGE(PG8_SA(0, 1), a2, v21);
            PG8_WAIT_V(8); PG8_WAIT_L(0); PG8_BAR; PG8_MMA(0, 0, At, B0); PG8_MMA(0, 1, At, B1); PG8_BAR; PG8_SCHED;
            PG8_LDA(At, 1, 1); PG8_STAGE(PG8_SB(1, 0), b3, voffB); PG8_STAGE(PG8_SB(1, 1), b3 + hstep, voffB); PG8_STAGE(PG8_SA(1, 0), a3, v20);
            PG8_WAIT_V(8); PG8_WAIT_L(0); PG8_BAR; PG8_MMA(1, 0, At, B0); PG8_MMA(1, 1, At, B1); PG8_BAR; PG8_SCHED;
            } else {
            PG8_LDB(B0, 0, 0); PG8_SCHED; PG8_LDA(At, 0, 0); PG8_STAGE(PG8_SA(1, 1), a1, vA1);
            PG8_WAIT_L(8); PG8_BAR; PG8_WAIT_L(0); PG8_MMA(0, 0, At, B0); PG8_BAR; PG8_SCHED;
            PG8_LDB(B1, 0, 1); PG8_STAGE(PG8_SB(0, 0), b2, voffB);
            PG8_BAR; PG8_WAIT_L(0); PG8_MMA(0, 1, At, B1); PG8_BAR;
            PG8_LDA(At, 0, 1); PG8_STAGE(PG8_SA(0, 0), a2, v20);
            PG8_BAR; PG8_WAIT_L(0); PG8_MMA(1, 0, At, B0); PG8_BAR; PG8_SCHED;
            PG8_STAGE(PG8_SB(0, 1), b2 + hstep, voffB);
            PG8_WAIT_V(6); PG8_BAR; PG8_MMA(1, 1, At, B1); PG8_BAR;
            PG8_LDB(B0, 1, 0); PG8_SCHED; PG8_LDA(At, 1, 0); PG8_STAGE(PG8_SA(0, 1), a2, v21);
            PG8_WAIT_L(8); PG8_BAR; PG8_WAIT_L(0); PG8_MMA(0, 0, At, B0); PG8_BAR; PG8_SCHED;
            PG8_LDB(B1, 1, 1); PG8_STAGE(PG8_SB(1, 0), b3, voffB);
            PG8_BAR; PG8_WAIT_L(0); PG8_MMA(0, 1, At, B1); PG8_BAR;
            PG8_LDA(At, 1, 1); PG8_STAGE(PG8_SA(1, 0), a3, v20);
            PG8_BAR; PG8_WAIT_L(0); PG8_MMA(1, 0, At, B0); PG8_BAR; PG8_SCHED;
            PG8_STAGE(PG8_SB(1, 1), b3 + hstep, voffB);
            PG8_WAIT_V(6); PG8_BAR; PG8_MMA(1, 1, At, B1); PG8_BAR;
            }
        }
        if constexpr (ALIGN_EPI) { if (wr == 0) PG8_BAR; }
        if constexpr (!Epi::AFTER_DRAIN) { E(acc, cur, wr, wc, fr, fq); S.done(cur); }
        if (!has_next) break;
#pragma unroll
        for (int a = 0; a < 2; ++a)
#pragma unroll
            for (int b = 0; b < 2; ++b)
#pragma unroll
                for (int m = 0; m < 4; ++m)
#pragma unroll
                    for (int n = 0; n < 2; ++n) acc[a][b][m][n] = (f32x4){0.f, 0.f, 0.f, 0.f};
        cur = nxt; cA = nA; cB = nB; ++ui; vA0[0] = vN0[0]; vA0[1] = vN0[1]; vA1[0] = vN1[0]; vA1[1] = vN1[1];
        if constexpr (ALIGN_EPI) { if (wr == 1) PG8_BAR; }
    }
    PG8_WAIT_V(0);
    if constexpr (!ALIGN_EPI) { if (wr == 0) PG8_BAR; }
    PG8_BAR;
    if constexpr (Epi::AFTER_DRAIN) { E.fused(acc, cur, wr, wc, fr, fq, lds, wid, lane); S.done(cur); }
#undef PG8_TOKOFF
#undef PG8_SA
#undef PG8_SB
#undef PG8_STAGE
#undef PG8_LDA
#undef PG8_LDB
#undef PG8_MMA
#undef PG8_WAIT_V
#undef PG8_WAIT_L
#undef PG8_BAR
#undef PG8_SCHED
}
}

#define LAS __attribute__((address_space(3)))
#define XB_TMO      128
#define XB_XCNT(j)  (256  + 64 * (j))
#define XB_XSUB(j)  (1280 + 64 * (j))
#define XB_XGEN(j)  (2304 + 64 * (j))
#define XB_TOP      3328
#define XB_TOPGEN   3392
#define XCD_BAR_WORDS 3456
#define XB_SPIN_CAP (1u << 22)

__device__ __forceinline__ unsigned xb_ld(unsigned* p)              { return __hip_atomic_load(p, __ATOMIC_RELAXED, __HIP_MEMORY_SCOPE_AGENT); }
__device__ __forceinline__ unsigned xb_add(unsigned* p, unsigned v) { return __hip_atomic_fetch_add(p, v, __ATOMIC_RELAXED, __HIP_MEMORY_SCOPE_AGENT); }
__device__ __forceinline__ unsigned xb_xcc_id() { return (unsigned)__builtin_amdgcn_s_getreg((3 << 11) | 20) & 0xFu; }
#define XB_SPIN(cond, bar) do { unsigned _sp = 0; while (cond) { __builtin_amdgcn_s_sleep(1); \
    if ((++_sp & 255u) == 0u) { if (xb_ld(&(bar)[XB_TMO])) break; if (_sp > XB_SPIN_CAP) { atomicAdd(&(bar)[XB_TMO], 1u); break; } } } } while (0)

struct XcdBarrier {
    unsigned* bar; unsigned x;
    volatile LAS unsigned* st;
};

__device__ __forceinline__ XcdBarrier xcd_barrier_post(unsigned* bar, volatile LAS unsigned* st) {
    XcdBarrier b; b.bar = bar; b.x = xb_xcc_id(); b.st = st;
    if (threadIdx.x == 0) (void)xb_add(&bar[XB_XCNT(b.x)], 1u);
    return b;
}
__device__ __forceinline__ void xcd_barrier_complete(unsigned* bar, unsigned x, unsigned& nloc, unsigned& nx) {
    const unsigned G = gridDim.x * gridDim.y * gridDim.z;
    unsigned sum, cnt, mine, sp = 0u;
    for (;;) {
        sum = 0u; cnt = 0u; mine = 0u;
#pragma unroll
        for (unsigned j = 0; j < 16; ++j) { const unsigned c = xb_ld(&bar[XB_XCNT(j)]); sum += c; cnt += (c > 0u) ? 1u : 0u; mine = (j == x) ? c : mine; }
        if (sum == G) break;
        __builtin_amdgcn_s_sleep(1);
        if ((++sp & 255u) == 0u) { if (xb_ld(&bar[XB_TMO])) break; if (sp > XB_SPIN_CAP) { atomicAdd(&bar[XB_TMO], 1u); break; } }
    }
    nloc = mine > 0u ? mine : 1u; nx = cnt > 0u ? cnt : 1u;
}

__device__ __forceinline__ void xcd_barrier(const XcdBarrier& b) {
    asm volatile("s_waitcnt vmcnt(0)" ::: "memory");
    __syncthreads();
    if (threadIdx.x == 0) {
        unsigned* bar = b.bar;
        __builtin_amdgcn_s_waitcnt(0);
        unsigned nloc = b.st[0], nx = b.st[1];
        if (nloc == 0u) { xcd_barrier_complete(bar, b.x, nloc, nx); b.st[0] = nloc; b.st[1] = nx; }
        const unsigned old = xb_add(&bar[XB_XSUB(b.x)], 1u);
        const unsigned gen = old / nloc;
        if (old + 1u == (gen + 1u) * nloc) {
            __builtin_amdgcn_fence(__ATOMIC_RELEASE, "agent");
            asm volatile("s_waitcnt vmcnt(0)" ::: "memory");
            const unsigned og = xb_add(&bar[XB_TOP], 1u);
            const unsigned tg = og / nx;
            if (og + 1u == (tg + 1u) * nx) xb_add(&bar[XB_TOPGEN], 1u);
            else XB_SPIN(xb_ld(&bar[XB_TOPGEN]) == tg, bar);
            __builtin_amdgcn_fence(__ATOMIC_ACQUIRE, "agent");
            xb_add(&bar[XB_XGEN(b.x)], 1u);
            asm volatile("s_waitcnt vmcnt(0)" ::: "memory");
        } else {
            XB_SPIN(xb_ld(&bar[XB_XGEN(b.x)]) == gen, bar);
            __builtin_amdgcn_fence(__ATOMIC_ACQUIRE, "agent");
            asm volatile("s_waitcnt vmcnt(0)" ::: "memory");
        }
    }
    __syncthreads();
}

constexpr int NWAVES = 8;
constexpr int BATCH = 8, SEQ = 4096, D = 1024, T = BATCH * SEQ, DEPTH = 4;
constexpr int NQKV = 3072, NH4 = 4096, NEXP = 32, FEXP = 512;
constexpr int MAX_TILES = 288;
constexpr float ALPHA = 1.6817928305074292f;
constexpr float LN_EPS = 1e-5f, RMS_EPS = 1e-6f;
constexpr size_t MiB = 1u << 20;
constexpr size_t WS_CTL = 0, CTL_ZERO_BYTES = 1 * MiB;
constexpr size_t WS_ROPE = 1 * MiB;
constexpr size_t WS_LB = 1 * MiB + 256 * 1024;
constexpr size_t WS_KMEAN = 256 * 1024;
constexpr size_t WS_CNTL = 768 * 1024;
constexpr size_t WS_HIST = 1 * MiB + 512 * 1024;
constexpr size_t WS_RE = 2 * MiB;
constexpr size_t WS_RW = 2 * MiB + 256 * 1024;
constexpr size_t WS_POS = 2 * MiB + 512 * 1024;
constexpr size_t WS_WR = 4 * MiB;
constexpr size_t WS_GCNT = 960 * 1024;
constexpr size_t WS_TOK2 = 72 * MiB;
constexpr int TOKCAP = 32768;
constexpr size_t WS_TOK = 5 * MiB;
constexpr size_t WS_X = 8 * MiB;
constexpr size_t WS_XB = 136 * MiB;
constexpr size_t WS_WIN = 200 * MiB, WS_WOUT = 208 * MiB, WS_W13 = 210 * MiB, WS_W2 = 274 * MiB;
constexpr size_t WS_MIX = 306 * MiB;
constexpr size_t WS_O = 562 * MiB;
constexpr size_t WS_QF = 626 * MiB, WS_KF = 690 * MiB, WS_VF = 754 * MiB;
constexpr size_t WS_INTRA = 818 * MiB, WS_INTER = 882 * MiB;
constexpr size_t WS_DEC = 946 * MiB;
constexpr size_t WS_MO = 626 * MiB;
constexpr size_t WS_W13B = 136 * MiB, WS_W2B = 950 * MiB;
constexpr size_t WS_XG = 306 * MiB, WS_HB = 450 * MiB, WS_YB = 522 * MiB;
constexpr size_t WS_END = 982 * MiB;
constexpr int CW_BAR = 4096;
constexpr int CW_CNT = 16384;
constexpr int CW_CUR = 16384 + 512;
constexpr int RING_BYTES = 131072, LDS_BYTES = 163840, MISC_OFF = LDS_BYTES - 4096;

#define GAS __attribute__((address_space(1)))
typedef unsigned short bf16;
typedef unsigned v4u __attribute__((ext_vector_type(4)));
typedef unsigned v2u __attribute__((ext_vector_type(2)));
typedef float f32x4 __attribute__((ext_vector_type(4)));
typedef float f32x8 __attribute__((ext_vector_type(8)));
typedef _Float16 f16x4 __attribute__((ext_vector_type(4)));
typedef _Float16 f16x8 __attribute__((ext_vector_type(8)));
#define LDS_WAIT() asm volatile("s_waitcnt lgkmcnt(0)" ::: "memory")
#define WG_SYNC() asm volatile("s_waitcnt lgkmcnt(0)\n\ts_barrier" ::: "memory")
__device__ __forceinline__ unsigned pk2(float lo, float hi) { typedef float f2_t_ __attribute__((ext_vector_type(2))); typedef __bf16 b2_t_ __attribute__((ext_vector_type(2))); const f2_t_ v = {lo, hi}; return __builtin_bit_cast(unsigned, __builtin_convertvector(v, b2_t_)); }
__device__ __forceinline__ unsigned f2bf(float f) { return pk2(f, f) & 0xffffu; }
__device__ __forceinline__ unsigned pk2h(float lo, float hi) { typedef _Float16 h2_t __attribute__((ext_vector_type(2))); typedef float f2_t __attribute__((ext_vector_type(2))); const f2_t v = {lo, hi}; return __builtin_bit_cast(unsigned, __builtin_convertvector(v, h2_t)); }
__device__ __forceinline__ float bf2f(unsigned short b) { return __builtin_bit_cast(float, (unsigned)b << 16); }
__device__ __forceinline__ float bflo(unsigned w) { return __builtin_bit_cast(float, w << 16); }
__device__ __forceinline__ float bfhi(unsigned w) { return __builtin_bit_cast(float, w & 0xffff0000u); }
__device__ __forceinline__ float wave_sum(float v) {
#pragma unroll
    for (int o = 1; o < 64; o <<= 1) v += __shfl_xor(v, o);
    return v;
}

#define AS_GLOBAL(T, p) ((T)(__attribute__((address_space(1))) unsigned char*)(unsigned char*)(p))
struct Frame {
    LAS unsigned char* lds;
    volatile LAS unsigned* MISC;
    unsigned char* ws;
    int tid, lane, wave, gw, NGW, G;
};
__device__ __forceinline__ const float* in_ptr(const Frame& F, int i) {
    const unsigned lo = __builtin_amdgcn_readfirstlane(F.MISC[512 + 2 * i]), hi = __builtin_amdgcn_readfirstlane(F.MISC[513 + 2 * i]);
    GAS const float* pg_ = (GAS const float*)(((unsigned long long)hi << 32) | lo); asm volatile("" : "+s"(pg_)); return (const float*)pg_;
}
#define LAUNDER_WS() GAS unsigned char* ws0_ = (GAS unsigned char*)F.ws; int bx = blockIdx.x; asm volatile("" : "+s"(ws0_), "+s"(bx)); unsigned char* ws = (unsigned char*)ws0_
#define PHASE_BEGIN() GAS unsigned char* ws0_ = (GAS unsigned char*)F.ws; int tid = threadIdx.x, bx = blockIdx.x; asm volatile("" : "+s"(ws0_), "+v"(tid), "+s"(bx)); unsigned char* ws = (unsigned char*)ws0_; const int lane = tid & 63, gw = bx * NWAVES + __builtin_amdgcn_readfirstlane(tid >> 6); (void)tid; (void)gw; (void)lane; (void)bx
struct CvtItem { const float* src; bf16* dst; int N, K; bool f16; };
constexpr int CVT_MOE = 64 * 256 + 32 * 256;
__device__ __forceinline__ void cvt_decode(Frame& F, unsigned char* ws, int l, int r, CvtItem& it) {
    const int j = l >> 1; const bool even = (l & 1) == 0; const int Nin = even ? NQKV : NH4;
    const int I_in = 16 * (Nin / 32), I_13 = 64 * 256, I_2 = 32 * 256;
    if (r < I_13) { const int mat = r >> 8, e = mat >> 1, which = mat & 1, q = r & 255, kb = q >> 4, n0 = (q & 15) * 32;
        const float* W = in_ptr(F, which ? 14 : 13) + (size_t)(l * NEXP + e) * D * FEXP;
        it.src = W + (size_t)kb * 64 * FEXP + n0; it.dst = (bf16*)(ws + ((l & 1) ? WS_W13B : WS_W13)) + ((size_t)e * 1024 + (size_t)(n0 >> 7) * 256 + (n0 & 127) + which * 128) * D + kb * 64; it.N = FEXP; it.K = D; it.f16 = true; return; } r -= I_13;
    if (r < I_2) { const int e = r >> 8, q = r & 255, kb = q >> 5, n0 = (q & 31) * 32; const float* W = in_ptr(F, 15) + (size_t)(l * NEXP + e) * FEXP * D;
        it.src = W + (size_t)kb * 64 * D + n0; it.dst = (bf16*)(ws + ((l & 1) ? WS_W2B : WS_W2)) + ((size_t)e * 1024 + n0) * FEXP + kb * 64; it.N = D; it.K = FEXP; it.f16 = false; return; } r -= I_2;
    if (r < I_in) { const int nb = Nin / 32, kb = r / nb, n0 = (r % nb) * 32; const float* W = even ? in_ptr(F, 1) + (size_t)j * D * NQKV : in_ptr(F, 3) + (size_t)j * D * NH4;
        it.src = W + (size_t)kb * 64 * Nin + n0; it.dst = (bf16*)(ws + WS_WIN) + (size_t)n0 * D + kb * 64; it.N = Nin; it.K = D; it.f16 = true; return; } r -= I_in;
    { const int kb = r / 32, n0 = (r % 32) * 32; const float* W = (even ? in_ptr(F, 2) : in_ptr(F, 4)) + (size_t)j * D * D;
        it.src = W + (size_t)kb * 64 * D + n0; it.dst = (bf16*)(ws + WS_WOUT) + (size_t)n0 * D + kb * 64; it.N = D; it.K = D; it.f16 = false; }
}
__device__ __forceinline__ void cvt_run(Frame& F, unsigned char* ws, int lane, int l, int first, int end, int stride, int scr_off = -1) {
    LAS float* scr = (LAS float*)(F.lds + (scr_off < 0 ? F.wave * 16384 : scr_off));
    const int kr = lane >> 3, nc = lane & 7, c = lane & 7;
    CvtItem cur, nxt; f32x4 v[8], vn[8];
    int itx = first;
    if (itx < end) { cvt_decode(F, ws, l, itx, cur);
#pragma unroll
        for (int i = 0; i < 8; ++i) v[i] = *(const f32x4*)(cur.src + (size_t)(8 * i + kr) * cur.N + 4 * nc); }
    for (; itx < end; itx += stride) {
        const bool more = itx + stride < end;
        if (more) { cvt_decode(F, ws, l, itx + stride, nxt);
#pragma unroll
            for (int i = 0; i < 8; ++i) vn[i] = *(const f32x4*)(nxt.src + (size_t)(8 * i + kr) * nxt.N + 4 * nc); }
#pragma unroll
        for (int i = 0; i < 8; ++i) { LAS float* sp = scr + (8 * i + kr) * 33 + 4 * nc; sp[0] = v[i].x; sp[1] = v[i].y; sp[2] = v[i].z; sp[3] = v[i].w; }
        LDS_WAIT(); asm volatile("" ::: "memory");
#pragma unroll
        for (int jq = 0; jq < 4; ++jq) { const int n = (lane >> 3) + 8 * jq; const LAS float* s = scr + (8 * c) * 33 + n;
            v4u o; if (cur.f16) { o.x = pk2h(s[0 * 33], s[1 * 33]); o.y = pk2h(s[2 * 33], s[3 * 33]); o.z = pk2h(s[4 * 33], s[5 * 33]); o.w = pk2h(s[6 * 33], s[7 * 33]); }
            else { o.x = pk2(s[0 * 33], s[1 * 33]); o.y = pk2(s[2 * 33], s[3 * 33]); o.z = pk2(s[4 * 33], s[5 * 33]); o.w = pk2(s[6 * 33], s[7 * 33]); }
            *(v4u*)(cur.dst + (size_t)n * cur.K + 8 * c) = o; }
        LDS_WAIT(); asm volatile("" ::: "memory");
        if (more) { cur = nxt;
#pragma unroll
            for (int i = 0; i < 8; ++i) v[i] = vn[i]; }
    }
}
__device__ __forceinline__ int cvt_tail(Frame& F, int l, int ntiles, int vc, int start, int per, int when) {
    const int total = ntiles * 4, maxu = (total + F.G - 1) / F.G, rem = total - (maxu - 1) * F.G, nidle = F.G - rem;
    int covered = start + nidle * per; covered = covered > CVT_MOE ? CVT_MOE : covered;
    if (vc >= rem && ((vc - rem) & 1) == when) { PHASE_BEGIN(); const int r = vc - rem; int e0 = start + r * per, e1 = e0 + per; e1 = e1 > CVT_MOE ? CVT_MOE : e1;
        if (e0 < e1) cvt_run(F, ws, lane, l, e0 + F.wave, e1, NWAVES); }
    return covered;
}
__device__ __forceinline__ void convert_weights(Frame& F, int l, int moe_from) {
    PHASE_BEGIN();
    const int Nin = (l & 1) == 0 ? NQKV : NH4; const int NIT = CVT_MOE + 16 * (Nin / 32) + 16 * 32;
    cvt_run(F, ws, lane, l, moe_from + gw, NIT, F.NGW);
    { const float* wg = in_ptr(F, 9) + (size_t)l * D * 4; const float* we = in_ptr(F, 11) + (size_t)l * D * 32; unsigned char* WR = ws + WS_WR;
      const int gt = gw * 64 + lane;
      if (gt < 32 * 3 * 64) { const int ln = gt & 63, nt = (gt >> 6) % 3, ks = gt / 192; const int n = 16 * nt + (ln & 15), k0 = 32 * ks + 8 * (ln >> 4);
          unsigned hiw[4], low[4];
#pragma unroll
          for (int jj = 0; jj < 8; ++jj) { const int k = k0 + jj; const float w = n < 4 ? wg[(size_t)k * 4 + n] : (n < 36 ? we[(size_t)k * 32 + (n - 4)] : 0.f);
              const unsigned h = f2bf(w); const float rem = w - bf2f((unsigned short)h); const unsigned lo2 = f2bf(rem);
              if (jj & 1) { hiw[jj >> 1] |= h << 16; low[jj >> 1] |= lo2 << 16; } else { hiw[jj >> 1] = h; low[jj >> 1] = lo2; } }
          v4u a, b2; a.x = hiw[0]; a.y = hiw[1]; a.z = hiw[2]; a.w = hiw[3]; b2.x = low[0]; b2.y = low[1]; b2.z = low[2]; b2.w = low[3];
          *(v4u*)(WR + ((size_t)((ks * 3 + nt) * 2 + 0) * 64 + ln) * 16) = a; *(v4u*)(WR + ((size_t)((ks * 3 + nt) * 2 + 1) * 64 + ln) * 16) = b2; } }
}

__device__ __forceinline__ void prologue(Frame& F) {
    PHASE_BEGIN();
    const float* x = in_ptr(F, 0); _Float16* xh = (_Float16*)(ws + WS_X);
    for (int m = gw; m < T; m += F.NGW) {
        const f32x4* xr = (const f32x4*)(x + (size_t)m * D) + lane; f16x4* o8 = (f16x4*)(xh + (size_t)m * D) + lane;
#pragma unroll
        for (int j = 0; j < 4; ++j) o8[64 * j] = __builtin_convertvector(xr[64 * j], f16x4);
    }
    float* rope = (float*)(ws + WS_ROPE);
    const int gt = gw * 64 + lane, NGT = F.NGW * 64;
    for (int idx = gt; idx < SEQ * 8; idx += NGT) { const int pos = idx >> 3, i = idx & 7;
        const float inv = powf(500000.0f, -(float)i / 8.0f); const float ang = (float)pos * inv;
        rope[pos * 16 + i] = cosf(ang); rope[pos * 16 + 8 + i] = sinf(ang); }
    float* lb = (float*)(ws + WS_LB);
    for (int idx = gt; idx < D; idx += NGT) { const float l0 = in_ptr(F, 6)[idx], l1 = in_ptr(F, 6)[D + idx];
        lb[idx] = 0.f; lb[D + idx] = 1.0f / (1.0f + expf(l0 - l1)); }
}


#ifndef PROBE_MASK
#define PROBE_MASK 0
#endif
#define STAMP(g) do { if (PROBE_MASK != 0 && blockIdx.x == 0 && F.tid == 0) { const unsigned now_ = (unsigned)__builtin_amdgcn_s_memrealtime(); F.MISC[600 + (g)] += now_ - F.MISC[599]; F.MISC[599] = now_; } } while (0)
typedef float f32x16 __attribute__((ext_vector_type(16)));
typedef short s16x4 __attribute__((ext_vector_type(4)));
typedef short bf16x8v __attribute__((ext_vector_type(8)));
typedef float f32x2_t __attribute__((ext_vector_type(2))); typedef __bf16 bf16x2_t __attribute__((ext_vector_type(2)));
__device__ __forceinline__ unsigned cvtpk_s(float lo, float hi) { f32x2_t v = {lo, hi}; bf16x2_t b = __builtin_convertvector(v, bf16x2_t); return __builtin_bit_cast(unsigned, b); }
__device__ __forceinline__ int crow(int r, int hi) { return (r & 3) + 8 * (r >> 2) + 4 * hi; }
constexpr float ATT_C2 = 0.125f * 1.4426950408889634f;
__device__ __forceinline__ s16x4 lds_tr(LAS unsigned char* p) { typedef short v4i16_t __attribute__((ext_vector_type(4))); return __builtin_bit_cast(s16x4, __builtin_amdgcn_ds_read_tr16_b64_v4i16((LAS v4i16_t*)p)); }

template <int NS>
__device__ __forceinline__ void softmax_step(f32x16 (&p)[NS], float& m, float& l, f32x16 (&o)[2], bf16x8v (&pf)[NS][2]) {
    float mx = p[0][0];
#pragma unroll
    for (int s = 0; s < NS; ++s)
#pragma unroll
        for (int r = 0; r < 16; ++r) mx = fmaxf(mx, p[s][r]);
    { const auto rr = __builtin_amdgcn_permlane32_swap(__builtin_bit_cast(unsigned, mx), __builtin_bit_cast(unsigned, mx), false, false); float r_; asm("v_max_f32_e32 %0, %1, %2" : "=v"(r_) : "v"(rr[0]), "v"(rr[1])); mx = r_; }
    const float mn = fmaxf(m, mx * ATT_C2);
    const float alpha = __builtin_amdgcn_exp2f(m - mn);
    m = mn; float sum = 0.f;
#pragma unroll
    for (int s = 0; s < NS; ++s)
#pragma unroll
        for (int r = 0; r < 16; ++r) { const float e = __builtin_amdgcn_exp2f(p[s][r] * ATT_C2 - mn); p[s][r] = e; sum += e; }
    l = l * alpha + sum;
    if (!__all(alpha == 1.0f)) {
#pragma unroll
        for (int d0 = 0; d0 < 2; ++d0)
#pragma unroll
            for (int r = 0; r < 16; ++r) o[d0][r] *= alpha;
    }
#pragma unroll
    for (int s = 0; s < NS; ++s)
#pragma unroll
        for (int k = 0; k < 2; ++k) { union { unsigned u[4]; bf16x8v v; } t;
#pragma unroll
            for (int j = 0; j < 4; ++j) t.u[j] = cvtpk_s(p[s][8 * k + 2 * j], p[s][8 * k + 2 * j + 1]);
            pf[s][k] = t.v; }
}
template <int NS>
__device__ __forceinline__ void pv_step(LAS unsigned char* vbase, const unsigned (&vb)[2], const bf16x8v (&pf)[NS][2], f32x16 (&o)[2]) {
    s16x4 lo[2 * NS][2], hi[2 * NS][2];
#pragma unroll
    for (int ks = 0; ks < 2 * NS; ++ks)
#pragma unroll
        for (int d0 = 0; d0 < 2; ++d0) { lo[ks][d0] = lds_tr(vbase + vb[d0] + ks * 2048); hi[ks][d0] = lds_tr(vbase + vb[d0] + ks * 2048 + 1024); }
    asm volatile("s_waitcnt lgkmcnt(0)" ::: "memory"); __builtin_amdgcn_sched_barrier(0);
#pragma unroll
    for (int ks = 0; ks < 2 * NS; ++ks)
#pragma unroll
        for (int d0 = 0; d0 < 2; ++d0) { const bf16x8v vf = {lo[ks][d0][0], lo[ks][d0][1], lo[ks][d0][2], lo[ks][d0][3], hi[ks][d0][0], hi[ks][d0][1], hi[ks][d0][2], hi[ks][d0][3]};
            o[d0] = __builtin_amdgcn_mfma_f32_32x32x16_bf16(vf, pf[ks >> 1][ks & 1], o[d0], 0, 0, 0); }
}
__device__ __forceinline__ void store_ot(bf16* orow  , const f32x16 (&o)[2], float rl, int hi) {
#pragma unroll
    for (int d0 = 0; d0 < 2; ++d0)
#pragma unroll
        for (int rg = 0; rg < 4; ++rg) { v2u w; w.x = cvtpk_s(o[d0][4 * rg] * rl, o[d0][4 * rg + 1] * rl); w.y = cvtpk_s(o[d0][4 * rg + 2] * rl, o[d0][4 * rg + 3] * rl);
            *(v2u*)(orow + 32 * d0 + 8 * rg + 4 * hi) = w; }
}

__device__ __forceinline__ void win_tile(LAS unsigned char* Kt, LAS unsigned char* Vt, const bf16x8v (&qr)[4], int q, int hi, const unsigned (&vb)[2], float& m, float& l, f32x16 (&o)[2], int k0, int tq) {
    bf16x8v kfr[2][4];
#pragma unroll
    for (int sub = 0; sub < 2; ++sub)
#pragma unroll
        for (int d0 = 0; d0 < 4; ++d0) { const int row = 32 * sub + q; kfr[sub][d0] = *(const LAS bf16x8v*)(Kt + row * 128 + (((2 * d0 + hi) ^ ((row >> 1) & 7)) << 4)); }
    asm volatile("s_waitcnt lgkmcnt(0)" ::: "memory"); __builtin_amdgcn_sched_barrier(0);
    f32x16 p[2];
    p[0] = __builtin_amdgcn_mfma_f32_32x32x16_bf16(kfr[0][0], qr[0], f32x16{}, 0, 0, 0); p[1] = __builtin_amdgcn_mfma_f32_32x32x16_bf16(kfr[1][0], qr[0], f32x16{}, 0, 0, 0);
#pragma unroll
    for (int d0 = 1; d0 < 4; ++d0) { p[0] = __builtin_amdgcn_mfma_f32_32x32x16_bf16(kfr[0][d0], qr[d0], p[0], 0, 0, 0); p[1] = __builtin_amdgcn_mfma_f32_32x32x16_bf16(kfr[1][d0], qr[d0], p[1], 0, 0, 0); }
    { const int base_ = tq - k0 - 4 * hi; const unsigned lim_ = (unsigned)(128 < tq ? 128 : tq);
#pragma unroll
      for (int sub = 0; sub < 2; ++sub)
#pragma unroll
          for (int r = 0; r < 16; ++r) { const int dist_ = base_ - (32 * sub + (r & 3) + 8 * (r >> 2)); if ((unsigned)dist_ > lim_) p[sub][r] = -INFINITY; } }
    bf16x8v pf[2][2];
    softmax_step<2>(p, m, l, o, pf);
    pv_step<2>(Vt, vb, pf, o);
}
constexpr int AL_KM = 0, AL_K = 4096, AL_V2 = 4096 + 32768, AL_WV = 40960;
__device__ __forceinline__ void attn_fast_phase(Frame& F, int jl) {
    PHASE_BEGIN();
    const bf16* qkv = (const bf16*)(ws + WS_MIX); bf16* O = (bf16*)(ws + WS_O); const float* km = (const float*)(ws + WS_KMEAN) + (size_t)jl * 65536;
    LAS unsigned char* L = F.lds;
    const int wid = __builtin_amdgcn_readfirstlane(tid >> 6), q = lane & 31, hi = lane >> 5;
    unsigned vb[2];
    { const int i = lane & 15, g1 = (lane >> 4) & 1, sw = (lane >> 3) & 1;
      const unsigned base = (unsigned)((4 * hi + (i >> 2)) * 128 + (2 * g1 + ((i >> 1) & 1)) * 16 + (i & 1) * 8);
      vb[0] = base + (unsigned)((0 ^ sw) * 64); vb[1] = base + (unsigned)((1 ^ sw) * 64); }
    { int* LISTS = (int*)(ws + WS_KF); int* CNTL = (int*)(ws + WS_CNTL) + jl * 16384;
      for (int task = gw; task < 64 * 15 * 8; task += F.NGW) {
          const int grp = task & 7; int r_ = task >> 3;
          if (F.G == 256) { const int k_ = r_ >> 8, i_ = r_ & 255; const int s_ = k_ == 0 ? i_ : (k_ == 1 ? 959 - i_ : (k_ == 2 ? 256 + i_ : 703 - i_)); r_ = (s_ & 63) * 15 + (s_ >> 6); }
          const int own = 1 + (r_ % 15), bh = r_ / 15, b = bh >> 3, h = bh & 7;
          const int tq = 256 * own + 32 * grp + q;
          bf16x8v qr[4];
#pragma unroll
          for (int d0 = 0; d0 < 4; ++d0) qr[d0] = *(const bf16x8v*)(qkv + ((size_t)b * SEQ + tq) * NQKV + h * 64 + 16 * d0 + 8 * hi);
          float g[16];
#pragma unroll
          for (int n = 0; n < 16; ++n) { g[n] = -INFINITY;
              if (n < own) { float sacc = 0.f; const float* kp = km + (size_t)bh * 1024 + n * 64 + 8 * hi;
#pragma unroll
                  for (int d0 = 0; d0 < 4; ++d0) { const f32x4 k0 = *(const f32x4*)(kp + 16 * d0), k1 = *(const f32x4*)(kp + 16 * d0 + 4);
                      sacc += bf2f((unsigned short)qr[d0][0]) * k0.x + bf2f((unsigned short)qr[d0][1]) * k0.y + bf2f((unsigned short)qr[d0][2]) * k0.z + bf2f((unsigned short)qr[d0][3]) * k0.w
                            + bf2f((unsigned short)qr[d0][4]) * k1.x + bf2f((unsigned short)qr[d0][5]) * k1.y + bf2f((unsigned short)qr[d0][6]) * k1.z + bf2f((unsigned short)qr[d0][7]) * k1.w; }
                  g[n] = sacc + __shfl_xor(sacc, 32); } }
          const int nsel = own < 3 ? own : 3; unsigned selmask = 0u;
          for (int sl = 0; sl < nsel; ++sl) { float best = -INFINITY; int bi = 0;
#pragma unroll
              for (int n = 0; n < 16; ++n) if (!((selmask >> n) & 1u) && g[n] > best) { best = g[n]; bi = n; }
              selmask |= 1u << bi;
              int mycnt = 0, rank = 0;
#pragma unroll
              for (int n = 0; n < 15; ++n) { const unsigned long long mk = __ballot(hi == 0 && bi == n); if (lane == n) mycnt = __popcll(mk); if (bi == n) rank = __popcll(mk & ((1ull << lane) - 1ull)); }
              int base = 0;
              if (lane < 15 && mycnt > 0) base = __hip_atomic_fetch_add(CNTL + (bh * 16 + lane) * 16, mycnt, __ATOMIC_RELAXED, __HIP_MEMORY_SCOPE_AGENT);
              const int pos = __shfl(base, bi) + rank;
              if (hi == 0) LISTS[((size_t)bh * 16 + bi) * 4096 + pos] = tq | (sl << 12); }
      } }
    {
        bf16* PART = (bf16*)(ws + WS_QF); float* PML = (float*)(ws + WS_DEC);
        const int srow = tid >> 3, sch = tid & 7;
        const unsigned kst = (unsigned)(srow * 128 + ((sch ^ ((srow >> 1) & 7)) << 4)), vst = (unsigned)(srow * 128 + ((sch ^ (((srow >> 1) & 1) << 2)) << 4));
        v4u rk[6], rv[6];
#define PA_LOAD(u_) do { const int qb_ = (u_) & 15, h_ = ((u_) >> 4) & 7, b_ = (u_) >> 7; const bf16* kb_ = qkv + (size_t)b_ * SEQ * NQKV + 2048 + h_ * 64 + sch * 8; \
            _Pragma("unroll") for (int i6 = 0; i6 < 6; ++i6) { int key_ = 256 * qb_ - 128 + 64 * i6 + srow; key_ = key_ < 0 ? 0 : (key_ > SEQ - 1 ? SEQ - 1 : key_); rk[i6] = *(const v4u*)(kb_ + (size_t)key_ * NQKV); rv[i6] = *(const v4u*)(kb_ + (size_t)key_ * NQKV + 512); } } while (0)
#define PA_STORE() do { _Pragma("unroll") for (int i6 = 0; i6 < 6; ++i6) { *(LAS v4u*)(L + AL_K + i6 * 8192 + kst) = rk[i6]; *(LAS v4u*)(L + AL_K + 49152 + i6 * 8192 + vst) = rv[i6]; } } while (0)
        PA_LOAD(bx * 4); PA_STORE();
        WG_SYNC();
        for (int k4 = 0; k4 < 4; ++k4) {
            const int u = bx * 4 + k4, qb = u & 15, h = (u >> 4) & 7, b = u >> 7;
            if (k4 < 3) PA_LOAD(u + 1);
            const size_t rowbase = (size_t)b * SEQ; const int tq = 256 * qb + 32 * wid + q;
            bf16x8v qr[4];
#pragma unroll
            for (int d0 = 0; d0 < 4; ++d0) qr[d0] = *(const bf16x8v*)(qkv + (rowbase + tq) * NQKV + 1536 + h * 64 + 16 * d0 + 8 * hi);
            float m = -1e30f, l = 0.f; f32x16 o[2]; o[0] = f32x16{}; o[1] = f32x16{};
            for (int jt = (wid >> 1); jt <= (wid >> 1) + 2; ++jt) win_tile(L + AL_K + jt * 8192, L + AL_K + 49152 + jt * 8192, qr, q, hi, vb, m, l, o, 256 * qb - 128 + 64 * jt, tq);
            { const float lt = l + __shfl_xor(l, 32); bf16* pp = PART + ((size_t)(b * 8 + h) * SEQ + tq) * 64 + hi * 32;
#pragma unroll
              for (int d0 = 0; d0 < 2; ++d0)
#pragma unroll
                  for (int rg2 = 0; rg2 < 2; ++rg2) { v4u w; w.x = cvtpk_s(o[d0][8 * rg2], o[d0][8 * rg2 + 1]); w.y = cvtpk_s(o[d0][8 * rg2 + 2], o[d0][8 * rg2 + 3]); w.z = cvtpk_s(o[d0][8 * rg2 + 4], o[d0][8 * rg2 + 5]); w.w = cvtpk_s(o[d0][8 * rg2 + 6], o[d0][8 * rg2 + 7]);
                      *(v4u*)(pp + 16 * d0 + 8 * rg2) = w; }
              if (hi == 0) { float* ml = PML + ((size_t)(b * 8 + h) * SEQ + tq) * 2; ml[0] = m; ml[1] = lt; } }
            WG_SYNC();
            if (k4 < 3) { PA_STORE(); WG_SYNC(); }
        }
#undef PA_LOAD
#undef PA_STORE
    }
}
#define DIL_LOAD(k0_, stride_, KF, VV) do { int kp_ = (k0_) + q * (stride_); kp_ = kp_ < 0 ? 0 : (kp_ > SEQ - 1 ? SEQ - 1 : kp_); \
                _Pragma("unroll") for (int d0 = 0; d0 < 4; ++d0) KF[d0] = *(const bf16x8v*)(Kb + (size_t)kp_ * NQKV + 16 * d0 + 8 * hi); \
                _Pragma("unroll") for (int jj = 0; jj < 4; ++jj) { int vp_ = (k0_) + (vr0 + 8 * jj) * (stride_); vp_ = vp_ < 0 ? 0 : (vp_ > SEQ - 1 ? SEQ - 1 : vp_); VV[jj] = *(const v4u*)(Vb + (size_t)vp_ * NQKV + vch * 8); } } while (0)
#define DIL_BODY(k0, stride, W) do { f32x16 p[1]; p[0] = f32x16{}; \
                _Pragma("unroll") for (int d0 = 0; d0 < 4; ++d0) p[0] = __builtin_amdgcn_mfma_f32_32x32x16_bf16(kf[d0], qr[d0], p[0], 0, 0, 0); \
                _Pragma("unroll") for (int r = 0; r < 16; ++r) { const int pos = (k0) + crow(r, hi) * (stride), dist = tq - pos; if (pos < 0 || dist < 0 || dist > (W)) p[0][r] = -INFINITY; } \
                _Pragma("unroll") for (int jj = 0; jj < 4; ++jj) { const int row = vr0 + 8 * jj; *(LAS v4u*)(Vt + row * 128 + ((vch ^ (((row >> 1) & 1) << 2)) << 4)) = vv[jj]; } \
                bf16x8v pf[1][2]; softmax_step<1>(p, m, l, o, pf); pv_step<1>(Vt, vb, pf, o); } while (0)
__device__ __forceinline__ void moba_tile(LAS unsigned char* Kt, LAS unsigned char* Vt, const bf16x8v (&qr)[4], int q, int hi, const unsigned (&vb)[2], float& m, float& l, f32x16 (&o)[2], int diag, int qrel) {
    bf16x8v kfr[2][4];
#pragma unroll
    for (int sub = 0; sub < 2; ++sub)
#pragma unroll
        for (int d0 = 0; d0 < 4; ++d0) { const int row = 32 * sub + q; kfr[sub][d0] = *(const LAS bf16x8v*)(Kt + row * 128 + (((2 * d0 + hi) ^ ((row >> 1) & 7)) << 4)); }
    asm volatile("s_waitcnt lgkmcnt(0)" ::: "memory"); __builtin_amdgcn_sched_barrier(0);
    f32x16 p[2];
    p[0] = __builtin_amdgcn_mfma_f32_32x32x16_bf16(kfr[0][0], qr[0], f32x16{}, 0, 0, 0); p[1] = __builtin_amdgcn_mfma_f32_32x32x16_bf16(kfr[1][0], qr[0], f32x16{}, 0, 0, 0);
#pragma unroll
    for (int d0 = 1; d0 < 4; ++d0) { p[0] = __builtin_amdgcn_mfma_f32_32x32x16_bf16(kfr[0][d0], qr[d0], p[0], 0, 0, 0); p[1] = __builtin_amdgcn_mfma_f32_32x32x16_bf16(kfr[1][d0], qr[d0], p[1], 0, 0, 0); }
    if (diag >= 0) {
#pragma unroll
        for (int sub = 0; sub < 2; ++sub)
#pragma unroll
            for (int r = 0; r < 16; ++r) if (64 * diag + 32 * sub + crow(r, hi) > qrel) p[sub][r] = -INFINITY;
    }
    bf16x8v pf[2][2];
    softmax_step<2>(p, m, l, o, pf);
    pv_step<2>(Vt, vb, pf, o);
}
__device__ __forceinline__ void attn_gather_phase(Frame& F, int jl) {
    PHASE_BEGIN();
    const bf16* qkv = (const bf16*)(ws + WS_MIX); const int* LISTS = (const int*)(ws + WS_KF); const int* CNTL = (const int*)(ws + WS_CNTL) + jl * 16384;
    bf16* PO = (bf16*)(ws + WS_VF); float* PMLG = (float*)(ws + WS_INTER);
    LAS unsigned char* L = F.lds;
    const int wid = __builtin_amdgcn_readfirstlane(tid >> 6), q = lane & 31, hi = lane >> 5;
    unsigned vb[2];
    { const int i = lane & 15, g1 = (lane >> 4) & 1, sw = (lane >> 3) & 1;
      const unsigned base = (unsigned)((4 * hi + (i >> 2)) * 128 + (2 * g1 + ((i >> 1) & 1)) * 16 + (i & 1) * 8);
      vb[0] = base + (unsigned)((0 ^ sw) * 64); vb[1] = base + (unsigned)((1 ^ sw) * 64); }
    const int bh = (bx & 7) + 8 * (bx >> 5), gsel = (bx >> 3) & 3;
    if (bh < 64) {
        const int b = bh >> 3, h = bh & 7; const size_t rowbase = (size_t)b * SEQ;
        const unsigned code = gsel == 0 ? 0xEDCB0u : (gsel == 1 ? 0xA51u : (gsel == 2 ? 0x942u : 0x8763u)); const int nblk = gsel == 0 ? 5 : (gsel == 3 ? 4 : 3);
        const int srow = tid >> 3, sch = tid & 7;
        const bf16* kg = qkv + rowbase * NQKV + 512 + h * 64 + sch * 8 + (size_t)srow * NQKV; const bf16* vg = kg + 512;
        const unsigned kst = (unsigned)(srow * 128 + ((sch ^ ((srow >> 1) & 7)) << 4)), vst = (unsigned)(srow * 128 + ((sch ^ (((srow >> 1) & 1) << 2)) << 4));
        v4u rk[4], rv[4];
#define MOBA_LOADB(blk) do { _Pragma("unroll") for (int i4 = 0; i4 < 4; ++i4) { rk[i4] = *(const v4u*)(kg + (size_t)(256 * (blk) + 64 * i4) * NQKV); rv[i4] = *(const v4u*)(vg + (size_t)(256 * (blk) + 64 * i4) * NQKV); } } while (0)
#define MOBA_STOREB(bufi) do { _Pragma("unroll") for (int i4 = 0; i4 < 4; ++i4) { *(LAS v4u*)(L + AL_K + (bufi) * 65536 + i4 * 8192 + kst) = rk[i4]; *(LAS v4u*)(L + AL_V2 + (bufi) * 65536 + i4 * 8192 + vst) = rv[i4]; } } while (0)
        MOBA_LOADB((int)(code & 15u)); MOBA_STOREB(0);
        WG_SYNC();
        for (int bi = 0; bi < nblk; ++bi) {
            const int cur = bi & 1, n = (int)((code >> (4 * bi)) & 15u);
            if (bi + 1 < nblk) MOBA_LOADB((int)((code >> (4 * (bi + 1))) & 15u));
            int cnt = CNTL[(bh * 16 + n) * 16]; cnt = cnt > 3840 ? 3840 : cnt; const int ntile = (cnt + 31) >> 5;
            const int* lst = LISTS + ((size_t)bh * 16 + n) * 4096;
            bf16x8v qn[4]; int en = 0; bool vn = false;
#define GATH_FETCH(tile_) do { const int idx_ = 32 * (tile_) + q; vn = idx_ < cnt; en = lst[vn ? idx_ : 0]; const int t_ = en & 4095; \
                _Pragma("unroll") for (int d0 = 0; d0 < 4; ++d0) qn[d0] = *(const bf16x8v*)(qkv + (rowbase + t_) * NQKV + h * 64 + 16 * d0 + 8 * hi); } while (0)
            if (wid < ntile) GATH_FETCH(wid);
            for (int tile = wid; tile < ntile; tile += NWAVES) {
                const bool valid = vn; const int t = en & 4095, slot = (en >> 12) & 3;
                bf16x8v qr[4];
#pragma unroll
                for (int d0 = 0; d0 < 4; ++d0) qr[d0] = qn[d0];
                if (tile + NWAVES < ntile) GATH_FETCH(tile + NWAVES);
                float m = -1e30f, l = 0.f; f32x16 o[2]; o[0] = f32x16{}; o[1] = f32x16{};
                for (int jt = 0; jt < 4; ++jt) moba_tile(L + AL_K + cur * 65536 + jt * 8192, L + AL_V2 + cur * 65536 + jt * 8192, qr, q, hi, vb, m, l, o, -1, 0);
                const float lt = l + __shfl_xor(l, 32);
                if (valid) { bf16* pp = PO + (((size_t)bh * SEQ + t) * 3 + slot) * 64 + hi * 32;
#pragma unroll
                    for (int d0 = 0; d0 < 2; ++d0)
#pragma unroll
                        for (int rg2 = 0; rg2 < 2; ++rg2) { v4u w; w.x = cvtpk_s(o[d0][8 * rg2], o[d0][8 * rg2 + 1]); w.y = cvtpk_s(o[d0][8 * rg2 + 2], o[d0][8 * rg2 + 3]); w.z = cvtpk_s(o[d0][8 * rg2 + 4], o[d0][8 * rg2 + 5]); w.w = cvtpk_s(o[d0][8 * rg2 + 6], o[d0][8 * rg2 + 7]);
                            *(v4u*)(pp + 16 * d0 + 8 * rg2) = w; }
                    if (hi == 0) { float* ml = PMLG + (((size_t)bh * SEQ + t) * 3 + slot) * 2; ml[0] = m; ml[1] = lt; } }
            }
#undef GATH_FETCH
            if (bi + 1 < nblk) MOBA_STOREB(cur ^ 1);
            WG_SYNC();
        }
    }
}
__device__ __forceinline__ void attn_own_phase(Frame& F) {
    PHASE_BEGIN();
    const bf16* qkv = (const bf16*)(ws + WS_MIX); bf16* O = (bf16*)(ws + WS_O); const bf16* PO = (const bf16*)(ws + WS_VF); const float* PMLG = (const float*)(ws + WS_INTER);
    LAS unsigned char* L = F.lds;
    const int wid = __builtin_amdgcn_readfirstlane(tid >> 6), q = lane & 31, hi = lane >> 5;
    unsigned vb[2];
    { const int i = lane & 15, g1 = (lane >> 4) & 1, sw = (lane >> 3) & 1;
      const unsigned base = (unsigned)((4 * hi + (i >> 2)) * 128 + (2 * g1 + ((i >> 1) & 1)) * 16 + (i & 1) * 8);
      vb[0] = base + (unsigned)((0 ^ sw) * 64); vb[1] = base + (unsigned)((1 ^ sw) * 64); }
    const int bh = (bx & 7) + 8 * (bx >> 5), s4 = (bx >> 3) & 3;
    if (bh < 64) {
        const int b = bh >> 3, h = bh & 7; const size_t rowbase = (size_t)b * SEQ;
        const int srow = tid >> 3, sch = tid & 7;
        const bf16* kg = qkv + rowbase * NQKV + 512 + h * 64 + sch * 8 + (size_t)srow * NQKV; const bf16* vg = kg + 512;
        const unsigned kst = (unsigned)(srow * 128 + ((sch ^ ((srow >> 1) & 7)) << 4)), vst = (unsigned)(srow * 128 + ((sch ^ (((srow >> 1) & 1) << 2)) << 4));
        v4u rk[4], rv[4];
#define OWN_OF(k4_) ((k4_) == 0 ? s4 : ((k4_) == 1 ? 7 - s4 : ((k4_) == 2 ? 8 + s4 : 15 - s4)))
        MOBA_LOADB(OWN_OF(0)); MOBA_STOREB(0);
        WG_SYNC();
        for (int k4 = 0; k4 < 4; ++k4) {
            const int own = OWN_OF(k4), cur = k4 & 1;
            if (k4 < 3) MOBA_LOADB(OWN_OF(k4 + 1));
            const int qrel = 32 * wid + q, tq = 256 * own + qrel;
            bf16x8v qr[4];
#pragma unroll
            for (int d0 = 0; d0 < 4; ++d0) qr[d0] = *(const bf16x8v*)(qkv + (rowbase + tq) * NQKV + h * 64 + 16 * d0 + 8 * hi);
            const int nsel = own < 3 ? own : 3;
            v4u pw[3][4]; float pm_[3], pl_[3];
#pragma unroll
            for (int sl = 0; sl < 3; ++sl) if (sl < nsel) { const bf16* pp = PO + (((size_t)bh * SEQ + tq) * 3 + sl) * 64 + hi * 32; const float* ml = PMLG + (((size_t)bh * SEQ + tq) * 3 + sl) * 2;
#pragma unroll
                for (int c4 = 0; c4 < 4; ++c4) pw[sl][c4] = *(const v4u*)(pp + 8 * c4);
                pm_[sl] = ml[0]; pl_[sl] = ml[1]; }
            float m = -1e30f, l = 0.f; f32x16 o[2]; o[0] = f32x16{}; o[1] = f32x16{};
            for (int jt = 0; jt <= (wid >> 1); ++jt) moba_tile(L + AL_K + cur * 65536 + jt * 8192, L + AL_V2 + cur * 65536 + jt * 8192, qr, q, hi, vb, m, l, o, jt == (wid >> 1) ? jt : -1, qrel);
#pragma unroll
            for (int sl = 0; sl < 3; ++sl) if (sl < nsel) {
                const float mn = fmaxf(m, pm_[sl]); const float a = __builtin_amdgcn_exp2f(m - mn), c = __builtin_amdgcn_exp2f(pm_[sl] - mn); m = mn;
                l = l * a + (hi == 0 ? pl_[sl] * c : 0.f);
#pragma unroll
                for (int d0 = 0; d0 < 2; ++d0)
#pragma unroll
                    for (int rg2 = 0; rg2 < 2; ++rg2) { const v4u w = pw[sl][2 * d0 + rg2]; const unsigned wu[4] = {w.x, w.y, w.z, w.w};
#pragma unroll
                        for (int k2 = 0; k2 < 4; ++k2) { o[d0][8 * rg2 + 2 * k2] = o[d0][8 * rg2 + 2 * k2] * a + bflo(wu[k2]) * c; o[d0][8 * rg2 + 2 * k2 + 1] = o[d0][8 * rg2 + 2 * k2 + 1] * a + bfhi(wu[k2]) * c; } } }
            { const float lt = l + __shfl_xor(l, 32); store_ot(O + (rowbase + tq) * D + h * 64, o, 1.0f / lt, hi); }
            if (k4 < 3) MOBA_STOREB(cur ^ 1);
            WG_SYNC();
        }
#undef OWN_OF
    }
#undef MOBA_LOADB
#undef MOBA_STOREB
}
__device__ __forceinline__ void attn_dil2_phase(Frame& F, int cvt_layer) {
    PHASE_BEGIN();
    int cvt_next = gw;
    const bf16* qkv = (const bf16*)(ws + WS_MIX); bf16* O = (bf16*)(ws + WS_O);
    const bf16* PART = (const bf16*)(ws + WS_QF); const float* PML = (const float*)(ws + WS_DEC);
    LAS unsigned char* L = F.lds;
    const int wid = __builtin_amdgcn_readfirstlane(tid >> 6), q = lane & 31, hi = lane >> 5;
    unsigned vb[2];
    { const int i = lane & 15, g1 = (lane >> 4) & 1, sw = (lane >> 3) & 1;
      const unsigned base = (unsigned)((4 * hi + (i >> 2)) * 128 + (2 * g1 + ((i >> 1) & 1)) * 16 + (i & 1) * 8);
      vb[0] = base + (unsigned)((0 ^ sw) * 64); vb[1] = base + (unsigned)((1 ^ sw) * 64); }
    LAS unsigned char* Vt = L + AL_WV + wid * 4096;
    const int vch = lane & 7, vr0 = lane >> 3;
    for (int task = gw; task < BATCH * 8 * 16 * 8; task += F.NGW) {
        const int iw = (task + task / F.NGW) & 7, r16 = (task >> 3) & 15, h = (task >> 7) & 7, b = task >> 10;
        const size_t rowbase = (size_t)b * SEQ; const int tlo = r16 + 512 * iw, tq = tlo + 16 * q;
        const bf16* Kb = qkv + rowbase * NQKV + 2048 + h * 64; const bf16* Vb = qkv + rowbase * NQKV + 2560 + h * 64;
        bf16x8v qr[4];
#pragma unroll
        for (int d0 = 0; d0 < 4; ++d0) qr[d0] = *(const bf16x8v*)(qkv + (rowbase + tq) * NQKV + 1536 + h * 64 + 16 * d0 + 8 * hi);
        float m, l; f32x16 o[2];
        { const bf16* pp = PART + ((size_t)(b * 8 + h) * SEQ + tq) * 64 + hi * 32; const float* ml = PML + ((size_t)(b * 8 + h) * SEQ + tq) * 2;
#pragma unroll
          for (int d0 = 0; d0 < 2; ++d0)
#pragma unroll
              for (int rg2 = 0; rg2 < 2; ++rg2) { const v4u w = *(const v4u*)(pp + 16 * d0 + 8 * rg2);
                  o[d0][8 * rg2] = bflo(w.x); o[d0][8 * rg2 + 1] = bfhi(w.x); o[d0][8 * rg2 + 2] = bflo(w.y); o[d0][8 * rg2 + 3] = bfhi(w.y);
                  o[d0][8 * rg2 + 4] = bflo(w.z); o[d0][8 * rg2 + 5] = bfhi(w.z); o[d0][8 * rg2 + 6] = bflo(w.w); o[d0][8 * rg2 + 7] = bfhi(w.w); }
          m = ml[0]; l = hi == 0 ? ml[1] : 0.f; }
#define DIL_TILE(ti_, stride_, W_, k0_) do { const int br_ = (ti_) < 8 ? 1 : 2; stride_ = br_ == 1 ? 4 : 16; W_ = 128 * stride_; const int kt_ = (ti_) - (br_ == 1 ? 0 : 8); k0_ = tlo - W_ + 32 * kt_ * stride_; } while (0)
        bf16x8v kfa[4], kfb[4]; v4u vva[4], vvb[4];
        { int st_, W_, k0_; DIL_TILE(0, st_, W_, k0_); if (k0_ + 31 * st_ >= 0) DIL_LOAD(k0_, st_, kfa, vva); DIL_TILE(1, st_, W_, k0_); if (k0_ + 31 * st_ >= 0) DIL_LOAD(k0_, st_, kfb, vvb); }
#define DILB_STEP(ti, KFS, VVS) do { if ((ti) < 13) { bf16x8v kf[4]; v4u vv[4]; int stride, W, k0; DIL_TILE((ti), stride, W, k0); \
            _Pragma("unroll") for (int d0 = 0; d0 < 4; ++d0) { kf[d0] = KFS[d0]; vv[d0] = VVS[d0]; } \
            if ((ti) + 2 < 13) { int st_, W_, k0_; DIL_TILE((ti) + 2, st_, W_, k0_); if (k0_ + 31 * st_ >= 0) DIL_LOAD(k0_, st_, KFS, VVS); } \
            if (k0 + 31 * stride >= 0) DIL_BODY(k0, stride, W); } } while (0)
        for (int ti = 0; ti < 13; ti += 2) { DILB_STEP(ti, kfa, vva); DILB_STEP(ti + 1, kfb, vvb); }
#undef DILB_STEP
#undef DIL_TILE
#undef DIL_LOAD
#undef DIL_BODY
        { const float lt = l + __shfl_xor(l, 32); store_ot(O + (rowbase + tq) * D + 512 + h * 64, o, 1.0f / lt, hi); }
        if (cvt_layer >= 0) { const int e_ = cvt_next + 3 * F.NGW; cvt_run(F, ws, lane, cvt_layer, cvt_next, e_ < CVT_MOE ? e_ : CVT_MOE, F.NGW, 73728 + wid * 8448); cvt_next = e_; }
    }
    if (cvt_layer >= 0) cvt_run(F, ws, lane, cvt_layer, cvt_next, CVT_MOE, F.NGW, 73728 + wid * 8448);
}

constexpr size_t HM_STRIDE = (size_t)64 * SEQ * 128;
constexpr int HL_QS = 0, HL_KS = 17408, HL_KT = 34816, HL_VT = 53248, HL_SEG = 71680, HL_VT2 = 73728;
__device__ __forceinline__ void hgrn_h1_phase(Frame& F, int j) {
    PHASE_BEGIN();
    const bf16* H = (const bf16*)(ws + WS_MIX); const float* lbp = (const float*)(ws + WS_LB) + (size_t)j * D;
    bf16* INTRA = (bf16*)(ws + WS_INTRA); unsigned char* QF = ws + WS_QF; unsigned char* KF = ws + WS_KF; unsigned char* VF = ws + WS_VF; float* DEC = (float*)(ws + WS_DEC);
    LAS unsigned char* L = F.lds;
    const int wid = __builtin_amdgcn_readfirstlane(tid >> 6), q = lane & 31, hi = lane >> 5;
    const int d = tid & 127, tq4 = tid >> 7;
    unsigned short rq[16], rz[16], rv[16];
#define H1_LOAD(u_) do { const int c_ = (u_) & 63, bh_ = (u_) >> 6; const bf16* hp_ = H + ((size_t)bh_ * SEQ + 64 * c_ + 16 * tq4) * 128 + d;     \
        _Pragma("unroll") for (int k = 0; k < 16; ++k) { rq[k] = hp_[(size_t)k * 128]; rz[k] = hp_[(size_t)k * 128 + HM_STRIDE]; rv[k] = hp_[(size_t)k * 128 + 2 * HM_STRIDE]; } } while (0)
    if (bx < BATCH * 8 * 64) H1_LOAD(bx);
    int vto = HL_VT;
    for (int unit = bx; unit < BATCH * 8 * 64; unit += F.G, vto = (HL_VT + HL_VT2) - vto) {
        const int c = unit & 63, bh = unit >> 6, b = bh >> 3, h = bh & 7;
        const size_t row0 = (size_t)b * SEQ + 64 * c;
        const float lbv = lbp[h * 128 + d];
        float bb[16], kk[16]; float run = 0.f;
#pragma unroll
        for (int k = 0; k < 16; ++k) { const float z = bf2f(rz[k]); const float sg = __builtin_amdgcn_rcpf(1.0f + __expf(-z)); const float f = lbv + (1.0f - lbv) * sg;
            kk[k] = (1.0f - lbv) * (1.0f - sg); run += __logf(f); bb[k] = run; }
        ((LAS float*)(L + HL_SEG))[tq4 * 128 + d] = run;
        { v4u w0, w1; w0.x = rv[0] | ((unsigned)rv[1] << 16); w0.y = rv[2] | ((unsigned)rv[3] << 16); w0.z = rv[4] | ((unsigned)rv[5] << 16); w0.w = rv[6] | ((unsigned)rv[7] << 16);
          w1.x = rv[8] | ((unsigned)rv[9] << 16); w1.y = rv[10] | ((unsigned)rv[11] << 16); w1.z = rv[12] | ((unsigned)rv[13] << 16); w1.w = rv[14] | ((unsigned)rv[15] << 16);
          *(LAS v4u*)(L + vto + d * 144 + tq4 * 32) = w0; *(LAS v4u*)(L + vto + d * 144 + tq4 * 32 + 16) = w1; }
        WG_SYNC();
        { const LAS float* sg_ = (const LAS float*)(L + HL_SEG) + d; const float s0 = sg_[0], s1 = sg_[128], s2 = sg_[256], s3 = sg_[384];
          const float pre = (tq4 > 0 ? s0 : 0.f) + (tq4 > 1 ? s1 : 0.f) + (tq4 > 2 ? s2 : 0.f); const float bref = s0 + s1, blast = (s0 + s1) + (s2 + s3); const float ebl = __expf(blast - bref);
          unsigned kt[8];
#pragma unroll
          for (int k = 0; k < 16; ++k) { const float bk = pre + bb[k]; const float e1 = __expf(bk - bref), e2 = __builtin_amdgcn_rcpf(e1), e3 = e2 * ebl;
              const int t = 16 * tq4 + k;
              *(LAS unsigned short*)(L + HL_QS + t * 272 + d * 2) = (unsigned short)f2bf(bf2f(rq[k]) * e1);
              *(LAS unsigned short*)(L + HL_KS + t * 272 + d * 2) = (unsigned short)f2bf(kk[k] * e2);
              const unsigned kb = f2bf(kk[k] * e3); if (k & 1) kt[k >> 1] |= kb << 16; else kt[k >> 1] = kb; }
          { v4u w0, w1; w0.x = kt[0]; w0.y = kt[1]; w0.z = kt[2]; w0.w = kt[3]; w1.x = kt[4]; w1.y = kt[5]; w1.z = kt[6]; w1.w = kt[7];
            *(LAS v4u*)(L + HL_KT + d * 144 + tq4 * 32) = w0; *(LAS v4u*)(L + HL_KT + d * 144 + tq4 * 32 + 16) = w1; }
          if (tq4 == 0) { DEC[(size_t)unit * 256 + d] = __expf(blast); DEC[(size_t)unit * 256 + 128 + d] = __expf(bref); } }
        WG_SYNC();
        if (unit + F.G < BATCH * 8 * 64) H1_LOAD(unit + F.G);
        { const int et = wid & 3, ti = wid >> 2; f32x16 intra = f32x16{};
          for (int tj = 0; tj <= ti; ++tj) { f32x16 acc = f32x16{};
#pragma unroll
              for (int s = 0; s < 8; ++s) { const bf16x8v kf = *(const LAS bf16x8v*)(L + HL_KS + (32 * tj + q) * 272 + (16 * s + 8 * hi) * 2), qf = *(const LAS bf16x8v*)(L + HL_QS + (32 * ti + q) * 272 + (16 * s + 8 * hi) * 2);
                  acc = __builtin_amdgcn_mfma_f32_32x32x16_bf16(kf, qf, acc, 0, 0, 0); }
              if (tj == ti) {
#pragma unroll
                  for (int r = 0; r < 16; ++r) if (crow(r, hi) > q) acc[r] = 0.f;
              }
#pragma unroll
              for (int s2 = 0; s2 < 2; ++s2) { union { unsigned u[4]; bf16x8v v; } pk;
#pragma unroll
                  for (int jj = 0; jj < 4; ++jj) pk.u[jj] = cvtpk_s(acc[8 * s2 + 2 * jj], acc[8 * s2 + 2 * jj + 1]);
                  const LAS unsigned char* vp = L + vto + (32 * et + q) * 144 + (32 * tj + 16 * s2 + 4 * hi) * 2;
                  union { v2u u2[2]; bf16x8v v; } vf; vf.u2[0] = *(const LAS v2u*)vp; vf.u2[1] = *(const LAS v2u*)(vp + 16);
                  intra = __builtin_amdgcn_mfma_f32_32x32x16_bf16(vf.v, pk.v, intra, 0, 0, 0); } }
          bf16* op = INTRA + (row0 + 32 * ti + q) * D + h * 128 + 32 * et;
#pragma unroll
          for (int rg = 0; rg < 4; ++rg) { v2u w; w.x = cvtpk_s(intra[4 * rg], intra[4 * rg + 1]); w.y = cvtpk_s(intra[4 * rg + 2], intra[4 * rg + 3]); *(v2u*)(op + 8 * rg + 4 * hi) = w; } }
#pragma unroll
        for (int k6 = 0; k6 < 6; ++k6) { const int fi = wid + 8 * k6; v4u w;
            if (fi < 16) { const int ti = fi >> 3, Ts = fi & 7;
                const LAS unsigned char* p = L + HL_QS + (32 * ti + q) * 272 + (16 * Ts + 4 * hi) * 2; const v2u a = *(const LAS v2u*)p, c2 = *(const LAS v2u*)(p + 16);
                w.x = a.x; w.y = a.y; w.z = c2.x; w.w = c2.y; *(v4u*)(QF + ((size_t)unit * 16 + fi) * 1024 + lane * 16) = w; }
            else if (fi < 32) { const int f2 = fi - 16, T4 = f2 >> 2, s = f2 & 3;
                w = *(const LAS v4u*)(L + HL_KT + (32 * T4 + q) * 144 + (16 * s + 8 * hi) * 2); *(v4u*)(KF + ((size_t)unit * 16 + f2) * 1024 + lane * 16) = w; }
            else { const int f2 = fi - 32, es = f2 >> 2, s = f2 & 3;
                w = *(const LAS v4u*)(L + vto + (32 * es + q) * 144 + (16 * s + 8 * hi) * 2); *(v4u*)(VF + ((size_t)unit * 16 + f2) * 1024 + lane * 16) = w; } }
    }
}

constexpr int SL_FB = 0, SL_FBSZ = 37888  , SL_PB = 2 * SL_FBSZ, SL_PBSZ = 4 * 2 * 4608;
__device__ __forceinline__ void hgrn_h2_phase(Frame& F) {
    PHASE_BEGIN();
    if (bx >= 256) return;
    const unsigned char* QF = ws + WS_QF; const unsigned char* KF = ws + WS_KF; const unsigned char* VF = ws + WS_VF; const unsigned char* DEC = ws + WS_DEC; bf16* INTER = (bf16*)(ws + WS_INTER);
    LAS unsigned char* L = F.lds;
    const int wid = __builtin_amdgcn_readfirstlane(tid >> 6), q = lane & 31, hi = lane >> 5;
    const int bh = (bx & 7) + 8 * (bx >> 5), es = (bx >> 3) & 3, b = bh >> 3, h = bh & 7;
    f32x16 S = f32x16{};
    struct H2Regs { v4u q0, q1, k0, k1, v, d; };
    H2Regs ra, rb; ra.v = ra.d = rb.v = rb.d = (v4u){0u, 0u, 0u, 0u};
#define H2_LOAD(R, cc) do { if ((cc) < 64) { const size_t uc = (size_t)bh * 64 + (cc); R.q0 = *(const v4u*)(QF + uc * 16384 + tid * 16); R.q1 = *(const v4u*)(QF + uc * 16384 + 8192 + tid * 16); \
        R.k0 = *(const v4u*)(KF + uc * 16384 + tid * 16); R.k1 = *(const v4u*)(KF + uc * 16384 + 8192 + tid * 16); \
        if (tid < 256) R.v = *(const v4u*)(VF + uc * 16384 + es * 4096 + tid * 16); if (tid < 64) R.d = *(const v4u*)(DEC + uc * 1024 + tid * 16); } } while (0)
#define H2_STORE(R, bufi) do { LAS unsigned char* fb = L + SL_FB + (bufi) * SL_FBSZ; *(LAS v4u*)(fb + tid * 16) = R.q0; *(LAS v4u*)(fb + 8192 + tid * 16) = R.q1; \
        *(LAS v4u*)(fb + 16384 + tid * 16) = R.k0; *(LAS v4u*)(fb + 24576 + tid * 16) = R.k1; if (tid < 256) *(LAS v4u*)(fb + 32768 + tid * 16) = R.v; if (tid < 64) *(LAS v4u*)(fb + 36864 + tid * 16) = R.d; } while (0)
#define H2_REDUCE(cc) do { const LAS unsigned char* pb = L + SL_PB + ((cc) & 1) * SL_PBSZ; const int rti = tid >> 8, ri = (tid >> 3) & 31, e4 = tid & 7; f32x4 a = {0.f, 0.f, 0.f, 0.f}; \
        _Pragma("unroll") for (int T4 = 0; T4 < 4; ++T4) a += *(const LAS f32x4*)(pb + (T4 * 2 + rti) * 4608 + ri * 144 + e4 * 16); \
        v2u w; w.x = cvtpk_s(a.x, a.y); w.y = cvtpk_s(a.z, a.w); *(v2u*)(INTER + ((size_t)b * SEQ + 64 * (cc) + 32 * rti + ri) * D + h * 128 + 32 * es + 4 * e4) = w; } while (0)
    H2_LOAD(ra, 0); H2_STORE(ra, 0); H2_LOAD(ra, 1); H2_LOAD(rb, 2);
    WG_SYNC();
    for (int c2 = 0; c2 < 64; c2 += 2) {
        { const int c = c2;
        if (wid < 4) {
            const LAS unsigned char* fb = L + SL_FB + (c & 1) * SL_FBSZ; const int T4 = wid;
            const LAS float* decp = (const LAS float*)(fb + 36864) + 32 * T4 + 4 * hi;
            f32x4 rf[4], df[4]; bf16x8v qf[2][2], kf[4], vf[4];
#pragma unroll
            for (int g4 = 0; g4 < 4; ++g4) { rf[g4] = *(const LAS f32x4*)(decp + 128 + 8 * g4); df[g4] = *(const LAS f32x4*)(decp + 8 * g4); }
#pragma unroll
            for (int ti = 0; ti < 2; ++ti)
#pragma unroll
                for (int s = 0; s < 2; ++s) qf[ti][s] = *(const LAS bf16x8v*)(fb + (ti * 8 + 2 * T4 + s) * 1024 + lane * 16);
#pragma unroll
            for (int s = 0; s < 4; ++s) { kf[s] = *(const LAS bf16x8v*)(fb + 16384 + (T4 * 4 + s) * 1024 + lane * 16); vf[s] = *(const LAS bf16x8v*)(fb + 32768 + s * 1024 + lane * 16); }
            asm volatile("s_waitcnt lgkmcnt(0)" ::: "memory"); __builtin_amdgcn_sched_barrier(0);
            bf16x8v sop[2];
#pragma unroll
            for (int s = 0; s < 2; ++s) { union { unsigned u[4]; bf16x8v v; } pk;
#pragma unroll
                for (int g2 = 0; g2 < 2; ++g2) { const f32x4 r4 = rf[2 * s + g2]; const int r0 = 8 * s + 4 * g2;
                    pk.u[2 * g2] = cvtpk_s(S[r0] * r4.x, S[r0 + 1] * r4.y); pk.u[2 * g2 + 1] = cvtpk_s(S[r0 + 2] * r4.z, S[r0 + 3] * r4.w); }
                sop[s] = pk.v; }
            LAS unsigned char* pb = L + SL_PB + (c & 1) * SL_PBSZ;
            f32x16 acc0 = __builtin_amdgcn_mfma_f32_32x32x16_bf16(sop[0], qf[0][0], f32x16{}, 0, 0, 0), acc1 = __builtin_amdgcn_mfma_f32_32x32x16_bf16(sop[0], qf[1][0], f32x16{}, 0, 0, 0);
#pragma unroll
            for (int rg = 0; rg < 4; ++rg) { S[4 * rg] *= df[rg].x; S[4 * rg + 1] *= df[rg].y; S[4 * rg + 2] *= df[rg].z; S[4 * rg + 3] *= df[rg].w; }
            acc0 = __builtin_amdgcn_mfma_f32_32x32x16_bf16(sop[1], qf[0][1], acc0, 0, 0, 0); acc1 = __builtin_amdgcn_mfma_f32_32x32x16_bf16(sop[1], qf[1][1], acc1, 0, 0, 0);
#pragma unroll
            for (int s = 0; s < 4; ++s) S = __builtin_amdgcn_mfma_f32_32x32x16_bf16(kf[s], vf[s], S, 0, 0, 0);
#pragma unroll
            for (int rg = 0; rg < 4; ++rg) { const f32x4 o4 = {acc0[4 * rg], acc0[4 * rg + 1], acc0[4 * rg + 2], acc0[4 * rg + 3]}, o5 = {acc1[4 * rg], acc1[4 * rg + 1], acc1[4 * rg + 2], acc1[4 * rg + 3]};
                *(LAS f32x4*)(pb + (T4 * 2 + 0) * 4608 + q * 144 + (8 * rg + 4 * hi) * 4) = o4; *(LAS f32x4*)(pb + (T4 * 2 + 1) * 4608 + q * 144 + (8 * rg + 4 * hi) * 4) = o5; }
        }
        if (c > 0) H2_REDUCE(c - 1);
        H2_STORE(ra, 1); H2_LOAD(ra, c + 3);
        WG_SYNC(); }
        { const int c = c2 + 1;
        if (wid < 4) {
            const LAS unsigned char* fb = L + SL_FB + (c & 1) * SL_FBSZ; const int T4 = wid;
            const LAS float* decp = (const LAS float*)(fb + 36864) + 32 * T4 + 4 * hi;
            f32x4 rf[4], df[4]; bf16x8v qf[2][2], kf[4], vf[4];
#pragma unroll
            for (int g4 = 0; g4 < 4; ++g4) { rf[g4] = *(const LAS f32x4*)(decp + 128 + 8 * g4); df[g4] = *(const LAS f32x4*)(decp + 8 * g4); }
#pragma unroll
            for (int ti = 0; ti < 2; ++ti)
#pragma unroll
                for (int s = 0; s < 2; ++s) qf[ti][s] = *(const LAS bf16x8v*)(fb + (ti * 8 + 2 * T4 + s) * 1024 + lane * 16);
#pragma unroll
            for (int s = 0; s < 4; ++s) { kf[s] = *(const LAS bf16x8v*)(fb + 16384 + (T4 * 4 + s) * 1024 + lane * 16); vf[s] = *(const LAS bf16x8v*)(fb + 32768 + s * 1024 + lane * 16); }
            asm volatile("s_waitcnt lgkmcnt(0)" ::: "memory"); __builtin_amdgcn_sched_barrier(0);
            bf16x8v sop[2];
#pragma unroll
            for (int s = 0; s < 2; ++s) { union { unsigned u[4]; bf16x8v v; } pk;
#pragma unroll
                for (int g2 = 0; g2 < 2; ++g2) { const f32x4 r4 = rf[2 * s + g2]; const int r0 = 8 * s + 4 * g2;
                    pk.u[2 * g2] = cvtpk_s(S[r0] * r4.x, S[r0 + 1] * r4.y); pk.u[2 * g2 + 1] = cvtpk_s(S[r0 + 2] * r4.z, S[r0 + 3] * r4.w); }
                sop[s] = pk.v; }
            LAS unsigned char* pb = L + SL_PB + (c & 1) * SL_PBSZ;
            f32x16 acc0 = __builtin_amdgcn_mfma_f32_32x32x16_bf16(sop[0], qf[0][0], f32x16{}, 0, 0, 0), acc1 = __builtin_amdgcn_mfma_f32_32x32x16_bf16(sop[0], qf[1][0], f32x16{}, 0, 0, 0);
#pragma unroll
            for (int rg = 0; rg < 4; ++rg) { S[4 * rg] *= df[rg].x; S[4 * rg + 1] *= df[rg].y; S[4 * rg + 2] *= df[rg].z; S[4 * rg + 3] *= df[rg].w; }
            acc0 = __builtin_amdgcn_mfma_f32_32x32x16_bf16(sop[1], qf[0][1], acc0, 0, 0, 0); acc1 = __builtin_amdgcn_mfma_f32_32x32x16_bf16(sop[1], qf[1][1], acc1, 0, 0, 0);
#pragma unroll
            for (int s = 0; s < 4; ++s) S = __builtin_amdgcn_mfma_f32_32x32x16_bf16(kf[s], vf[s], S, 0, 0, 0);
#pragma unroll
            for (int rg = 0; rg < 4; ++rg) { const f32x4 o4 = {acc0[4 * rg], acc0[4 * rg + 1], acc0[4 * rg + 2], acc0[4 * rg + 3]}, o5 = {acc1[4 * rg], acc1[4 * rg + 1], acc1[4 * rg + 2], acc1[4 * rg + 3]};
                *(LAS f32x4*)(pb + (T4 * 2 + 0) * 4608 + q * 144 + (8 * rg + 4 * hi) * 4) = o4; *(LAS f32x4*)(pb + (T4 * 2 + 1) * 4608 + q * 144 + (8 * rg + 4 * hi) * 4) = o5; }
        }
        H2_REDUCE(c - 1);
        if (c + 1 < 64) H2_STORE(rb, 0); H2_LOAD(rb, c + 3);
        WG_SYNC(); }
    }
    H2_REDUCE(63);
#undef H2_LOAD
#undef H2_STORE
#undef H2_REDUCE
}
__device__ __forceinline__ void hgrn_norm2_phase(Frame& F, int j) {
    PHASE_BEGIN();
    const bf16* INTRA = (const bf16*)(ws + WS_INTRA); const bf16* INTER = (const bf16*)(ws + WS_INTER); const bf16* H = (const bf16*)(ws + WS_MIX); bf16* O = (bf16*)(ws + WS_O);
    const float* ng = in_ptr(F, 5) + (size_t)j * 128 + ((8 * lane) & 127);
    const f32x4 gn0 = *(const f32x4*)ng, gn1 = *(const f32x4*)(ng + 4);
    const float gn[8] = {gn0.x, gn0.y, gn0.z, gn0.w, gn1.x, gn1.y, gn1.z, gn1.w};
    for (int m0 = gw * 4; m0 < T; m0 += F.NGW * 4) {
        v4u ia[4][2], ib[4][2], ig[4][2];
#pragma unroll
        for (int r = 0; r < 4; ++r)
#pragma unroll
            for (int hf = 0; hf < 2; ++hf) { const size_t m = (size_t)(m0 + r);
                ia[r][hf] = *(const v4u*)(INTRA + m * D + 512 * hf + 8 * lane); ib[r][hf] = *(const v4u*)(INTER + m * D + 512 * hf + 8 * lane); ig[r][hf] = *(const v4u*)(H + 3 * HM_STRIDE + ((((m >> 12) * 8 + (lane >> 4) + 4 * hf) * SEQ) + (m & 4095)) * 128 + ((8 * lane) & 127)); }
#pragma unroll
        for (int r = 0; r < 4; ++r)
#pragma unroll
            for (int hf = 0; hf < 2; ++hf) { const unsigned a4[4] = {ia[r][hf].x, ia[r][hf].y, ia[r][hf].z, ia[r][hf].w}, b4[4] = {ib[r][hf].x, ib[r][hf].y, ib[r][hf].z, ib[r][hf].w}, g4[4] = {ig[r][hf].x, ig[r][hf].y, ig[r][hf].z, ig[r][hf].w};
                float o[8]; float ss = 0.f;
#pragma unroll
                for (int k = 0; k < 4; ++k) { o[2 * k] = bflo(a4[k]) + bflo(b4[k]); o[2 * k + 1] = bfhi(a4[k]) + bfhi(b4[k]); ss += o[2 * k] * o[2 * k] + o[2 * k + 1] * o[2 * k + 1]; }
                ss += __shfl_xor(ss, 1); ss += __shfl_xor(ss, 2); ss += __shfl_xor(ss, 4); ss += __shfl_xor(ss, 8);
                const float rr = 1.0f / sqrtf(ss * (1.0f / 128.0f) + RMS_EPS);
                unsigned w4[4];
#pragma unroll
                for (int k = 0; k < 4; ++k) { const float g0 = bflo(g4[k]), g1 = bfhi(g4[k]);
                    w4[k] = pk2(o[2 * k] * rr * gn[2 * k] * (g0 / (1.0f + __expf(-g0))), o[2 * k + 1] * rr * gn[2 * k + 1] * (g1 / (1.0f + __expf(-g1)))); }
                v4u w; w.x = w4[0]; w.y = w4[1]; w.z = w4[2]; w.w = w4[3];
                *(v4u*)(O + (size_t)(m0 + r) * D + 512 * hf + 8 * lane) = w; }
    }
}

constexpr int LNA_HOLD = 24;
constexpr int RL_G = 0, RL_B = 4096, RL_LG = 8192, RL_HIST = 8192 + 8 * 3072, RL_BASE = RL_HIST + 128;
__device__ __forceinline__ void lna_phase(Frame& F, int l) {
    PHASE_BEGIN();
    _Float16* X = (_Float16*)(ws + WS_X); bf16* XB = (bf16*)(ws + WS_XB); const unsigned char* WR = ws + WS_WR;
    const float* XIN = in_ptr(F, 0); const bf16* MO = (const bf16*)(ws + WS_MO);
    const float* lg_ = in_ptr(F, 7) + (size_t)(l * 2) * D; const float* lb_ = in_ptr(F, 8) + (size_t)(l * 2) * D;
    const float* bg = in_ptr(F, 10) + l * 4; const float* be = in_ptr(F, 12) + l * 32;
    float* RW = (float*)(ws + WS_RW); int* POS = (int*)(ws + WS_POS); int* TOK2 = (int*)(ws + WS_TOK2); unsigned* GCNT = (unsigned*)(ws + WS_GCNT) + l * 512;
    LAS unsigned char* L = F.lds; const int wid = __builtin_amdgcn_readfirstlane(tid >> 6);
    if (tid < 256) { ((LAS f32x4*)(L + RL_G))[tid] = ((const f32x4*)lg_)[tid]; ((LAS f32x4*)(L + RL_B))[tid] = ((const f32x4*)lb_)[tid]; }
    if (tid < 32) ((LAS unsigned*)(L + RL_HIST))[tid] = 0u;
    WG_SYNC();
    const int row = lane & 15, kq = lane >> 4; const size_t m = (size_t)gw * 16 + row;
    _Float16* xrow = X + m * D + 8 * kq; bf16* xbrow = XB + m * D + 8 * kq; const float* xin = XIN + m * D + 8 * kq; const bf16* morow = MO + m * D + 8 * kq;
#define LNA_V(ks, a, b2) do { f32x4 xa_, xb_; if (l == 0) { xa_ = *(const f32x4*)(xin + 32 * (ks)); xb_ = *(const f32x4*)(xin + 32 * (ks) + 4); } \
        else { const f32x8 x8_ = __builtin_convertvector(*(const f16x8*)(xrow + 32 * (ks)), f32x8); xa_ = (f32x4){x8_[0], x8_[1], x8_[2], x8_[3]}; xb_ = (f32x4){x8_[4], x8_[5], x8_[6], x8_[7]}; } \
        const v4u mo_ = *(const v4u*)(morow + 32 * (ks)); \
        a.x = ALPHA * xa_.x + bflo(mo_.x); a.y = ALPHA * xa_.y + bfhi(mo_.x); a.z = ALPHA * xa_.z + bflo(mo_.y); a.w = ALPHA * xa_.w + bfhi(mo_.y); \
        b2.x = ALPHA * xb_.x + bflo(mo_.z); b2.y = ALPHA * xb_.y + bfhi(mo_.z); b2.z = ALPHA * xb_.z + bflo(mo_.w); b2.w = ALPHA * xb_.w + bfhi(mo_.w); } while (0)
    float s1 = 0.f, s2 = 0.f; f16x8 vh[LNA_HOLD];
#pragma unroll
    for (int ks = 0; ks < 32; ++ks) { f32x4 a, b2; LNA_V(ks, a, b2);
        s1 += (a.x + a.y) + (a.z + a.w) + (b2.x + b2.y) + (b2.z + b2.w);
        s2 += (a.x * a.x + a.y * a.y) + (a.z * a.z + a.w * a.w) + (b2.x * b2.x + b2.y * b2.y) + (b2.z * b2.z + b2.w * b2.w);
        if (ks < LNA_HOLD) { const f32x8 v8 = {a.x, a.y, a.z, a.w, b2.x, b2.y, b2.z, b2.w}; vh[ks] = __builtin_convertvector(v8, f16x8); }
        if ((ks & 7) == 7) __builtin_amdgcn_sched_barrier(0); }
    s1 += __shfl_xor(s1, 16); s1 += __shfl_xor(s1, 32); s2 += __shfl_xor(s2, 16); s2 += __shfl_xor(s2, 32);
    const float mean = s1 * (1.f / D); const float var = fmaxf(s2 * (1.f / D) - mean * mean, 0.f); const float rstd = 1.f / sqrtf(var + LN_EPS);
    typedef float f32x4a __attribute__((ext_vector_type(4)));
    f32x4a acc[3]; acc[0] = acc[1] = acc[2] = (f32x4a){0.f, 0.f, 0.f, 0.f};
#pragma unroll
    for (int kk = 0; kk < 32; ++kk) { const int ks = (kk + LNA_HOLD) & 31;
        f32x4 a, b2;
        if (ks < LNA_HOLD) { const f32x8 v8 = __builtin_convertvector(vh[ks], f32x8); a = (f32x4){v8[0], v8[1], v8[2], v8[3]}; b2 = (f32x4){v8[4], v8[5], v8[6], v8[7]}; }
        else LNA_V(ks, a, b2);
        const LAS float* gp = (const LAS float*)(L + RL_G) + 32 * ks + 8 * kq; const LAS float* bp = (const LAS float*)(L + RL_B) + 32 * ks + 8 * kq;
        const f32x4 g0 = *(const LAS f32x4*)gp, g1 = *(const LAS f32x4*)(gp + 4), c0 = *(const LAS f32x4*)bp, c1 = *(const LAS f32x4*)(bp + 4);
        const f32x4 y0 = (a - mean) * rstd * g0 + c0, y1 = (b2 - mean) * rstd * g1 + c1;
        { const f32x8 y8 = {y0.x, y0.y, y0.z, y0.w, y1.x, y1.y, y1.z, y1.w}; *(f16x8*)(xrow + 32 * ks) = __builtin_convertvector(y8, f16x8); }
        union { unsigned u[4]; bf16x8v v; v4u q; } xh, xl;
        xh.u[0] = pk2(y0.x, y0.y); xh.u[1] = pk2(y0.z, y0.w); xh.u[2] = pk2(y1.x, y1.y); xh.u[3] = pk2(y1.z, y1.w);
        xl.u[0] = pk2(y0.x - bflo(xh.u[0]), y0.y - bfhi(xh.u[0])); xl.u[1] = pk2(y0.z - bflo(xh.u[1]), y0.w - bfhi(xh.u[1]));
        xl.u[2] = pk2(y1.x - bflo(xh.u[2]), y1.y - bfhi(xh.u[2])); xl.u[3] = pk2(y1.z - bflo(xh.u[3]), y1.w - bfhi(xh.u[3]));
#pragma unroll
        for (int nt = 0; nt < 3; ++nt) { const bf16x8v wh = *(const bf16x8v*)(WR + ((size_t)((ks * 3 + nt) * 2 + 0) * 64 + lane) * 16), wl = *(const bf16x8v*)(WR + ((size_t)((ks * 3 + nt) * 2 + 1) * 64 + lane) * 16);
            acc[nt] = __builtin_amdgcn_mfma_f32_16x16x32_bf16(xh.v, wh, acc[nt], 0, 0, 0);
            acc[nt] = __builtin_amdgcn_mfma_f32_16x16x32_bf16(xh.v, wl, acc[nt], 0, 0, 0);
            acc[nt] = __builtin_amdgcn_mfma_f32_16x16x32_bf16(xl.v, wh, acc[nt], 0, 0, 0); }
        if ((kk & 3) == 3) __builtin_amdgcn_sched_barrier(0);
    }
    LAS float* lgs = (LAS float*)(L + RL_LG + wid * 3072);
#pragma unroll
    for (int nt = 0; nt < 3; ++nt)
#pragma unroll
        for (int r = 0; r < 4; ++r) lgs[(4 * kq + r) * 48 + 16 * nt + row] = acc[nt][r];
    LDS_WAIT(); asm volatile("" ::: "memory");
    int e1 = 0, e2 = 0; unsigned r1 = 0u, r2 = 0u;
    if (lane < 16) {
        float lg[4], le[32];
        { const f32x4 t0 = *(const LAS f32x4*)(lgs + lane * 48); lg[0] = t0.x + bg[0]; lg[1] = t0.y + bg[1]; lg[2] = t0.z + bg[2]; lg[3] = t0.w + bg[3]; }
#pragma unroll
        for (int q4 = 0; q4 < 8; ++q4) { const f32x4 t0 = *(const LAS f32x4*)(lgs + lane * 48 + 4 + 4 * q4); const f32x4 bb = *(const f32x4*)(be + 4 * q4);
            le[4 * q4] = t0.x + bb.x; le[4 * q4 + 1] = t0.y + bb.y; le[4 * q4 + 2] = t0.z + bb.z; le[4 * q4 + 3] = t0.w + bb.w; }
        float best = lg[0]; int grp = 0;
#pragma unroll
        for (int i = 1; i < 4; ++i) if (lg[i] > best) { best = lg[i]; grp = i; }
        float den = 0.f;
#pragma unroll
        for (int i = 0; i < 4; ++i) den += expf(lg[i] - best);
        const float pg = 1.0f / den;
        float b1 = -INFINITY, b2v = -INFINITY; int i1 = 0, i2 = 0;
#pragma unroll
        for (int i = 0; i < 32; ++i) if ((i >> 3) == grp && le[i] > b1) { b1 = le[i]; i1 = i; }
#pragma unroll
        for (int i = 0; i < 32; ++i) if ((i >> 3) == grp && i != i1 && le[i] > b2v) { b2v = le[i]; i2 = i; }
        const float e21 = expf(b2v - b1); const float w1 = pg / (1.0f + e21), w2 = pg * e21 / (1.0f + e21);
        const size_t mt = (size_t)gw * 16 + lane; RW[2 * mt] = w1; RW[2 * mt + 1] = w2; e1 = i1; e2 = i2;
        r1 = __hip_atomic_fetch_add((LAS unsigned*)(L + RL_HIST) + i1, 1u, __ATOMIC_RELAXED, __HIP_MEMORY_SCOPE_WORKGROUP); r2 = __hip_atomic_fetch_add((LAS unsigned*)(L + RL_HIST) + i2, 1u, __ATOMIC_RELAXED, __HIP_MEMORY_SCOPE_WORKGROUP);
    }
    WG_SYNC();
    if (tid < 32) { const unsigned c = ((LAS unsigned*)(L + RL_HIST))[tid]; unsigned base = 0u; if (c) base = __hip_atomic_fetch_add(GCNT + tid * 16, c, __ATOMIC_RELAXED, __HIP_MEMORY_SCOPE_AGENT); ((LAS unsigned*)(L + RL_BASE))[tid] = base; }
    WG_SYNC();
    if (lane < 16) { const int mt = gw * 16 + lane; const unsigned o1 = ((LAS unsigned*)(L + RL_BASE))[e1] + r1, o2 = ((LAS unsigned*)(L + RL_BASE))[e2] + r2;
        POS[2 * mt] = (int)(((unsigned)e1 << 20) | o1); POS[2 * mt + 1] = (int)(((unsigned)e2 << 20) | o2); TOK2[(size_t)e1 * TOKCAP + o1] = mt; TOK2[(size_t)e2 * TOKCAP + o2] = mt; }
}
__device__ __forceinline__ void slot_phase(Frame& F, int l) {
    PHASE_BEGIN();
    const int* HIST = (const int*)(ws + WS_HIST);
    volatile LAS int* MI = (volatile LAS int*)F.MISC; volatile LAS int* SC = (volatile LAS int*)F.lds;
    { const int e = tid & 31, part = tid >> 5; int tot = 0, bef = 0;
      for (int k = 0; k < 16; ++k) { const int wgi = part * 16 + k; const int hv = HIST[wgi * 32 + e]; tot += hv; bef += (wgi < bx) ? hv : 0; }
      SC[part * 32 + e] = tot; SC[512 + part * 32 + e] = bef; }
    WG_SYNC();
    if (tid < 32) { int tot = 0, bef = 0;
        for (int k = 0; k < 16; ++k) { tot += SC[k * 32 + tid]; bef += SC[512 + k * 32 + tid]; }
        SC[1024 + tid] = tot; SC[1056 + tid] = bef; }
    WG_SYNC();
    const int* RE = (const int*)(ws + WS_RE); int* POS = (int*)(ws + WS_POS); int* TOK = (int*)(ws + WS_TOK);
    const int myp = gw * 32 + (lane & 31); const int mye = RE[myp];
    if (tid < 64) { const int e = tid & 31; const int n = (SC[1024 + e] + 255) >> 8; int inc = n;
#pragma unroll
        for (int d = 1; d < 32; d <<= 1) { const int o_ = __shfl_up(inc, d, 32); if (e >= d) inc += o_; }
        const int acc = inc - n;
        if (tid < 32) { MI[320 + e] = acc; MI[352 + e] = acc * 256 + SC[1056 + e];
            for (int k = 0; k < n; ++k) MI[17 + acc + k] = e;
            if (e == 31) MI[16] = inc; } }
    WG_SYNC();
    if (lane < 32) { const int sl = __hip_atomic_fetch_add((LAS int*)(F.MISC + 352) + mye, 1, __ATOMIC_RELAXED, __HIP_MEMORY_SCOPE_WORKGROUP); POS[myp] = sl; TOK[sl] = myp >> 1; }
}
__device__ __forceinline__ void lnb_phase(Frame& F, int l) {
    PHASE_BEGIN();
    _Float16* X = (_Float16*)(ws + WS_X); bf16* XB = (bf16*)(ws + WS_XB); const bf16* YB = (const bf16*)(ws + WS_YB);
    const float* lg_ = in_ptr(F, 7) + (size_t)(l * 2 + 1) * D; const float* lb_ = in_ptr(F, 8) + (size_t)(l * 2 + 1) * D;
    const int* POS = (const int*)(ws + WS_POS); const float* RW = (const float*)(ws + WS_RW);
    const bool last = (l == DEPTH - 1); float* OUT = (float*)in_ptr(F, 16);
    f32x4 gv[4], bv[4];
#pragma unroll
    for (int j = 0; j < 4; ++j) { gv[j] = *(const f32x4*)(lg_ + 4 * lane + 256 * j); bv[j] = *(const f32x4*)(lb_ + 4 * lane + 256 * j); }
    for (int p = gw; p < T / 2; p += F.NGW) {
        const v4u pp = *(const v4u*)(POS + 4 * p); const f32x4 ww = *(const f32x4*)(RW + 4 * p);
        const int ps[4] = {(int)F.MISC[320 + (pp.x >> 20)] * 256 + (int)(pp.x & 0xFFFFFu), (int)F.MISC[320 + (pp.y >> 20)] * 256 + (int)(pp.y & 0xFFFFFu), (int)F.MISC[320 + (pp.z >> 20)] * 256 + (int)(pp.z & 0xFFFFFu), (int)F.MISC[320 + (pp.w >> 20)] * 256 + (int)(pp.w & 0xFFFFFu)}; const float wv[4] = {ww.x, ww.y, ww.z, ww.w};
        f32x4 xv[2][4]; v2u ya[2][4], yc[2][4];
#pragma unroll
        for (int t = 0; t < 2; ++t) { const f16x4* xr = (const f16x4*)(X + (size_t)(2 * p + t) * D) + lane;
            const v2u* y0 = (const v2u*)(YB + (size_t)ps[2 * t] * D) + lane; const v2u* y1 = (const v2u*)(YB + (size_t)ps[2 * t + 1] * D) + lane;
#pragma unroll
            for (int j = 0; j < 4; ++j) { xv[t][j] = __builtin_convertvector(xr[64 * j], f32x4); ya[t][j] = y0[64 * j]; yc[t][j] = y1[64 * j]; } }
#pragma unroll
        for (int t = 0; t < 2; ++t) { const float w0 = wv[2 * t], w1 = wv[2 * t + 1]; f32x4 v[4]; float s = 0.f;
#pragma unroll
            for (int j = 0; j < 4; ++j) { const f32x4 x4 = xv[t][j]; const v2u a = ya[t][j], c = yc[t][j];
                v[j].x = ALPHA * x4.x + w0 * bflo(a.x) + w1 * bflo(c.x); v[j].y = ALPHA * x4.y + w0 * bfhi(a.x) + w1 * bfhi(c.x);
                v[j].z = ALPHA * x4.z + w0 * bflo(a.y) + w1 * bflo(c.y); v[j].w = ALPHA * x4.w + w0 * bfhi(a.y) + w1 * bfhi(c.y);
                s += (v[j].x + v[j].y) + (v[j].z + v[j].w); }
            const float mean = wave_sum(s) * (1.f / D); float s2 = 0.f;
#pragma unroll
            for (int j = 0; j < 4; ++j) { v[j] = v[j] - mean; s2 += (v[j].x * v[j].x + v[j].y * v[j].y) + (v[j].z * v[j].z + v[j].w * v[j].w); }
            const float rstd = 1.f / sqrtf(wave_sum(s2) * (1.f / D) + LN_EPS);
            f32x4* outr = (f32x4*)(OUT + (size_t)(2 * p + t) * D) + lane; f16x4* outh = (f16x4*)(X + (size_t)(2 * p + t) * D) + lane; v2u* o8 = (v2u*)(XB + (size_t)(2 * p + t) * D) + lane;
#pragma unroll
            for (int j = 0; j < 4; ++j) { v[j] = v[j] * rstd * gv[j] + bv[j]; if (last) outr[64 * j] = v[j]; else outh[64 * j] = __builtin_convertvector(v[j], f16x4);
} }
    }
}

struct Args { const float* in[16]; float* out; unsigned char* ws; };
#ifndef PROBE_MASK
#define PROBE_MASK 0
#endif
#define GRID_BAR(g) do { unsigned char* wsb_ = F.ws; asm volatile("" : "+s"(wsb_)); XcdBarrier bar_; bar_.bar = (unsigned*)(wsb_ + WS_CTL) + CW_BAR; bar_.x = xb_xcc_id(); bar_.st = F.MISC; xcd_barrier(bar_); STAMP(g); } while (0)
template <int l>
__device__ __forceinline__ void layer_body(Frame& F, PG8_LAS unsigned char* ring) {
    constexpr bool even = (l & 1) == 0; constexpr int j = l >> 1; int moe_done = 0;
    if constexpr (even) { LAUNDER_WS();
        pg8::Gemm g{(const pg8::bf16_t*)(ws + WS_X), (const pg8::bf16_t*)(ws + WS_WIN), T, NQKV, D}; pg8::StaticOrder S; S.init(T, NQKV, F.G, bx);
        pg8::EpiQKV E{(pg8::bf16_t*)(ws + WS_MIX), (const float*)(ws + WS_ROPE), (float*)(ws + WS_KMEAN) + (size_t)j * 65536};
        pg8::gemm_phase<pg8::EpiQKV, pg8::StaticOrder, true, true, true>(ring, g, S, E); }
    else { LAUNDER_WS();
        pg8::Gemm g{(const pg8::bf16_t*)(ws + WS_X), (const pg8::bf16_t*)(ws + WS_WIN), T, NH4, D}; pg8::StaticOrder S; S.init(T, NH4, F.G, bx);
        pg8::EpiHeadMajor E{(pg8::bf16_t*)(ws + WS_MIX)};
        pg8::gemm_phase<pg8::EpiHeadMajor, pg8::StaticOrder, true, true, true>(ring, g, S, E); }
    GRID_BAR(1);
    if constexpr (even) {
        attn_fast_phase(F, j); GRID_BAR(12);
        attn_gather_phase(F, j); attn_dil2_phase(F, l == 0 ? 0 : -1); GRID_BAR(2);
        attn_own_phase(F); GRID_BAR(13);
    } else {
        hgrn_h1_phase(F, j); GRID_BAR(3);
        hgrn_h2_phase(F); GRID_BAR(4);
        hgrn_norm2_phase(F, j); GRID_BAR(5);
    }
    { LAUNDER_WS(); pg8::Gemm g{(const pg8::bf16_t*)(ws + WS_O), (const pg8::bf16_t*)(ws + WS_WOUT), T, D, D}; pg8::StaticOrder S; S.init(T, D, F.G, bx);
      pg8::EpiPlain E{(pg8::bf16_t*)(ws + WS_MO), D, 0xffff};
      pg8::gemm_phase<pg8::EpiPlain, pg8::StaticOrder, true, true>(ring, g, S, E); }
    GRID_BAR(6);
    lna_phase(F, l); GRID_BAR(7);
    { LAUNDER_WS(); pg8::Gemm g{(const pg8::bf16_t*)(ws + WS_X), (const pg8::bf16_t*)(ws + ((l & 1) ? WS_W13B : WS_W13)), T, 1024, D};
      pg8::MoeOrder S{(const PG8_LAS int*)(F.lds + MISC_OFF + 64), F.G, (F.G % 8 == 0) ? (bx % 8) * (F.G / 8) + bx / 8 : bx};
      pg8::EpiSwiGlu E{(pg8::bf16_t*)(ws + WS_HB), FEXP};
      PG8_LAS int* tokl = (PG8_LAS int*)(F.lds + RING_BYTES); const int* TOK2 = (const int*)(ws + WS_TOK2);
      { volatile LAS int* MI = (volatile LAS int*)F.MISC; unsigned* GC = (unsigned*)(ws + WS_GCNT) + l * 512;
        if (threadIdx.x < 64) { const int e = threadIdx.x & 31; const int tot = (int)__hip_atomic_load(GC + e * 16, __ATOMIC_RELAXED, __HIP_MEMORY_SCOPE_AGENT); const int n = (tot + 255) >> 8; int inc = n;
#pragma unroll
            for (int d = 1; d < 32; d <<= 1) { const int o_ = __shfl_up(inc, d, 32); if (e >= d) inc += o_; }
            const int acc = inc - n;
            if (threadIdx.x < 32) { MI[320 + e] = acc; MI[352 + e] = tot;
                for (int k = 0; k < n; ++k) MI[17 + acc + k] = e;
                if (e == 31) MI[16] = inc; } }
        WG_SYNC();
        for (int i = 0; i < 5; ++i) { pg8::Unit u; if (!S.next(i, u)) break;
            if (threadIdx.x < 256) { const int e = u.pn >> 2; const int loc = (u.pm - MI[320 + e]) * 256 + (int)threadIdx.x; int t = 0; if (loc < MI[352 + e]) t = TOK2[(size_t)e * TOKCAP + loc]; tokl[i * 256 + threadIdx.x] = ((unsigned)t < (unsigned)T) ? t : 0; } } }
      WG_SYNC();
      if constexpr (l + 1 < DEPTH) { (void)cvt_tail(F, l + 1, (int)F.MISC[16], S.vc, 0, 80, 0); WG_SYNC(); }
      pg8::gemm_phase_gather<pg8::EpiSwiGlu, pg8::MoeOrder, true>(ring, g, S, E, tokl);
      if constexpr (l + 1 < DEPTH) { WG_SYNC(); moe_done = cvt_tail(F, l + 1, (int)F.MISC[16], S.vc, 0, 80, 1); } }
    GRID_BAR(9);
    { LAUNDER_WS(); pg8::Gemm g{(const pg8::bf16_t*)(ws + WS_HB), (const pg8::bf16_t*)(ws + ((l & 1) ? WS_W2B : WS_W2)), MAX_TILES * 256, 1024, FEXP};
      pg8::MoeOrder S{(const PG8_LAS int*)(F.lds + MISC_OFF + 64), F.G, (F.G % 8 == 0) ? (bx % 8) * (F.G / 8) + bx / 8 : bx};
      pg8::EpiPlain E{(pg8::bf16_t*)(ws + WS_YB), D, 3};
      if constexpr (l + 1 < DEPTH) { (void)cvt_tail(F, l + 1, (int)F.MISC[16], S.vc, moe_done, 48, 0); WG_SYNC(); }
      pg8::gemm_phase<pg8::EpiPlain, pg8::MoeOrder, false, true>(ring, g, S, E);
      if constexpr (l + 1 < DEPTH) { WG_SYNC(); moe_done = cvt_tail(F, l + 1, (int)F.MISC[16], S.vc, moe_done, 48, 1); } }
    GRID_BAR(10);
    lnb_phase(F, l);
    if constexpr (l + 1 < DEPTH) { convert_weights(F, l + 1, moe_done); GRID_BAR(11); }
}
__global__ void __launch_bounds__(NWAVES * 64, 2) mega_fwd(Args args) {
    extern __shared__ __attribute__((aligned(16))) unsigned char lds[];
    Frame F;
    F.lds = (LAS unsigned char*)lds; F.MISC = (volatile LAS unsigned*)(F.lds + MISC_OFF);
    F.tid = threadIdx.x; F.lane = F.tid & 63; F.wave = __builtin_amdgcn_readfirstlane(F.tid >> 6);
    F.G = gridDim.x; F.gw = blockIdx.x * NWAVES + F.wave; F.NGW = F.G * NWAVES;
    F.ws = args.ws;
    for (int u = F.tid; u < (LDS_BYTES - MISC_OFF) / 4; u += NWAVES * 64) F.MISC[u] = 0u;
    __syncthreads();
    if (F.tid < 17) { const unsigned long long p = F.tid < 16 ? (unsigned long long)args.in[F.tid] : (unsigned long long)args.out; F.MISC[512 + 2 * F.tid] = (unsigned)p; F.MISC[513 + 2 * F.tid] = (unsigned)(p >> 32); }
    if (PROBE_MASK != 0 && F.tid == 0) F.MISC[599] = (unsigned)__builtin_amdgcn_s_memrealtime();
    __syncthreads();
    { XcdBarrier b0 = xcd_barrier_post((unsigned*)(F.ws + WS_CTL) + CW_BAR, F.MISC); (void)b0; }
    PG8_LAS unsigned char* ring = (PG8_LAS unsigned char*)lds;
    prologue(F); convert_weights(F, 0, CVT_MOE);
    GRID_BAR(0);
    layer_body<0>(F, ring); layer_body<1>(F, ring); layer_body<2>(F, ring); layer_body<3>(F, ring);
    if (PROBE_MASK != 0 && blockIdx.x == 0 && F.tid == 0) {
        STAMP(11); unsigned tot = 0;
        for (int g = 0; g < 16; ++g) if ((PROBE_MASK >> g) & 1) tot += F.MISC[600 + g];
        const unsigned long long t0 = __builtin_amdgcn_s_memrealtime(), wait = 8ull * tot;
        while (__builtin_amdgcn_s_memrealtime() - t0 < wait) __builtin_amdgcn_s_sleep(32);
    }
}

extern "C" void kernel_launch(void* const* d_in, const int* in_sizes, int n_in, void* d_out, int out_size, void* d_ws, size_t ws_size, hipStream_t stream) {
    static int grid = 0;
    if (grid == 0) {
        if (n_in != 16 || in_sizes[0] != T * D || out_size != T * D || ws_size < WS_END) { fprintf(stderr, "kernel_launch: unexpected shapes (n_in %d, in0 %d, out %d, ws %zu)\n", n_in, n_in > 0 ? in_sizes[0] : -1, out_size, ws_size); grid = -1; return; }
        int dev = 0, cus = 0, per_cu = 0;
        if (hipGetDevice(&dev) != hipSuccess || hipDeviceGetAttribute(&cus, hipDeviceAttributeMultiprocessorCount, dev) != hipSuccess) { grid = -1; return; }
        if (hipFuncSetAttribute((const void*)mega_fwd, hipFuncAttributeMaxDynamicSharedMemorySize, LDS_BYTES) != hipSuccess) { fprintf(stderr, "kernel_launch: hipFuncSetAttribute failed\n"); grid = -1; return; }
        if (hipOccupancyMaxActiveBlocksPerMultiprocessor(&per_cu, (const void*)mega_fwd, NWAVES * 64, LDS_BYTES) != hipSuccess || per_cu < 1) fprintf(stderr, "kernel_launch: occupancy query reports %d\n", per_cu);
        (void)hipGetLastError();
        grid = cus;
    }
    if (grid < 0) return;
    if (hipMemsetAsync((char*)d_ws + WS_CTL, 0, CTL_ZERO_BYTES, stream) != hipSuccess) return;
    Args a{};
    for (int i = 0; i < 16; ++i) a.in[i] = (const float*)d_in[i];
    a.out = (float*)d_out; a.ws = (unsigned char*)d_ws;
    hipLaunchKernelGGL(mega_fwd, dim3(grid), dim3(NWAVES * 64), LDS_BYTES, stream, a);
}
```

```cpp
#include <hip/hip_runtime.h>
#include <cstdio>
#include <cstdint>
#include <cmath>
namespace pg8 {
#define PG8_LAS __attribute__((address_space(3)))
typedef unsigned short bf16_t;
typedef short bf16x8 __attribute__((ext_vector_type(8)));
typedef float f32x4 __attribute__((ext_vector_type(4)));
typedef unsigned u32x4 __attribute__((ext_vector_type(4)));
constexpr int BM = 256, BK = 64, HALF = 128, HTB = HALF * BK * 2  , STAGE_BYTES = 8 * HTB, NXCD = 8, WGM = 8;

__host__ __device__ __forceinline__ int lds_byte(int r, int c) { const int st = (r >> 4) * 2 + (c >> 5), rr = r & 15, cc = c & 31, ob = rr * 64 + cc * 2; return st * 1024 + (ob ^ (((ob >> 9) & 1) << 5)); }
__host__ __device__ __forceinline__ void stage_rc(int b, int& R, int& C) { const int st = b / 1024, sb = b % 1024, swz = sb ^ (((sb >> 9) & 1) << 5); R = (st >> 1) * 16 + swz / 64; C = (st & 1) * 32 + (swz % 64) / 2; }
__host__ __device__ __forceinline__ int perm32(int rho) { const int n = rho >> 4, i = rho & 15; return 8 * (i >> 2) + 4 * n + (i & 3); }

struct Unit { int pm, pn; };
struct Gemm { const bf16_t* A; const bf16_t* Bt; int M, N, K; };

struct StaticOrder {
    int nM, nN, nwg, G, c;
    __host__ __device__ void init(int M, int N, int G_, int c_) { nM = M / BM; nN = N / BM; nwg = nM * nN; G = G_; c = c_; }
    __host__ __device__ bool next(int i, Unit& u) const {
        const long L = (long)i * G + c; if (L >= nwg) return false;
        int wgid = (int)L; { const int q = nwg / NXCD, r = nwg % NXCD, xcd = wgid % NXCD, off = wgid / NXCD; wgid = (xcd < r ? xcd * (q + 1) : r * (q + 1) + (xcd - r) * q) + off; }
        const int nig = WGM * nN, gid = wgid / nig, fm = gid * WGM, gsz = (nM - fm) < WGM ? (nM - fm) : WGM;
        u.pm = fm + ((wgid % nig) % gsz); u.pn = (wgid % nig) / gsz; return true;
    }
    __device__ __forceinline__ void a_ready(const Unit&) const {}
    __device__ __forceinline__ void done(const Unit&) const {}
};

__device__ __forceinline__ unsigned cvt_pk_bf16(float lo, float hi) { unsigned r; asm volatile("v_cvt_pk_bf16_f32 %0, %1, %2" : "=v"(r) : "v"(lo), "v"(hi)); return r; }
typedef float f32x2 __attribute__((ext_vector_type(2)));

__device__ __forceinline__ float silu_f(float a) { return a * __builtin_amdgcn_rcpf(1.0f + __expf(-a)); }
struct EpiPlain {
    static constexpr bool PERM = true, AFTER_DRAIN = false;
    bf16_t* O; int ldc; int pn_mask;
    __device__ __forceinline__ void operator()(const f32x4 (&acc)[2][2][4][2], const Unit& u, int wr, int wc, int fr, int fq) const {
        const int row0 = u.pm * BM + wr * 64 + fr; const int col0 = (u.pn & pn_mask) * BM + wc * 32 + 8 * fq;
#pragma unroll
        for (int ai = 0; ai < 2; ++ai)
#pragma unroll
            for (int m = 0; m < 4; ++m) { bf16_t* rowp = O + (size_t)(row0 + ai * HALF + m * 16) * ldc + col0;
#pragma unroll
                for (int bj = 0; bj < 2; ++bj) { const f32x4 v0 = acc[ai][bj][m][0], v1 = acc[ai][bj][m][1];
                    u32x4 w; w.x = cvt_pk_bf16(v0[0], v0[1]); w.y = cvt_pk_bf16(v0[2], v0[3]); w.z = cvt_pk_bf16(v1[0], v1[1]); w.w = cvt_pk_bf16(v1[2], v1[3]);
                    *(u32x4*)(rowp + bj * HALF) = w; } }
    }
};

struct EpiQKV {
    static constexpr bool PERM = true, AFTER_DRAIN = false;
    bf16_t* O; const float* rope; float* kmean;
    __device__ __forceinline__ void operator()(const f32x4 (&acc)[2][2][4][2], const Unit& u, int wr, int wc, int fr, int fq) const {
        const int row0 = u.pm * BM + wr * 64 + fr; const int col0 = u.pn * BM + wc * 32 + 8 * fq;
        const bool roped = (u.pn < 4) || (u.pn >= 6 && u.pn < 10); const bool iska = (u.pn == 2) || (u.pn == 3);
        const bool rl = ((wc & 1) == 0) && (fq < 2); const float sgn = fq == 0 ? -1.0f : 1.0f;
        f32x4 cs[2][2]; cs[0][0] = cs[0][1] = cs[1][0] = cs[1][1] = (f32x4){0.f, 0.f, 0.f, 0.f};
#pragma unroll
        for (int ai = 0; ai < 2; ++ai)
#pragma unroll
            for (int m = 0; m < 4; ++m) { const int row = row0 + ai * HALF + m * 16; bf16_t* rowp = O + (size_t)row * 3072 + col0;
                f32x4 c0 = {1.f, 1.f, 1.f, 1.f}, c1 = c0, s0 = {0.f, 0.f, 0.f, 0.f}, s1 = s0;
                if (roped && rl) { const float* rp = rope + (size_t)(row & 4095) * 16; c0 = *(const f32x4*)rp; c1 = *(const f32x4*)(rp + 4); s0 = *(const f32x4*)(rp + 8) * sgn; s1 = *(const f32x4*)(rp + 12) * sgn; }
#pragma unroll
                for (int bj = 0; bj < 2; ++bj) { f32x4 v0 = acc[ai][bj][m][0], v1 = acc[ai][bj][m][1];
                    if (roped) { f32x4 p0, p1;
#pragma unroll
                        for (int k = 0; k < 4; ++k) { p0[k] = __shfl_xor(v0[k], 16); p1[k] = __shfl_xor(v1[k], 16); }
                        v0 = v0 * c0 + p0 * s0; v1 = v1 * c1 + p1 * s1; }
                    if (iska) { cs[bj][0] += v0; cs[bj][1] += v1; }
                    u32x4 w; w.x = cvt_pk_bf16(v0[0], v0[1]); w.y = cvt_pk_bf16(v0[2], v0[3]); w.z = cvt_pk_bf16(v1[0], v1[1]); w.w = cvt_pk_bf16(v1[2], v1[3]);
                    *(u32x4*)(rowp + bj * HALF) = w; } }
        if (iska) {
#pragma unroll
            for (int bj = 0; bj < 2; ++bj)
#pragma unroll
                for (int n = 0; n < 2; ++n)
#pragma unroll
                    for (int k = 0; k < 4; ++k) { float v = cs[bj][n][k];
                        v += __shfl_xor(v, 1); v += __shfl_xor(v, 2); v += __shfl_xor(v, 4); v += __shfl_xor(v, 8);
                        if (fr == 0) { const int head = (u.pn - 2) * 4 + bj * 2 + (wc >> 1), dim = (wc & 1) * 32 + 8 * fq + 4 * n + k;
                            __hip_atomic_fetch_add(kmean + (((size_t)(u.pm >> 4) * 8 + head) * 16 + (u.pm & 15)) * 64 + dim, v * (1.0f / 256.0f), __ATOMIC_RELAXED, __HIP_MEMORY_SCOPE_AGENT); } }
        }
    }
};

struct EpiHeadMajor {
    static constexpr bool PERM = true, AFTER_DRAIN = false;
    bf16_t* O;
    __device__ __forceinline__ void operator()(const f32x4 (&acc)[2][2][4][2], const Unit& u, int wr, int wc, int fr, int fq) const {
        const int row0 = u.pm * BM + wr * 64 + fr; const int which = u.pn >> 2, b = (u.pm * BM) >> 12;
#pragma unroll
        for (int ai = 0; ai < 2; ++ai)
#pragma unroll
            for (int m = 0; m < 4; ++m) { const int t = (row0 + ai * HALF + m * 16) & 4095;
#pragma unroll
                for (int bj = 0; bj < 2; ++bj) { const int head = (u.pn & 3) * 2 + bj; const f32x4 v0 = acc[ai][bj][m][0], v1 = acc[ai][bj][m][1];
                    u32x4 w; w.x = cvt_pk_bf16(v0[0], v0[1]); w.y = cvt_pk_bf16(v0[2], v0[3]); w.z = cvt_pk_bf16(v1[0], v1[1]); w.w = cvt_pk_bf16(v1[2], v1[3]);
                    *(u32x4*)(O + ((((size_t)which * 8 + b) * 8 + head) * 4096 + t) * 128 + wc * 32 + 8 * fq) = w; } }
    }
};
struct EpiSwiGlu {
    static constexpr bool PERM = true, AFTER_DRAIN = false;
    bf16_t* O; int ldc;
    __device__ __forceinline__ void operator()(const f32x4 (&acc)[2][2][4][2], const Unit& u, int wr, int wc, int fr, int fq) const {
        const int row0 = u.pm * BM + wr * 64 + fr; const int col0 = (u.pn & 3) * HALF + wc * 32 + 8 * fq;
#pragma unroll
        for (int ai = 0; ai < 2; ++ai)
#pragma unroll
            for (int m = 0; m < 4; ++m) { bf16_t* rowp = O + (size_t)(row0 + ai * HALF + m * 16) * ldc + col0;
                const f32x4 a0 = acc[ai][0][m][0], a1 = acc[ai][0][m][1], b0 = acc[ai][1][m][0], b1 = acc[ai][1][m][1];
                u32x4 w; w.x = cvt_pk_bf16(silu_f(a0[0]) * b0[0], silu_f(a0[1]) * b0[1]); w.y = cvt_pk_bf16(silu_f(a0[2]) * b0[2], silu_f(a0[3]) * b0[3]);
                w.z = cvt_pk_bf16(silu_f(a1[0]) * b1[0], silu_f(a1[1]) * b1[1]); w.w = cvt_pk_bf16(silu_f(a1[2]) * b1[2], silu_f(a1[3]) * b1[3]);
                *(u32x4*)rowp = w; }
    }
};
struct EpiResid {
    static constexpr bool PERM = false, AFTER_DRAIN = false;
    const float* base; float* out; float alpha;
    __device__ __forceinline__ void operator()(const f32x4 (&acc)[2][2][4][2], const Unit& u, int wr, int wc, int fr, int fq) const {
        const int row0 = u.pm * BM + wr * 64 + fr; const int col0 = u.pn * BM + wc * 32 + 4 * fq;
#pragma unroll
        for (int ai = 0; ai < 2; ++ai)
#pragma unroll
            for (int m = 0; m < 4; ++m) { const size_t off = (size_t)(row0 + ai * HALF + m * 16) * 1024 + col0;
#pragma unroll
                for (int bj = 0; bj < 2; ++bj)
#pragma unroll
                    for (int n = 0; n < 2; ++n) { const f32x4 bs = *(const f32x4*)(base + off + bj * HALF + n * 16);
                        *(f32x4*)(out + off + bj * HALF + n * 16) = bs * alpha + acc[ai][bj][m][n]; } }
    }
};
struct MoeOrder {
    const PG8_LAS int* tab; int G, vc;
    __device__ __forceinline__ bool next(int i, Unit& u) const {
        const long L = (long)i * G + vc; const int nt = __builtin_amdgcn_readfirstlane(tab[0]); if (L >= (long)nt * 4) return false;
        const int pm = (int)(L >> 2); u.pm = pm; u.pn = __builtin_amdgcn_readfirstlane(tab[1 + pm]) * 4 + (int)(L & 3); return true;
    }
    __device__ __forceinline__ void a_ready(const Unit&) const {}
    __device__ __forceinline__ void done(const Unit&) const {}
};
template <bool F16> __device__ __forceinline__ f32x4 mma16(bf16x8 a, bf16x8 b, f32x4 c) {
    if constexpr (F16) { typedef _Float16 f16x8_t __attribute__((ext_vector_type(8))); return __builtin_amdgcn_mfma_f32_16x16x32_f16(__builtin_bit_cast(f16x8_t, a), __builtin_bit_cast(f16x8_t, b), c, 0, 0, 0); }
    else return __builtin_amdgcn_mfma_f32_16x16x32_bf16(a, b, c, 0, 0, 0);
}
template <class Epi, class Sched, bool ALIGN_EPI = false, bool SP2 = false, bool F16 = false>
__device__ __forceinline__ void gemm_phase(PG8_LAS unsigned char* lds, const Gemm g, const Sched& S, const Epi& E) {
    int tid_ = threadIdx.x; asm volatile("" : "+v"(tid_));
    const int tid = tid_, wid = __builtin_amdgcn_readfirstlane(tid >> 6), lane = tid & 63, wr = wid >> 2, wc = wid & 3, fr = lane & 15, fq = lane >> 4;
    const int K = g.K, nt = K / BK;
    unsigned voffA[2], voffB[2];
#pragma unroll
    for (int i = 0; i < 2; ++i) { int R, C; stage_rc(tid * 16 + i * 8192, R, C); const int Rb = Epi::PERM ? ((R & ~31) + perm32(R & 31)) : R;
        voffA[i] = (unsigned)(R * K + C) * 2u; voffB[i] = (unsigned)(Rb * K + C) * 2u; }
    const size_t kstep = (size_t)(BK * 2);
    const size_t hstep = (size_t)HALF * K * 2;
    const size_t tstep = 2 * hstep;
    const unsigned ldsw = (unsigned)wid * 1024u;
    const int aoff = lds_byte(wr * 64 + fr, fq * 8), boff = lds_byte(wc * 32 + fr, fq * 8);
#define PG8_SA(b, h) (((b) * 2 + (h)) * HTB)
#define PG8_SB(b, h) ((4 + (b) * 2 + (h)) * HTB)
#define PG8_STAGE(bufoff, gbase, voff) do { _Pragma("unroll") for (int _i = 0; _i < 2; ++_i) \
        __builtin_amdgcn_global_load_lds((const unsigned*)((const char*)(gbase) + (voff)[_i]), (PG8_LAS unsigned*)(lds + (bufoff) + ldsw + _i * 8192), 16, 0, 0); } while (0)
#define PG8_LDA(dst, b, h) do { _Pragma("unroll") for (int m = 0; m < 4; ++m) _Pragma("unroll") for (int k = 0; k < 2; ++k) dst[m][k] = *(const PG8_LAS bf16x8*)(lds + PG8_SA(b, h) + aoff + m * 2048 + k * 1024); } while (0)
#define PG8_LDB(dst, b, h) do { _Pragma("unroll") for (int n = 0; n < 2; ++n) _Pragma("unroll") for (int k = 0; k < 2; ++k) dst[n][k] = *(const PG8_LAS bf16x8*)(lds + PG8_SB(b, h) + boff + n * 2048 + k * 1024); } while (0)
#define PG8_MMA(ai, bj, At, Bt) do { __builtin_amdgcn_s_setprio(1); _Pragma("unroll") for (int m = 0; m < 4; ++m) _Pragma("unroll") for (int n = 0; n < 2; ++n) _Pragma("unroll") for (int k = 0; k < 2; ++k) \
        acc[ai][bj][m][n] = mma16<F16>(Bt[n][k], At[m][k], acc[ai][bj][m][n]); __builtin_amdgcn_s_setprio(0); } while (0)
#define PG8_WAIT_V(n) asm volatile("s_waitcnt vmcnt(" #n ")" ::: "memory")
#define PG8_WAIT_L(n) asm volatile("s_waitcnt lgkmcnt(" #n ")" ::: "memory")
#define PG8_BAR __builtin_amdgcn_s_barrier()
#define PG8_SCHED __builtin_amdgcn_sched_barrier(0)
    Unit cur, nxt; int ui = 0;
    if (!S.next(0, cur)) return;
    f32x4 acc[2][2][4][2];
#pragma unroll
    for (int a = 0; a < 2; ++a)
#pragma unroll
        for (int b = 0; b < 2; ++b)
#pragma unroll
            for (int m = 0; m < 4; ++m)
#pragma unroll
                for (int n = 0; n < 2; ++n) acc[a][b][m][n] = (f32x4){0.f, 0.f, 0.f, 0.f};
    bf16x8 At[4][2], B0[2][2], B1[2][2];
    const char* cA = (const char*)g.A + (size_t)cur.pm * tstep; const char* cB = (const char*)g.Bt + (size_t)cur.pn * tstep;
    S.a_ready(cur);
    if constexpr (SP2) {
        PG8_STAGE(PG8_SB(0, 0), cB, voffB); PG8_STAGE(PG8_SB(0, 1), cB + hstep, voffB); PG8_STAGE(PG8_SA(0, 0), cA, voffA); PG8_STAGE(PG8_SA(0, 1), cA + hstep, voffA);
        if (wr == 1) PG8_BAR;
        PG8_WAIT_V(2); PG8_BAR;
        PG8_STAGE(PG8_SB(1, 0), cB + kstep, voffB); PG8_STAGE(PG8_SA(1, 0), cA + kstep, voffA); PG8_STAGE(PG8_SB(1, 1), cB + hstep + kstep, voffB);
        PG8_WAIT_V(6); PG8_BAR;
    } else {
        PG8_STAGE(PG8_SB(0, 0), cB, voffB); PG8_STAGE(PG8_SA(0, 0), cA, voffA); PG8_STAGE(PG8_SB(0, 1), cB + hstep, voffB); PG8_STAGE(PG8_SA(0, 1), cA + hstep, voffA);
        if (wr == 1) PG8_BAR;
        PG8_WAIT_V(4); PG8_BAR;
        PG8_STAGE(PG8_SB(1, 0), cB + kstep, voffB); PG8_STAGE(PG8_SA(1, 0), cA + kstep, voffA); PG8_STAGE(PG8_SB(1, 1), cB + hstep + kstep, voffB);
        PG8_WAIT_V(6); PG8_BAR;
    }
    for (;;) {
        const bool has_next = S.next(ui + 1, nxt);
        const char* nA = has_next ? (const char*)g.A + (size_t)nxt.pm * tstep : cA; const char* nB = has_next ? (const char*)g.Bt + (size_t)nxt.pn * tstep : cB;
        for (int t = 0; t < nt; t += 2) {
            const bool last = (t == nt - 2);
            const char* a1 = cA + (size_t)(t + 1) * kstep;
            const char* a2 = last ? nA : cA + (size_t)(t + 2) * kstep; const char* b2 = last ? nB : cB + (size_t)(t + 2) * kstep;
            const char* a3 = a2 + kstep; const char* b3 = b2 + kstep;
            if (last && has_next) S.a_ready(nxt);
            if constexpr (SP2) {
            PG8_LDB(B0, 0, 0); PG8_LDB(B1, 0, 1); PG8_SCHED; PG8_LDA(At, 0, 0); PG8_STAGE(PG8_SA(1, 1), a1 + hstep, voffA);
            PG8_WAIT_V(8); PG8_WAIT_L(0); PG8_BAR; PG8_MMA(0, 0, At, B0); PG8_MMA(0, 1, At, B1); PG8_BAR; PG8_SCHED;
            PG8_LDA(At, 0, 1); PG8_STAGE(PG8_SB(0, 0), b2, voffB); PG8_STAGE(PG8_SB(0, 1), b2 + hstep, voffB); PG8_STAGE(PG8_SA(0, 0), a2, voffA);
            PG8_WAIT_V(8); PG8_WAIT_L(0); PG8_BAR; PG8_MMA(1, 0, At, B0); PG8_MMA(1, 1, At, B1); PG8_BAR; PG8_SCHED;
            PG8_LDB(B0, 1, 0); PG8_LDB(B1, 1, 1); PG8_SCHED; PG8_LDA(At, 1, 0); PG8_STAGE(PG8_SA(0, 1), a2 + hstep, voffA);
            PG8_WAIT_V(8); PG8_WAIT_L(0); PG8_BAR; PG8_MMA(0, 0, At, B0); PG8_MMA(0, 1, At, B1); PG8_BAR; PG8_SCHED;
            PG8_LDA(At, 1, 1); PG8_STAGE(PG8_SB(1, 0), b3, voffB); PG8_STAGE(PG8_SB(1, 1), b3 + hstep, voffB); PG8_STAGE(PG8_SA(1, 0), a3, voffA);
            PG8_WAIT_V(8); PG8_WAIT_L(0); PG8_BAR; PG8_MMA(1, 0, At, B0); PG8_MMA(1, 1, At, B1); PG8_BAR; PG8_SCHED;
            } else {
            PG8_LDB(B0, 0, 0); PG8_SCHED; PG8_LDA(At, 0, 0); PG8_STAGE(PG8_SA(1, 1), a1 + hstep, voffA);
            PG8_WAIT_L(8); PG8_BAR; PG8_WAIT_L(0); PG8_MMA(0, 0, At, B0); PG8_BAR; PG8_SCHED;
            PG8_LDB(B1, 0, 1); PG8_STAGE(PG8_SB(0, 0), b2, voffB);
            PG8_BAR; PG8_WAIT_L(0); PG8_MMA(0, 1, At, B1); PG8_BAR;
            PG8_LDA(At, 0, 1); PG8_STAGE(PG8_SA(0, 0), a2, voffA);
            PG8_BAR; PG8_WAIT_L(0); PG8_MMA(1, 0, At, B0); PG8_BAR; PG8_SCHED;
            PG8_STAGE(PG8_SB(0, 1), b2 + hstep, voffB);
            PG8_WAIT_V(6); PG8_BAR; PG8_MMA(1, 1, At, B1); PG8_BAR;
            PG8_LDB(B0, 1, 0); PG8_SCHED; PG8_LDA(At, 1, 0); PG8_STAGE(PG8_SA(0, 1), a2 + hstep, voffA);
            PG8_WAIT_L(8); PG8_BAR; PG8_WAIT_L(0); PG8_MMA(0, 0, At, B0); PG8_BAR; PG8_SCHED;
            PG8_LDB(B1, 1, 1); PG8_STAGE(PG8_SB(1, 0), b3, voffB);
            PG8_BAR; PG8_WAIT_L(0); PG8_MMA(0, 1, At, B1); PG8_BAR;
            PG8_LDA(At, 1, 1); PG8_STAGE(PG8_SA(1, 0), a3, voffA);
            PG8_BAR; PG8_WAIT_L(0); PG8_MMA(1, 0, At, B0); PG8_BAR; PG8_SCHED;
            PG8_STAGE(PG8_SB(1, 1), b3 + hstep, voffB);
            PG8_WAIT_V(6); PG8_BAR; PG8_MMA(1, 1, At, B1); PG8_BAR;
            }
        }
        if constexpr (ALIGN_EPI) { if (wr == 0) PG8_BAR; }
        if constexpr (!Epi::AFTER_DRAIN) { E(acc, cur, wr, wc, fr, fq); S.done(cur); }
        if (!has_next) break;
#pragma unroll
        for (int a = 0; a < 2; ++a)
#pragma unroll
            for (int b = 0; b < 2; ++b)
#pragma unroll
                for (int m = 0; m < 4; ++m)
#pragma unroll
                    for (int n = 0; n < 2; ++n) acc[a][b][m][n] = (f32x4){0.f, 0.f, 0.f, 0.f};
        cur = nxt; cA = nA; cB = nB; ++ui;
        if constexpr (ALIGN_EPI) { if (wr == 1) PG8_BAR; }
    }
    PG8_WAIT_V(0);
    if constexpr (!ALIGN_EPI) { if (wr == 0) PG8_BAR; }
    PG8_BAR;
    if constexpr (Epi::AFTER_DRAIN) { E.fused(acc, cur, wr, wc, fr, fq, lds, wid, lane); S.done(cur); }
}
template <class Epi, class Sched, bool F16 = false>
__device__ __forceinline__ void gemm_phase_gather(PG8_LAS unsigned char* lds, const Gemm g, const Sched& S, const Epi& E, const PG8_LAS int* tokl) {
    constexpr bool ALIGN_EPI = true, SP2 = true;
    int tid_ = threadIdx.x; asm volatile("" : "+v"(tid_));
    const int tid = tid_, wid = __builtin_amdgcn_readfirstlane(tid >> 6), lane = tid & 63, wr = wid >> 2, wc = wid & 3, fr = lane & 15, fq = lane >> 4;
    const int K = g.K, nt = K / BK;
    unsigned voffB[2]; int Ra[2], Ca[2];
#pragma unroll
    for (int i = 0; i < 2; ++i) { int R, C; stage_rc(tid * 16 + i * 8192, R, C); const int Rb = Epi::PERM ? ((R & ~31) + perm32(R & 31)) : R;
        Ra[i] = R; Ca[i] = C; voffB[i] = (unsigned)(Rb * K + C) * 2u; }
    unsigned vA0[2], vA1[2], vN0[2], vN1[2];
#define PG8_TOKOFF(ui_, V0, V1) do { _Pragma("unroll") for (int i = 0; i < 2; ++i) { const int t0_ = tokl[(ui_) * 256 + Ra[i]], t1_ = tokl[(ui_) * 256 + 128 + Ra[i]]; \
        V0[i] = ((unsigned)t0_ * (unsigned)K + (unsigned)Ca[i]) * 2u; V1[i] = ((unsigned)t1_ * (unsigned)K + (unsigned)Ca[i]) * 2u; } } while (0)
    const size_t kstep = (size_t)(BK * 2);
    const size_t hstep = (size_t)HALF * K * 2;
    const size_t tstep = 2 * hstep;
    const unsigned ldsw = (unsigned)wid * 1024u;
    const int aoff = lds_byte(wr * 64 + fr, fq * 8), boff = lds_byte(wc * 32 + fr, fq * 8);
#define PG8_SA(b, h) (((b) * 2 + (h)) * HTB)
#define PG8_SB(b, h) ((4 + (b) * 2 + (h)) * HTB)
#define PG8_STAGE(bufoff, gbase, voff) do { _Pragma("unroll") for (int _i = 0; _i < 2; ++_i) \
        __builtin_amdgcn_global_load_lds((const unsigned*)((const char*)(gbase) + (voff)[_i]), (PG8_LAS unsigned*)(lds + (bufoff) + ldsw + _i * 8192), 16, 0, 0); } while (0)
#define PG8_LDA(dst, b, h) do { _Pragma("unroll") for (int m = 0; m < 4; ++m) _Pragma("unroll") for (int k = 0; k < 2; ++k) dst[m][k] = *(const PG8_LAS bf16x8*)(lds + PG8_SA(b, h) + aoff + m * 2048 + k * 1024); } while (0)
#define PG8_LDB(dst, b, h) do { _Pragma("unroll") for (int n = 0; n < 2; ++n) _Pragma("unroll") for (int k = 0; k < 2; ++k) dst[n][k] = *(const PG8_LAS bf16x8*)(lds + PG8_SB(b, h) + boff + n * 2048 + k * 1024); } while (0)
#define PG8_MMA(ai, bj, At, Bt) do { __builtin_amdgcn_s_setprio(1); _Pragma("unroll") for (int m = 0; m < 4; ++m) _Pragma("unroll") for (int n = 0; n < 2; ++n) _Pragma("unroll") for (int k = 0; k < 2; ++k) \
        acc[ai][bj][m][n] = mma16<F16>(Bt[n][k], At[m][k], acc[ai][bj][m][n]); __builtin_amdgcn_s_setprio(0); } while (0)
#define PG8_WAIT_V(n) asm volatile("s_waitcnt vmcnt(" #n ")" ::: "memory")
#define PG8_WAIT_L(n) asm volatile("s_waitcnt lgkmcnt(" #n ")" ::: "memory")
#define PG8_BAR __builtin_amdgcn_s_barrier()
#define PG8_SCHED __builtin_amdgcn_sched_barrier(0)
    Unit cur, nxt; int ui = 0;
    if (!S.next(0, cur)) return;
    f32x4 acc[2][2][4][2];
#pragma unroll
    for (int a = 0; a < 2; ++a)
#pragma unroll
        for (int b = 0; b < 2; ++b)
#pragma unroll
            for (int m = 0; m < 4; ++m)
#pragma unroll
                for (int n = 0; n < 2; ++n) acc[a][b][m][n] = (f32x4){0.f, 0.f, 0.f, 0.f};
    bf16x8 At[4][2], B0[2][2], B1[2][2];
    const char* cA = (const char*)g.A; PG8_TOKOFF(0, vA0, vA1); const char* cB = (const char*)g.Bt + (size_t)cur.pn * tstep;
    S.a_ready(cur);
    if constexpr (SP2) {
        PG8_STAGE(PG8_SB(0, 0), cB, voffB); PG8_STAGE(PG8_SB(0, 1), cB + hstep, voffB); PG8_STAGE(PG8_SA(0, 0), cA, vA0); PG8_STAGE(PG8_SA(0, 1), cA, vA1);
        if (wr == 1) PG8_BAR;
        PG8_WAIT_V(2); PG8_BAR;
        PG8_STAGE(PG8_SB(1, 0), cB + kstep, voffB); PG8_STAGE(PG8_SA(1, 0), cA + kstep, vA0); PG8_STAGE(PG8_SB(1, 1), cB + hstep + kstep, voffB);
        PG8_WAIT_V(6); PG8_BAR;
    } else {
        PG8_STAGE(PG8_SB(0, 0), cB, voffB); PG8_STAGE(PG8_SA(0, 0), cA, vA0); PG8_STAGE(PG8_SB(0, 1), cB + hstep, voffB); PG8_STAGE(PG8_SA(0, 1), cA, vA1);
        if (wr == 1) PG8_BAR;
        PG8_WAIT_V(4); PG8_BAR;
        PG8_STAGE(PG8_SB(1, 0), cB + kstep, voffB); PG8_STAGE(PG8_SA(1, 0), cA + kstep, vA0); PG8_STAGE(PG8_SB(1, 1), cB + hstep + kstep, voffB);
        PG8_WAIT_V(6); PG8_BAR;
    }
    for (;;) {
        const bool has_next = S.next(ui + 1, nxt);
        if (has_next) PG8_TOKOFF(ui + 1, vN0, vN1); else { vN0[0] = vA0[0]; vN0[1] = vA0[1]; vN1[0] = vA1[0]; vN1[1] = vA1[1]; }
        const char* nA = cA; const char* nB = has_next ? (const char*)g.Bt + (size_t)nxt.pn * tstep : cB;
        for (int t = 0; t < nt; t += 2) {
            const bool last = (t == nt - 2);
            const char* a1 = cA + (size_t)(t + 1) * kstep;
            const char* a2 = last ? nA : cA + (size_t)(t + 2) * kstep; const char* b2 = last ? nB : cB + (size_t)(t + 2) * kstep;
            const char* a3 = a2 + kstep; const char* b3 = b2 + kstep;
            unsigned v20[2], v21[2];
#pragma unroll
            for (int i = 0; i < 2; ++i) { v20[i] = last ? vN0[i] : vA0[i]; v21[i] = last ? vN1[i] : vA1[i]; }
            if (last && has_next) S.a_ready(nxt);
            if constexpr (SP2) {
            PG8_LDB(B0, 0, 0); PG8_LDB(B1, 0, 1); PG8_SCHED; PG8_LDA(At, 0, 0); PG8_STAGE(PG8_SA(1, 1), a1, vA1);
            PG8_WAIT_V(8); PG8_WAIT_L(0); PG8_BAR; PG8_MMA(0, 0, At, B0); PG8_MMA(0, 1, At, B1); PG8_BAR; PG8_SCHED;
            PG8_LDA(At, 0, 1); PG8_STAGE(PG8_SB(0, 0), b2, voffB); PG8_STAGE(PG8_SB(0, 1), b2 + hstep, voffB); PG8_STAGE(PG8_SA(0, 0), a2, v20);
            PG8_WAIT_V(8); PG8_WAIT_L(0); PG8_BAR; PG8_MMA(1, 0, At, B0); PG8_MMA(1, 1, At, B1); PG8_BAR; PG8_SCHED;
            PG8_LDB(B0, 1, 0); PG8_LDB(B1, 1, 1); PG8_SCHED; PG8_LDA(At, 1, 0); PG8_STAGE(PG8_SA(0, 1), a2, v21);
            PG8_WAIT_V(8); PG8_WAIT_L(0); PG8_BAR; PG8_MMA(0, 0, At, B0); PG8_MMA(0, 1, At, B1); PG8_BAR; PG8_SCHED;
            PG8_LDA(At, 1, 1); PG8_STAGE(PG8_SB(1, 0), b3, voffB); PG8_STAGE(PG8_SB(1, 1), b3 + hstep, voffB); PG8_STAGE(PG8_SA(1, 0), a3, v20);
            PG8_WAIT_V(8); PG8_WAIT_L(0); PG8_BAR; PG8_MMA(1, 0, At, B0); PG8_MMA(1, 1, At, B1); PG8_BAR; PG8_SCHED;
            } else {
            PG8_LDB(B0, 0, 0); PG8_SCHED; PG8_LDA(At, 0, 0); PG8_STAGE(PG8_SA(1, 1), a1, vA1);
            PG8_WAIT_L(8); PG8_BAR; PG8_WAIT_L(0); PG8_MMA(0, 0, At, B0); PG8_BAR; PG8_SCHED;
            PG8_LDB(B1, 0, 1); PG8_STAGE(PG8_SB(0, 0), b2, voffB);
            PG8_BAR; PG8_WAIT_L(0); PG8_MMA(0, 1, At, B1); PG8_BAR;
            PG8_LDA(At, 0, 1); PG8_STAGE(PG8_SA(0, 0), a2, v20);
            PG8_BAR; PG8_WAIT_L(0); PG8_MMA(1, 0, At, B0); PG8_BAR; PG8_SCHED;
            PG8_STAGE(PG8_SB(0, 1), b2 + hstep, voffB);
            PG8_WAIT_V(6); PG8_BAR; PG8_MMA(1, 1, At, B1); PG8_BAR;
            PG8_LDB(B0, 1, 0); PG8_SCHED; PG8_LDA(At, 1, 0); PG8_STAGE(PG8_SA(0, 1), a2, v21);
            PG8_WAIT_L(8); PG8_BAR; PG8_WAIT_L(0); PG8_MMA(0, 0, At, B0); PG8_BAR; PG8_SCHED;
            PG8_LDB(B1, 1, 1); PG8_STAGE(PG8_SB(1, 0), b3, voffB);
            PG8_BAR; PG8_WAIT_L(0); PG8_MMA(0, 1, At, B1); PG8_BAR;
            PG8_LDA(At, 1, 1); PG8_STAGE(PG8_SA(1, 0), a3, v20);
            PG8_BAR; PG8_WAIT_L(0); PG8_MMA(1, 0, At, B0); PG8_BAR; PG8_SCHED;
            PG8_STAGE(PG8_SB(1, 1), b3 + hstep, voffB);
            PG8_WAIT_V(6); PG8_BAR; PG8_MMA(1, 1, At, B1); PG8_BAR;
            }
        }
        if constexpr (ALIGN_EPI) { if (wr == 0) PG8_BAR; }
        if constexpr (!Epi::AFTER_DRAIN) { E(acc, cur, wr, wc, fr, fq); S.done(cur); }
        if (!has_next) break;
#pragma unroll
        for (int a = 0; a < 2; ++a)
#pragma unroll
            for (int b = 0; b < 2; ++b)
#pragma unroll
                for (int m = 0; m < 4; ++m)
#pragma unroll
                    for (int n = 0; n < 2; ++n) acc[a][b][m][n] = (f32x4){0.f, 0.f, 0.f, 0.f};
        cur = nxt; cA = nA; cB = nB; ++ui; vA0[0] = vN0[0]; vA0[1] = vN0[1]; vA1[0] = vN1[0]; vA1[1] = vN1[1];
        if constexpr (ALIGN_EPI) { if (wr == 1) PG8_BAR; }
    }
    PG8_WAIT_V(0);
    if constexpr (!ALIGN_EPI) { if (wr == 0) PG8_BAR; }
    PG8_BAR;
    if constexpr (Epi::AFTER_DRAIN) { E.fused(acc, cur, wr, wc, fr, fq, lds, wid, lane); S.done(cur); }
#undef PG8_TOKOFF
#undef PG8_SA
#undef PG8_SB
#undef PG8_STAGE
#undef PG8_LDA
#undef PG8_LDB
#undef PG8_MMA
#undef PG8_WAIT_V
#undef PG8_WAIT_L
#undef PG8_BAR
#undef PG8_SCHED
}
}

#define LAS __attribute__((address_space(3)))
#define XB_TMO      128
#define XB_XCNT(j)  (256  + 64 * (j))
#define XB_XSUB(j)  (1280 + 64 * (j))
#define XB_XGEN(j)  (2304 + 64 * (j))
#define XB_TOP      3328
#define XB_TOPGEN   3392
#define XCD_BAR_WORDS 3456
#define XB_SPIN_CAP (1u << 22)

__device__ __forceinline__ unsigned xb_ld(unsigned* p)              { return __hip_atomic_load(p, __ATOMIC_RELAXED, __HIP_MEMORY_SCOPE_AGENT); }
__device__ __forceinline__ unsigned xb_add(unsigned* p, unsigned v) { return __hip_atomic_fetch_add(p, v, __ATOMIC_RELAXED, __HIP_MEMORY_SCOPE_AGENT); }
__device__ __forceinline__ unsigned xb_xcc_id() { return (unsigned)__builtin_amdgcn_s_getreg((3 << 11) | 20) & 0xFu; }
#define XB_SPIN(cond, bar) do { unsigned _sp = 0; while (cond) { __builtin_amdgcn_s_sleep(1); \
    if ((++_sp & 255u) == 0u) { if (xb_ld(&(bar)[XB_TMO])) break; if (_sp > XB_SPIN_CAP) { atomicAdd(&(bar)[XB_TMO], 1u); break; } } } } while (0)

struct XcdBarrier {
    unsigned* bar; unsigned x;
    volatile LAS unsigned* st;
};

__device__ __forceinline__ XcdBarrier xcd_barrier_post(unsigned* bar, volatile LAS unsigned* st) {
    XcdBarrier b; b.bar = bar; b.x = xb_xcc_id(); b.st = st;
    if (threadIdx.x == 0) (void)xb_add(&bar[XB_XCNT(b.x)], 1u);
    return b;
}
__device__ __forceinline__ void xcd_barrier_complete(unsigned* bar, unsigned x, unsigned& nloc, unsigned& nx) {
    const unsigned G = gridDim.x * gridDim.y * gridDim.z;
    unsigned sum, cnt, mine, sp = 0u;
    for (;;) {
        sum = 0u; cnt = 0u; mine = 0u;
#pragma unroll
        for (unsigned j = 0; j < 16; ++j) { const unsigned c = xb_ld(&bar[XB_XCNT(j)]); sum += c; cnt += (c > 0u) ? 1u : 0u; mine = (j == x) ? c : mine; }
        if (sum == G) break;
        __builtin_amdgcn_s_sleep(1);
        if ((++sp & 255u) == 0u) { if (xb_ld(&bar[XB_TMO])) break; if (sp > XB_SPIN_CAP) { atomicAdd(&bar[XB_TMO], 1u); break; } }
    }
    nloc = mine > 0u ? mine : 1u; nx = cnt > 0u ? cnt : 1u;
}

__device__ __forceinline__ void xcd_barrier(const XcdBarrier& b) {
    asm volatile("s_waitcnt vmcnt(0)" ::: "memory");
    __syncthreads();
    if (threadIdx.x == 0) {
        unsigned* bar = b.bar;
        __builtin_amdgcn_s_waitcnt(0);
        unsigned nloc = b.st[0], nx = b.st[1];
        if (nloc == 0u) { xcd_barrier_complete(bar, b.x, nloc, nx); b.st[0] = nloc; b.st[1] = nx; }
        const unsigned old = xb_add(&bar[XB_XSUB(b.x)], 1u);
        const unsigned gen = old / nloc;
        if (old + 1u == (gen + 1u) * nloc) {
            __builtin_amdgcn_fence(__ATOMIC_RELEASE, "agent");
            asm volatile("s_waitcnt vmcnt(0)" ::: "memory");
            const unsigned og = xb_add(&bar[XB_TOP], 1u);
            const unsigned tg = og / nx;
            if (og + 1u == (tg + 1u) * nx) xb_add(&bar[XB_TOPGEN], 1u);
            else XB_SPIN(xb_ld(&bar[XB_TOPGEN]) == tg, bar);
            __builtin_amdgcn_fence(__ATOMIC_ACQUIRE, "agent");
            xb_add(&bar[XB_XGEN(b.x)], 1u);
            asm volatile("s_waitcnt vmcnt(0)" ::: "memory");
        } else {
            XB_SPIN(xb_ld(&bar[XB_XGEN(b.x)]) == gen, bar);
            __builtin_amdgcn_fence(__ATOMIC_ACQUIRE, "agent");
            asm volatile("s_waitcnt vmcnt(0)" ::: "memory");
        }
    }
    __syncthreads();
}

constexpr int NWAVES = 8;
constexpr int BATCH = 8, SEQ = 4096, D = 1024, T = BATCH * SEQ, DEPTH = 4;
constexpr int NQKV = 3072, NH4 = 4096, NEXP = 32, FEXP = 512;
constexpr int MAX_TILES = 288;
constexpr float ALPHA = 1.6817928305074292f;
constexpr float LN_EPS = 1e-5f, RMS_EPS = 1e-6f;
constexpr size_t MiB = 1u << 20;
constexpr size_t WS_CTL = 0, CTL_ZERO_BYTES = 1 * MiB;
constexpr size_t WS_ROPE = 1 * MiB;
constexpr size_t WS_LB = 1 * MiB + 256 * 1024;
constexpr size_t WS_KMEAN = 256 * 1024;
constexpr size_t WS_CNTL = 768 * 1024;
constexpr size_t WS_RW = 2 * MiB + 256 * 1024;
constexpr size_t WS_POS = 2 * MiB + 512 * 1024;
constexpr size_t WS_WR = 4 * MiB;
constexpr size_t WS_GCNT = 960 * 1024;
constexpr size_t WS_TOK2 = 72 * MiB;
constexpr int TOKCAP = 32768;
constexpr size_t WS_X = 8 * MiB;
constexpr size_t WS_XB = 136 * MiB;
constexpr size_t WS_WIN = 200 * MiB, WS_WOUT = 208 * MiB, WS_W13 = 210 * MiB, WS_W2 = 274 * MiB;
constexpr size_t WS_MIX = 306 * MiB;
constexpr size_t WS_O = 562 * MiB;
constexpr size_t WS_QF = 626 * MiB, WS_KF = 690 * MiB, WS_VF = 754 * MiB;
constexpr size_t WS_INTRA = 818 * MiB, WS_INTER = 882 * MiB;
constexpr size_t WS_DEC = 946 * MiB;
constexpr size_t WS_MO = 626 * MiB;
constexpr size_t WS_W13B = 136 * MiB, WS_W2B = 950 * MiB;
constexpr size_t WS_XG = 306 * MiB, WS_HB = 450 * MiB, WS_YB = 522 * MiB;
constexpr size_t WS_END = 982 * MiB;
constexpr int CW_BAR = 4096;
constexpr int CW_CNT = 16384;
constexpr int CW_CUR = 16384 + 512;
constexpr int RING_BYTES = 131072, LDS_BYTES = 163840, MISC_OFF = LDS_BYTES - 4096;

#define GAS __attribute__((address_space(1)))
typedef unsigned short bf16;
typedef unsigned v4u __attribute__((ext_vector_type(4)));
typedef unsigned v2u __attribute__((ext_vector_type(2)));
typedef float f32x4 __attribute__((ext_vector_type(4)));
typedef float f32x8 __attribute__((ext_vector_type(8)));
typedef _Float16 f16x4 __attribute__((ext_vector_type(4)));
typedef _Float16 f16x8 __attribute__((ext_vector_type(8)));
#define LDS_WAIT() asm volatile("s_waitcnt lgkmcnt(0)" ::: "memory")
#define WG_SYNC() asm volatile("s_waitcnt lgkmcnt(0)\n\ts_barrier" ::: "memory")
__device__ __forceinline__ unsigned pk2(float lo, float hi) { typedef float f2_t_ __attribute__((ext_vector_type(2))); typedef __bf16 b2_t_ __attribute__((ext_vector_type(2))); const f2_t_ v = {lo, hi}; return __builtin_bit_cast(unsigned, __builtin_convertvector(v, b2_t_)); }
__device__ __forceinline__ unsigned f2bf(float f) { return pk2(f, f) & 0xffffu; }
__device__ __forceinline__ unsigned pk2h(float lo, float hi) { typedef _Float16 h2_t __attribute__((ext_vector_type(2))); typedef float f2_t __attribute__((ext_vector_type(2))); const f2_t v = {lo, hi}; return __builtin_bit_cast(unsigned, __builtin_convertvector(v, h2_t)); }
__device__ __forceinline__ float bf2f(unsigned short b) { return __builtin_bit_cast(float, (unsigned)b << 16); }
__device__ __forceinline__ float bflo(unsigned w) { return __builtin_bit_cast(float, w << 16); }
__device__ __forceinline__ float bfhi(unsigned w) { return __builtin_bit_cast(float, w & 0xffff0000u); }
__device__ __forceinline__ float wave_sum(float v) {
#pragma unroll
    for (int o = 1; o < 64; o <<= 1) v += __shfl_xor(v, o);
    return v;
}

#define AS_GLOBAL(T, p) ((T)(__attribute__((address_space(1))) unsigned char*)(unsigned char*)(p))
struct Frame {
    LAS unsigned char* lds;
    volatile LAS unsigned* MISC;
    unsigned char* ws;
    int tid, lane, wave, gw, NGW, G;
};
__device__ __forceinline__ const float* in_ptr(const Frame& F, int i) {
    const unsigned lo = __builtin_amdgcn_readfirstlane(F.MISC[512 + 2 * i]), hi = __builtin_amdgcn_readfirstlane(F.MISC[513 + 2 * i]);
    GAS const float* pg_ = (GAS const float*)(((unsigned long long)hi << 32) | lo); asm volatile("" : "+s"(pg_)); return (const float*)pg_;
}
#define LAUNDER_WS() GAS unsigned char* ws0_ = (GAS unsigned char*)F.ws; int bx = blockIdx.x; asm volatile("" : "+s"(ws0_), "+s"(bx)); unsigned char* ws = (unsigned char*)ws0_
#define PHASE_BEGIN() GAS unsigned char* ws0_ = (GAS unsigned char*)F.ws; int tid = threadIdx.x, bx = blockIdx.x; asm volatile("" : "+s"(ws0_), "+v"(tid), "+s"(bx)); unsigned char* ws = (unsigned char*)ws0_; const int lane = tid & 63, gw = bx * NWAVES + __builtin_amdgcn_readfirstlane(tid >> 6); (void)tid; (void)gw; (void)lane; (void)bx
struct CvtItem { const float* src; bf16* dst; int N, K; bool f16; };
constexpr int CVT_MOE = 64 * 256 + 32 * 256;
__device__ __forceinline__ void cvt_decode(Frame& F, unsigned char* ws, int l, int r, CvtItem& it) {
    const int j = l >> 1; const bool even = (l & 1) == 0; const int Nin = even ? NQKV : NH4;
    const int I_in = 16 * (Nin / 32), I_13 = 64 * 256, I_2 = 32 * 256;
    if (r < I_13) { const int mat = r >> 8, e = mat >> 1, which = mat & 1, q = r & 255, kb = q >> 4, n0 = (q & 15) * 32;
        const float* W = in_ptr(F, which ? 14 : 13) + (size_t)(l * NEXP + e) * D * FEXP;
        it.src = W + (size_t)kb * 64 * FEXP + n0; it.dst = (bf16*)(ws + ((l & 1) ? WS_W13B : WS_W13)) + ((size_t)e * 1024 + (size_t)(n0 >> 7) * 256 + (n0 & 127) + which * 128) * D + kb * 64; it.N = FEXP; it.K = D; it.f16 = true; return; } r -= I_13;
    if (r < I_2) { const int e = r >> 8, q = r & 255, kb = q >> 5, n0 = (q & 31) * 32; const float* W = in_ptr(F, 15) + (size_t)(l * NEXP + e) * FEXP * D;
        it.src = W + (size_t)kb * 64 * D + n0; it.dst = (bf16*)(ws + ((l & 1) ? WS_W2B : WS_W2)) + ((size_t)e * 1024 + n0) * FEXP + kb * 64; it.N = D; it.K = FEXP; it.f16 = false; return; } r -= I_2;
    if (r < I_in) { const int nb = Nin / 32, kb = r / nb, n0 = (r % nb) * 32; const float* W = even ? in_ptr(F, 1) + (size_t)j * D * NQKV : in_ptr(F, 3) + (size_t)j * D * NH4;
        it.src = W + (size_t)kb * 64 * Nin + n0; it.dst = (bf16*)(ws + WS_WIN) + (size_t)n0 * D + kb * 64; it.N = Nin; it.K = D; it.f16 = true; return; } r -= I_in;
    { const int kb = r / 32, n0 = (r % 32) * 32; const float* W = (even ? in_ptr(F, 2) : in_ptr(F, 4)) + (size_t)j * D * D;
        it.src = W + (size_t)kb * 64 * D + n0; it.dst = (bf16*)(ws + WS_WOUT) + (size_t)n0 * D + kb * 64; it.N = D; it.K = D; it.f16 = false; }
}
__device__ __forceinline__ void cvt_run(Frame& F, unsigned char* ws, int lane, int l, int first, int end, int stride, int scr_off = -1) {
    LAS float* scr = (LAS float*)(F.lds + (scr_off < 0 ? F.wave * 16384 : scr_off));
    const int kr = lane >> 3, nc = lane & 7, c = lane & 7;
    CvtItem cur, nxt; f32x4 v[8], vn[8];
    int itx = first;
    if (itx < end) { cvt_decode(F, ws, l, itx, cur);
#pragma unroll
        for (int i = 0; i < 8; ++i) v[i] = *(const f32x4*)(cur.src + (size_t)(8 * i + kr) * cur.N + 4 * nc); }
    for (; itx < end; itx += stride) {
        const bool more = itx + stride < end;
        if (more) { cvt_decode(F, ws, l, itx + stride, nxt);
#pragma unroll
            for (int i = 0; i < 8; ++i) vn[i] = *(const f32x4*)(nxt.src + (size_t)(8 * i + kr) * nxt.N + 4 * nc); }
#pragma unroll
        for (int i = 0; i < 8; ++i) { LAS float* sp = scr + (8 * i + kr) * 33 + 4 * nc; sp[0] = v[i].x; sp[1] = v[i].y; sp[2] = v[i].z; sp[3] = v[i].w; }
        LDS_WAIT(); asm volatile("" ::: "memory");
#pragma unroll
        for (int jq = 0; jq < 4; ++jq) { const int n = (lane >> 3) + 8 * jq; const LAS float* s = scr + (8 * c) * 33 + n;
            v4u o; if (cur.f16) { o.x = pk2h(s[0 * 33], s[1 * 33]); o.y = pk2h(s[2 * 33], s[3 * 33]); o.z = pk2h(s[4 * 33], s[5 * 33]); o.w = pk2h(s[6 * 33], s[7 * 33]); }
            else { o.x = pk2(s[0 * 33], s[1 * 33]); o.y = pk2(s[2 * 33], s[3 * 33]); o.z = pk2(s[4 * 33], s[5 * 33]); o.w = pk2(s[6 * 33], s[7 * 33]); }
            *(v4u*)(cur.dst + (size_t)n * cur.K + 8 * c) = o; }
        LDS_WAIT(); asm volatile("" ::: "memory");
        if (more) { cur = nxt;
#pragma unroll
            for (int i = 0; i < 8; ++i) v[i] = vn[i]; }
    }
}
__device__ __forceinline__ int cvt_tail(Frame& F, int l, int ntiles, int vc, int start, int per, int when) {
    const int total = ntiles * 4, maxu = (total + F.G - 1) / F.G, rem = total - (maxu - 1) * F.G, nidle = F.G - rem;
    int covered = start + nidle * per; covered = covered > CVT_MOE ? CVT_MOE : covered;
    if (vc >= rem && ((vc - rem) & 1) == when) { PHASE_BEGIN(); const int r = vc - rem; int e0 = start + r * per, e1 = e0 + per; e1 = e1 > CVT_MOE ? CVT_MOE : e1;
        if (e0 < e1) cvt_run(F, ws, lane, l, e0 + F.wave, e1, NWAVES); }
    return covered;
}
__device__ __forceinline__ void convert_weights(Frame& F, int l, int moe_from) {
    PHASE_BEGIN();
    const int Nin = (l & 1) == 0 ? NQKV : NH4; const int NIT = CVT_MOE + 16 * (Nin / 32) + 16 * 32;
    cvt_run(F, ws, lane, l, moe_from + gw, NIT, F.NGW);
    { const float* wg = in_ptr(F, 9) + (size_t)l * D * 4; const float* we = in_ptr(F, 11) + (size_t)l * D * 32; unsigned char* WR = ws + WS_WR;
      const int gt = gw * 64 + lane;
      if (gt < 32 * 3 * 64) { const int ln = gt & 63, nt = (gt >> 6) % 3, ks = gt / 192; const int n = 16 * nt + (ln & 15), k0 = 32 * ks + 8 * (ln >> 4);
          unsigned hiw[4], low[4];
#pragma unroll
          for (int jj = 0; jj < 8; ++jj) { const int k = k0 + jj; const float w = n < 4 ? wg[(size_t)k * 4 + n] : (n < 36 ? we[(size_t)k * 32 + (n - 4)] : 0.f);
              const unsigned h = f2bf(w); const float rem = w - bf2f((unsigned short)h); const unsigned lo2 = f2bf(rem);
              if (jj & 1) { hiw[jj >> 1] |= h << 16; low[jj >> 1] |= lo2 << 16; } else { hiw[jj >> 1] = h; low[jj >> 1] = lo2; } }
          v4u a, b2; a.x = hiw[0]; a.y = hiw[1]; a.z = hiw[2]; a.w = hiw[3]; b2.x = low[0]; b2.y = low[1]; b2.z = low[2]; b2.w = low[3];
          *(v4u*)(WR + ((size_t)((ks * 3 + nt) * 2 + 0) * 64 + ln) * 16) = a; *(v4u*)(WR + ((size_t)((ks * 3 + nt) * 2 + 1) * 64 + ln) * 16) = b2; } }
}

__device__ __forceinline__ void prologue(Frame& F) {
    PHASE_BEGIN();
    const float* x = in_ptr(F, 0); _Float16* xh = (_Float16*)(ws + WS_X);
    for (int m = gw; m < T; m += F.NGW) {
        const f32x4* xr = (const f32x4*)(x + (size_t)m * D) + lane; f16x4* o8 = (f16x4*)(xh + (size_t)m * D) + lane;
#pragma unroll
        for (int j = 0; j < 4; ++j) o8[64 * j] = __builtin_convertvector(xr[64 * j], f16x4);
    }
    float* rope = (float*)(ws + WS_ROPE);
    const int gt = gw * 64 + lane, NGT = F.NGW * 64;
    for (int idx = gt; idx < SEQ * 8; idx += NGT) { const int pos = idx >> 3, i = idx & 7;
        const float inv = powf(500000.0f, -(float)i / 8.0f); const float ang = (float)pos * inv;
        rope[pos * 16 + i] = cosf(ang); rope[pos * 16 + 8 + i] = sinf(ang); }
    float* lb = (float*)(ws + WS_LB);
    for (int idx = gt; idx < D; idx += NGT) { const float l0 = in_ptr(F, 6)[idx], l1 = in_ptr(F, 6)[D + idx];
        lb[idx] = 0.f; lb[D + idx] = 1.0f / (1.0f + expf(l0 - l1)); }
}


#ifndef PROBE_MASK
#define PROBE_MASK 0
#endif
#define STAMP(g) do { if (PROBE_MASK != 0 && blockIdx.x == 0 && F.tid == 0) { const unsigned now_ = (unsigned)__builtin_amdgcn_s_memrealtime(); F.MISC[600 + (g)] += now_ - F.MISC[599]; F.MISC[599] = now_; } } while (0)
typedef float f32x16 __attribute__((ext_vector_type(16)));
typedef short s16x4 __attribute__((ext_vector_type(4)));
typedef short bf16x8v __attribute__((ext_vector_type(8)));
typedef float f32x2_t __attribute__((ext_vector_type(2))); typedef __bf16 bf16x2_t __attribute__((ext_vector_type(2)));
__device__ __forceinline__ unsigned cvtpk_s(float lo, float hi) { f32x2_t v = {lo, hi}; bf16x2_t b = __builtin_convertvector(v, bf16x2_t); return __builtin_bit_cast(unsigned, b); }
__device__ __forceinline__ int crow(int r, int hi) { return (r & 3) + 8 * (r >> 2) + 4 * hi; }
constexpr float ATT_C2 = 0.125f * 1.4426950408889634f;
__device__ __forceinline__ s16x4 lds_tr(LAS unsigned char* p) { typedef short v4i16_t __attribute__((ext_vector_type(4))); return __builtin_bit_cast(s16x4, __builtin_amdgcn_ds_read_tr16_b64_v4i16((LAS v4i16_t*)p)); }

template <int NS>
__device__ __forceinline__ void softmax_step(f32x16 (&p)[NS], float& m, float& l, f32x16 (&o)[2], bf16x8v (&pf)[NS][2]) {
    float mx = p[0][0];
#pragma unroll
    for (int s = 0; s < NS; ++s)
#pragma unroll
        for (int r = 0; r < 16; ++r) mx = fmaxf(mx, p[s][r]);
    { const auto rr = __builtin_amdgcn_permlane32_swap(__builtin_bit_cast(unsigned, mx), __builtin_bit_cast(unsigned, mx), false, false); float r_; asm("v_max_f32_e32 %0, %1, %2" : "=v"(r_) : "v"(rr[0]), "v"(rr[1])); mx = r_; }
    const float mn = fmaxf(m, mx * ATT_C2);
    const float alpha = __builtin_amdgcn_exp2f(m - mn);
    m = mn; float sum = 0.f;
#pragma unroll
    for (int s = 0; s < NS; ++s)
#pragma unroll
        for (int r = 0; r < 16; ++r) { const float e = __builtin_amdgcn_exp2f(p[s][r] * ATT_C2 - mn); p[s][r] = e; sum += e; }
    l = l * alpha + sum;
    if (!__all(alpha == 1.0f)) {
#pragma unroll
        for (int d0 = 0; d0 < 2; ++d0)
#pragma unroll
            for (int r = 0; r < 16; ++r) o[d0][r] *= alpha;
    }
#pragma unroll
    for (int s = 0; s < NS; ++s)
#pragma unroll
        for (int k = 0; k < 2; ++k) { union { unsigned u[4]; bf16x8v v; } t;
#pragma unroll
            for (int j = 0; j < 4; ++j) t.u[j] = cvtpk_s(p[s][8 * k + 2 * j], p[s][8 * k + 2 * j + 1]);
            pf[s][k] = t.v; }
}
template <int NS>
__device__ __forceinline__ void pv_step(LAS unsigned char* vbase, const unsigned (&vb)[2], const bf16x8v (&pf)[NS][2], f32x16 (&o)[2]) {
    s16x4 lo[2 * NS][2], hi[2 * NS][2];
#pragma unroll
    for (int ks = 0; ks < 2 * NS; ++ks)
#pragma unroll
        for (int d0 = 0; d0 < 2; ++d0) { lo[ks][d0] = lds_tr(vbase + vb[d0] + ks * 2048); hi[ks][d0] = lds_tr(vbase + vb[d0] + ks * 2048 + 1024); }
    asm volatile("s_waitcnt lgkmcnt(0)" ::: "memory"); __builtin_amdgcn_sched_barrier(0);
#pragma unroll
    for (int ks = 0; ks < 2 * NS; ++ks)
#pragma unroll
        for (int d0 = 0; d0 < 2; ++d0) { const bf16x8v vf = {lo[ks][d0][0], lo[ks][d0][1], lo[ks][d0][2], lo[ks][d0][3], hi[ks][d0][0], hi[ks][d0][1], hi[ks][d0][2], hi[ks][d0][3]};
            o[d0] = __builtin_amdgcn_mfma_f32_32x32x16_bf16(vf, pf[ks >> 1][ks & 1], o[d0], 0, 0, 0); }
}
__device__ __forceinline__ void store_ot(bf16* orow  , const f32x16 (&o)[2], float rl, int hi) {
#pragma unroll
    for (int d0 = 0; d0 < 2; ++d0)
#pragma unroll
        for (int rg = 0; rg < 4; ++rg) { v2u w; w.x = cvtpk_s(o[d0][4 * rg] * rl, o[d0][4 * rg + 1] * rl); w.y = cvtpk_s(o[d0][4 * rg + 2] * rl, o[d0][4 * rg + 3] * rl);
            *(v2u*)(orow + 32 * d0 + 8 * rg + 4 * hi) = w; }
}

__device__ __forceinline__ void win_tile(LAS unsigned char* Kt, LAS unsigned char* Vt, const bf16x8v (&qr)[4], int q, int hi, const unsigned (&vb)[2], float& m, float& l, f32x16 (&o)[2], int k0, int tq) {
    bf16x8v kfr[2][4];
#pragma unroll
    for (int sub = 0; sub < 2; ++sub)
#pragma unroll
        for (int d0 = 0; d0 < 4; ++d0) { const int row = 32 * sub + q; kfr[sub][d0] = *(const LAS bf16x8v*)(Kt + row * 128 + (((2 * d0 + hi) ^ ((row >> 1) & 7)) << 4)); }
    asm volatile("s_waitcnt lgkmcnt(0)" ::: "memory"); __builtin_amdgcn_sched_barrier(0);
    f32x16 p[2];
    p[0] = __builtin_amdgcn_mfma_f32_32x32x16_bf16(kfr[0][0], qr[0], f32x16{}, 0, 0, 0); p[1] = __builtin_amdgcn_mfma_f32_32x32x16_bf16(kfr[1][0], qr[0], f32x16{}, 0, 0, 0);
#pragma unroll
    for (int d0 = 1; d0 < 4; ++d0) { p[0] = __builtin_amdgcn_mfma_f32_32x32x16_bf16(kfr[0][d0], qr[d0], p[0], 0, 0, 0); p[1] = __builtin_amdgcn_mfma_f32_32x32x16_bf16(kfr[1][d0], qr[d0], p[1], 0, 0, 0); }
    { const int base_ = tq - k0 - 4 * hi; const unsigned lim_ = (unsigned)(128 < tq ? 128 : tq);
#pragma unroll
      for (int sub = 0; sub < 2; ++sub)
#pragma unroll
          for (int r = 0; r < 16; ++r) { const int dist_ = base_ - (32 * sub + (r & 3) + 8 * (r >> 2)); if ((unsigned)dist_ > lim_) p[sub][r] = -INFINITY; } }
    bf16x8v pf[2][2];
    softmax_step<2>(p, m, l, o, pf);
    pv_step<2>(Vt, vb, pf, o);
}
constexpr int AL_KM = 0, AL_K = 4096, AL_V2 = 4096 + 32768, AL_WV = 40960;
__device__ __forceinline__ void attn_fast_phase(Frame& F, int jl) {
    PHASE_BEGIN();
    const bf16* qkv = (const bf16*)(ws + WS_MIX); bf16* O = (bf16*)(ws + WS_O); const float* km = (const float*)(ws + WS_KMEAN) + (size_t)jl * 65536;
    LAS unsigned char* L = F.lds;
    const int wid = __builtin_amdgcn_readfirstlane(tid >> 6), q = lane & 31, hi = lane >> 5;
    unsigned vb[2];
    { const int i = lane & 15, g1 = (lane >> 4) & 1, sw = (lane >> 3) & 1;
      const unsigned base = (unsigned)((4 * hi + (i >> 2)) * 128 + (2 * g1 + ((i >> 1) & 1)) * 16 + (i & 1) * 8);
      vb[0] = base + (unsigned)((0 ^ sw) * 64); vb[1] = base + (unsigned)((1 ^ sw) * 64); }
    { int* LISTS = (int*)(ws + WS_KF); int* CNTL = (int*)(ws + WS_CNTL) + jl * 16384;
      for (int task = gw; task < 64 * 15 * 8; task += F.NGW) {
          const int grp = task & 7; int r_ = task >> 3;
          if (F.G == 256) { const int k_ = r_ >> 8, i_ = r_ & 255; const int s_ = k_ == 0 ? i_ : (k_ == 1 ? 959 - i_ : (k_ == 2 ? 256 + i_ : 703 - i_)); r_ = (s_ & 63) * 15 + (s_ >> 6); }
          const int own = 1 + (r_ % 15), bh = r_ / 15, b = bh >> 3, h = bh & 7;
          const int tq = 256 * own + 32 * grp + q;
          bf16x8v qr[4];
#pragma unroll
          for (int d0 = 0; d0 < 4; ++d0) qr[d0] = *(const bf16x8v*)(qkv + ((size_t)b * SEQ + tq) * NQKV + h * 64 + 16 * d0 + 8 * hi);
          float g[16];
#pragma unroll
          for (int n = 0; n < 16; ++n) { g[n] = -INFINITY;
              if (n < own) { float sacc = 0.f; const float* kp = km + (size_t)bh * 1024 + n * 64 + 8 * hi;
#pragma unroll
                  for (int d0 = 0; d0 < 4; ++d0) { const f32x4 k0 = *(const f32x4*)(kp + 16 * d0), k1 = *(const f32x4*)(kp + 16 * d0 + 4);
                      sacc += bf2f((unsigned short)qr[d0][0]) * k0.x + bf2f((unsigned short)qr[d0][1]) * k0.y + bf2f((unsigned short)qr[d0][2]) * k0.z + bf2f((unsigned short)qr[d0][3]) * k0.w
                            + bf2f((unsigned short)qr[d0][4]) * k1.x + bf2f((unsigned short)qr[d0][5]) * k1.y + bf2f((unsigned short)qr[d0][6]) * k1.z + bf2f((unsigned short)qr[d0][7]) * k1.w; }
                  g[n] = sacc + __shfl_xor(sacc, 32); } }
          const int nsel = own < 3 ? own : 3; unsigned selmask = 0u;
          for (int sl = 0; sl < nsel; ++sl) { float best = -INFINITY; int bi = 0;
#pragma unroll
              for (int n = 0; n < 16; ++n) if (!((selmask >> n) & 1u) && g[n] > best) { best = g[n]; bi = n; }
              selmask |= 1u << bi;
              int mycnt = 0, rank = 0;
#pragma unroll
              for (int n = 0; n < 15; ++n) { const unsigned long long mk = __ballot(hi == 0 && bi == n); if (lane == n) mycnt = __popcll(mk); if (bi == n) rank = __popcll(mk & ((1ull << lane) - 1ull)); }
              int base = 0;
              if (lane < 15 && mycnt > 0) base = __hip_atomic_fetch_add(CNTL + (bh * 16 + lane) * 16, mycnt, __ATOMIC_RELAXED, __HIP_MEMORY_SCOPE_AGENT);
              const int pos = __shfl(base, bi) + rank;
              if (hi == 0) LISTS[((size_t)bh * 16 + bi) * 4096 + pos] = tq | (sl << 12); }
      } }
    {
        bf16* PART = (bf16*)(ws + WS_QF); float* PML = (float*)(ws + WS_DEC);
        const int srow = tid >> 3, sch = tid & 7;
        const unsigned kst = (unsigned)(srow * 128 + ((sch ^ ((srow >> 1) & 7)) << 4)), vst = (unsigned)(srow * 128 + ((sch ^ (((srow >> 1) & 1) << 2)) << 4));
        v4u rk[6], rv[6];
#define PA_LOAD(u_) do { const int qb_ = (u_) & 15, h_ = ((u_) >> 4) & 7, b_ = (u_) >> 7; const bf16* kb_ = qkv + (size_t)b_ * SEQ * NQKV + 2048 + h_ * 64 + sch * 8; \
            _Pragma("unroll") for (int i6 = 0; i6 < 6; ++i6) { int key_ = 256 * qb_ - 128 + 64 * i6 + srow; key_ = key_ < 0 ? 0 : (key_ > SEQ - 1 ? SEQ - 1 : key_); rk[i6] = *(const v4u*)(kb_ + (size_t)key_ * NQKV); rv[i6] = *(const v4u*)(kb_ + (size_t)key_ * NQKV + 512); } } while (0)
#define PA_STORE() do { _Pragma("unroll") for (int i6 = 0; i6 < 6; ++i6) { *(LAS v4u*)(L + AL_K + i6 * 8192 + kst) = rk[i6]; *(LAS v4u*)(L + AL_K + 49152 + i6 * 8192 + vst) = rv[i6]; } } while (0)
        PA_LOAD(bx * 4); PA_STORE();
        WG_SYNC();
        for (int k4 = 0; k4 < 4; ++k4) {
            const int u = bx * 4 + k4, qb = u & 15, h = (u >> 4) & 7, b = u >> 7;
            if (k4 < 3) PA_LOAD(u + 1);
            const size_t rowbase = (size_t)b * SEQ; const int tq = 256 * qb + 32 * wid + q;
            bf16x8v qr[4];
#pragma unroll
            for (int d0 = 0; d0 < 4; ++d0) qr[d0] = *(const bf16x8v*)(qkv + (rowbase + tq) * NQKV + 1536 + h * 64 + 16 * d0 + 8 * hi);
            float m = -1e30f, l = 0.f; f32x16 o[2]; o[0] = f32x16{}; o[1] = f32x16{};
            for (int jt = (wid >> 1); jt <= (wid >> 1) + 2; ++jt) win_tile(L + AL_K + jt * 8192, L + AL_K + 49152 + jt * 8192, qr, q, hi, vb, m, l, o, 256 * qb - 128 + 64 * jt, tq);
            { const float lt = l + __shfl_xor(l, 32); bf16* pp = PART + ((size_t)(b * 8 + h) * SEQ + tq) * 64 + hi * 32;
#pragma unroll
              for (int d0 = 0; d0 < 2; ++d0)
#pragma unroll
                  for (int rg2 = 0; rg2 < 2; ++rg2) { v4u w; w.x = cvtpk_s(o[d0][8 * rg2], o[d0][8 * rg2 + 1]); w.y = cvtpk_s(o[d0][8 * rg2 + 2], o[d0][8 * rg2 + 3]); w.z = cvtpk_s(o[d0][8 * rg2 + 4], o[d0][8 * rg2 + 5]); w.w = cvtpk_s(o[d0][8 * rg2 + 6], o[d0][8 * rg2 + 7]);
                      *(v4u*)(pp + 16 * d0 + 8 * rg2) = w; }
              if (hi == 0) { float* ml = PML + ((size_t)(b * 8 + h) * SEQ + tq) * 2; ml[0] = m; ml[1] = lt; } }
            WG_SYNC();
            if (k4 < 3) { PA_STORE(); WG_SYNC(); }
        }
#undef PA_LOAD
#undef PA_STORE
    }
}
#define DIL_LOAD(k0_, stride_, KF, VV) do { int kp_ = (k0_) + q * (stride_); kp_ = kp_ < 0 ? 0 : (kp_ > SEQ - 1 ? SEQ - 1 : kp_); \
                _Pragma("unroll") for (int d0 = 0; d0 < 4; ++d0) KF[d0] = *(const bf16x8v*)(Kb + (size_t)kp_ * NQKV + 16 * d0 + 8 * hi); \
                _Pragma("unroll") for (int jj = 0; jj < 4; ++jj) { int vp_ = (k0_) + (vr0 + 8 * jj) * (stride_); vp_ = vp_ < 0 ? 0 : (vp_ > SEQ - 1 ? SEQ - 1 : vp_); VV[jj] = *(const v4u*)(Vb + (size_t)vp_ * NQKV + vch * 8); } } while (0)
#define DIL_BODY(k0, stride, W) do { f32x16 p[1]; p[0] = f32x16{}; \
                _Pragma("unroll") for (int d0 = 0; d0 < 4; ++d0) p[0] = __builtin_amdgcn_mfma_f32_32x32x16_bf16(kf[d0], qr[d0], p[0], 0, 0, 0); \
                _Pragma("unroll") for (int r = 0; r < 16; ++r) { const int pos = (k0) + crow(r, hi) * (stride), dist = tq - pos; if (pos < 0 || dist < 0 || dist > (W)) p[0][r] = -INFINITY; } \
                _Pragma("unroll") for (int jj = 0; jj < 4; ++jj) { const int row = vr0 + 8 * jj; *(LAS v4u*)(Vt + row * 128 + ((vch ^ (((row >> 1) & 1) << 2)) << 4)) = vv[jj]; } \
                bf16x8v pf[1][2]; softmax_step<1>(p, m, l, o, pf); pv_step<1>(Vt, vb, pf, o); } while (0)
__device__ __forceinline__ void moba_tile(LAS unsigned char* Kt, LAS unsigned char* Vt, const bf16x8v (&qr)[4], int q, int hi, const unsigned (&vb)[2], float& m, float& l, f32x16 (&o)[2], int diag, int qrel) {
    bf16x8v kfr[2][4];
#pragma unroll
    for (int sub = 0; sub < 2; ++sub)
#pragma unroll
        for (int d0 = 0; d0 < 4; ++d0) { const int row = 32 * sub + q; kfr[sub][d0] = *(const LAS bf16x8v*)(Kt + row * 128 + (((2 * d0 + hi) ^ ((row >> 1) & 7)) << 4)); }
    asm volatile("s_waitcnt lgkmcnt(0)" ::: "memory"); __builtin_amdgcn_sched_barrier(0);
    f32x16 p[2];
    p[0] = __builtin_amdgcn_mfma_f32_32x32x16_bf16(kfr[0][0], qr[0], f32x16{}, 0, 0, 0); p[1] = __builtin_amdgcn_mfma_f32_32x32x16_bf16(kfr[1][0], qr[0], f32x16{}, 0, 0, 0);
#pragma unroll
    for (int d0 = 1; d0 < 4; ++d0) { p[0] = __builtin_amdgcn_mfma_f32_32x32x16_bf16(kfr[0][d0], qr[d0], p[0], 0, 0, 0); p[1] = __builtin_amdgcn_mfma_f32_32x32x16_bf16(kfr[1][d0], qr[d0], p[1], 0, 0, 0); }
    if (diag >= 0) {
#pragma unroll
        for (int sub = 0; sub < 2; ++sub)
#pragma unroll
            for (int r = 0; r < 16; ++r) if (64 * diag + 32 * sub + crow(r, hi) > qrel) p[sub][r] = -INFINITY;
    }
    bf16x8v pf[2][2];
    softmax_step<2>(p, m, l, o, pf);
    pv_step<2>(Vt, vb, pf, o);
}
__device__ __forceinline__ void attn_gather_phase(Frame& F, int jl) {
    PHASE_BEGIN();
    const bf16* qkv = (const bf16*)(ws + WS_MIX); const int* LISTS = (const int*)(ws + WS_KF); const int* CNTL = (const int*)(ws + WS_CNTL) + jl * 16384;
    bf16* PO = (bf16*)(ws + WS_VF); float* PMLG = (float*)(ws + WS_INTER);
    LAS unsigned char* L = F.lds;
    const int wid = __builtin_amdgcn_readfirstlane(tid >> 6), q = lane & 31, hi = lane >> 5;
    unsigned vb[2];
    { const int i = lane & 15, g1 = (lane >> 4) & 1, sw = (lane >> 3) & 1;
      const unsigned base = (unsigned)((4 * hi + (i >> 2)) * 128 + (2 * g1 + ((i >> 1) & 1)) * 16 + (i & 1) * 8);
      vb[0] = base + (unsigned)((0 ^ sw) * 64); vb[1] = base + (unsigned)((1 ^ sw) * 64); }
    const int bh = (bx & 7) + 8 * (bx >> 5), gsel = (bx >> 3) & 3;
    if (bh < 64) {
        const int b = bh >> 3, h = bh & 7; const size_t rowbase = (size_t)b * SEQ;
        const unsigned code = gsel == 0 ? 0xEDCB0u : (gsel == 1 ? 0xA51u : (gsel == 2 ? 0x942u : 0x8763u)); const int nblk = gsel == 0 ? 5 : (gsel == 3 ? 4 : 3);
        const int srow = tid >> 3, sch = tid & 7;
        const bf16* kg = qkv + rowbase * NQKV + 512 + h * 64 + sch * 8 + (size_t)srow * NQKV; const bf16* vg = kg + 512;
        const unsigned kst = (unsigned)(srow * 128 + ((sch ^ ((srow >> 1) & 7)) << 4)), vst = (unsigned)(srow * 128 + ((sch ^ (((srow >> 1) & 1) << 2)) << 4));
        v4u rk[4], rv[4];
#define MOBA_LOADB(blk) do { _Pragma("unroll") for (int i4 = 0; i4 < 4; ++i4) { rk[i4] = *(const v4u*)(kg + (size_t)(256 * (blk) + 64 * i4) * NQKV); rv[i4] = *(const v4u*)(vg + (size_t)(256 * (blk) + 64 * i4) * NQKV); } } while (0)
#define MOBA_STOREB(bufi) do { _Pragma("unroll") for (int i4 = 0; i4 < 4; ++i4) { *(LAS v4u*)(L + AL_K + (bufi) * 65536 + i4 * 8192 + kst) = rk[i4]; *(LAS v4u*)(L + AL_V2 + (bufi) * 65536 + i4 * 8192 + vst) = rv[i4]; } } while (0)
        MOBA_LOADB((int)(code & 15u)); MOBA_STOREB(0);
        WG_SYNC();
        for (int bi = 0; bi < nblk; ++bi) {
            const int cur = bi & 1, n = (int)((code >> (4 * bi)) & 15u);
            if (bi + 1 < nblk) MOBA_LOADB((int)((code >> (4 * (bi + 1))) & 15u));
            int cnt = CNTL[(bh * 16 + n) * 16]; cnt = cnt > 3840 ? 3840 : cnt; const int ntile = (cnt + 31) >> 5;
            const int* lst = LISTS + ((size_t)bh * 16 + n) * 4096;
            bf16x8v qn[4]; int en = 0; bool vn = false;
#define GATH_FETCH(tile_) do { const int idx_ = 32 * (tile_) + q; vn = idx_ < cnt; en = lst[vn ? idx_ : 0]; const int t_ = en & 4095; \
                _Pragma("unroll") for (int d0 = 0; d0 < 4; ++d0) qn[d0] = *(const bf16x8v*)(qkv + (rowbase + t_) * NQKV + h * 64 + 16 * d0 + 8 * hi); } while (0)
            if (wid < ntile) GATH_FETCH(wid);
            for (int tile = wid; tile < ntile; tile += NWAVES) {
                const bool valid = vn; const int t = en & 4095, slot = (en >> 12) & 3;
                bf16x8v qr[4];
#pragma unroll
                for (int d0 = 0; d0 < 4; ++d0) qr[d0] = qn[d0];
                if (tile + NWAVES < ntile) GATH_FETCH(tile + NWAVES);
                float m = -1e30f, l = 0.f; f32x16 o[2]; o[0] = f32x16{}; o[1] = f32x16{};
                for (int jt = 0; jt < 4; ++jt) moba_tile(L + AL_K + cur * 65536 + jt * 8192, L + AL_V2 + cur * 65536 + jt * 8192, qr, q, hi, vb, m, l, o, -1, 0);
                const float lt = l + __shfl_xor(l, 32);
                if (valid) { bf16* pp = PO + (((size_t)bh * SEQ + t) * 3 + slot) * 64 + hi * 32;
#pragma unroll
                    for (int d0 = 0; d0 < 2; ++d0)
#pragma unroll
                        for (int rg2 = 0; rg2 < 2; ++rg2) { v4u w; w.x = cvtpk_s(o[d0][8 * rg2], o[d0][8 * rg2 + 1]); w.y = cvtpk_s(o[d0][8 * rg2 + 2], o[d0][8 * rg2 + 3]); w.z = cvtpk_s(o[d0][8 * rg2 + 4], o[d0][8 * rg2 + 5]); w.w = cvtpk_s(o[d0][8 * rg2 + 6], o[d0][8 * rg2 + 7]);
                            *(v4u*)(pp + 16 * d0 + 8 * rg2) = w; }
                    if (hi == 0) { float* ml = PMLG + (((size_t)bh * SEQ + t) * 3 + slot) * 2; ml[0] = m; ml[1] = lt; } }
            }
#undef GATH_FETCH
            if (bi + 1 < nblk) MOBA_STOREB(cur ^ 1);
            WG_SYNC();
        }
    }
}
__device__ __forceinline__ void attn_own_phase(Frame& F) {
    PHASE_BEGIN();
    const bf16* qkv = (const bf16*)(ws + WS_MIX); bf16* O = (bf16*)(ws + WS_O); const bf16* PO = (const bf16*)(ws + WS_VF); const float* PMLG = (const float*)(ws + WS_INTER);
    LAS unsigned char* L = F.lds;
    const int wid = __builtin_amdgcn_readfirstlane(tid >> 6), q = lane & 31, hi = lane >> 5;
    unsigned vb[2];
    { const int i = lane & 15, g1 = (lane >> 4) & 1, sw = (lane >> 3) & 1;
      const unsigned base = (unsigned)((4 * hi + (i >> 2)) * 128 + (2 * g1 + ((i >> 1) & 1)) * 16 + (i & 1) * 8);
      vb[0] = base + (unsigned)((0 ^ sw) * 64); vb[1] = base + (unsigned)((1 ^ sw) * 64); }
    const int bh = (bx & 7) + 8 * (bx >> 5), s4 = (bx >> 3) & 3;
    if (bh < 64) {
        const int b = bh >> 3, h = bh & 7; const size_t rowbase = (size_t)b * SEQ;
        const int srow = tid >> 3, sch = tid & 7;
        const bf16* kg = qkv + rowbase * NQKV + 512 + h * 64 + sch * 8 + (size_t)srow * NQKV; const bf16* vg = kg + 512;
        const unsigned kst = (unsigned)(srow * 128 + ((sch ^ ((srow >> 1) & 7)) << 4)), vst = (unsigned)(srow * 128 + ((sch ^ (((srow >> 1) & 1) << 2)) << 4));
        v4u rk[4], rv[4];
#define OWN_OF(k4_) ((k4_) == 0 ? s4 : ((k4_) == 1 ? 7 - s4 : ((k4_) == 2 ? 8 + s4 : 15 - s4)))
        MOBA_LOADB(OWN_OF(0)); MOBA_STOREB(0);
        WG_SYNC();
        for (int k4 = 0; k4 < 4; ++k4) {
            const int own = OWN_OF(k4), cur = k4 & 1;
            if (k4 < 3) MOBA_LOADB(OWN_OF(k4 + 1));
            const int qrel = 32 * wid + q, tq = 256 * own + qrel;
            bf16x8v qr[4];
#pragma unroll
            for (int d0 = 0; d0 < 4; ++d0) qr[d0] = *(const bf16x8v*)(qkv + (rowbase + tq) * NQKV + h * 64 + 16 * d0 + 8 * hi);
            const int nsel = own < 3 ? own : 3;
            v4u pw[3][4]; float pm_[3], pl_[3];
#pragma unroll
            for (int sl = 0; sl < 3; ++sl) if (sl < nsel) { const bf16* pp = PO + (((size_t)bh * SEQ + tq) * 3 + sl) * 64 + hi * 32; const float* ml = PMLG + (((size_t)bh * SEQ + tq) * 3 + sl) * 2;
#pragma unroll
                for (int c4 = 0; c4 < 4; ++c4) pw[sl][c4] = *(const v4u*)(pp + 8 * c4);
                pm_[sl] = ml[0]; pl_[sl] = ml[1]; }
            float m = -1e30f, l = 0.f; f32x16 o[2]; o[0] = f32x16{}; o[1] = f32x16{};
            for (int jt = 0; jt <= (wid >> 1); ++jt) moba_tile(L + AL_K + cur * 65536 + jt * 8192, L + AL_V2 + cur * 65536 + jt * 8192, qr, q, hi, vb, m, l, o, jt == (wid >> 1) ? jt : -1, qrel);
#pragma unroll
            for (int sl = 0; sl < 3; ++sl) if (sl < nsel) {
                const float mn = fmaxf(m, pm_[sl]); const float a = __builtin_amdgcn_exp2f(m - mn), c = __builtin_amdgcn_exp2f(pm_[sl] - mn); m = mn;
                l = l * a + (hi == 0 ? pl_[sl] * c : 0.f);
#pragma unroll
                for (int d0 = 0; d0 < 2; ++d0)
#pragma unroll
                    for (int rg2 = 0; rg2 < 2; ++rg2) { const v4u w = pw[sl][2 * d0 + rg2]; const unsigned wu[4] = {w.x, w.y, w.z, w.w};
#pragma unroll
                        for (int k2 = 0; k2 < 4; ++k2) { o[d0][8 * rg2 + 2 * k2] = o[d0][8 * rg2 + 2 * k2] * a + bflo(wu[k2]) * c; o[d0][8 * rg2 + 2 * k2 + 1] = o[d0][8 * rg2 + 2 * k2 + 1] * a + bfhi(wu[k2]) * c; } } }
            { const float lt = l + __shfl_xor(l, 32); store_ot(O + (rowbase + tq) * D + h * 64, o, 1.0f / lt, hi); }
            if (k4 < 3) MOBA_STOREB(cur ^ 1);
            WG_SYNC();
        }
#undef OWN_OF
    }
#undef MOBA_LOADB
#undef MOBA_STOREB
}
__device__ __forceinline__ void attn_dil2_phase(Frame& F, int cvt_layer) {
    PHASE_BEGIN();
    int cvt_next = gw;
    const bf16* qkv = (const bf16*)(ws + WS_MIX); bf16* O = (bf16*)(ws + WS_O);
    const bf16* PART = (const bf16*)(ws + WS_QF); const float* PML = (const float*)(ws + WS_DEC);
    LAS unsigned char* L = F.lds;
    const int wid = __builtin_amdgcn_readfirstlane(tid >> 6), q = lane & 31, hi = lane >> 5;
    unsigned vb[2];
    { const int i = lane & 15, g1 = (lane >> 4) & 1, sw = (lane >> 3) & 1;
      const unsigned base = (unsigned)((4 * hi + (i >> 2)) * 128 + (2 * g1 + ((i >> 1) & 1)) * 16 + (i & 1) * 8);
      vb[0] = base + (unsigned)((0 ^ sw) * 64); vb[1] = base + (unsigned)((1 ^ sw) * 64); }
    LAS unsigned char* Vt = L + AL_WV + wid * 4096;
    const int vch = lane & 7, vr0 = lane >> 3;
    for (int task = gw; task < BATCH * 8 * 16 * 8; task += F.NGW) {
        const int iw = (task + task / F.NGW) & 7, r16 = (task >> 3) & 15, h = (task >> 7) & 7, b = task >> 10;
        const size_t rowbase = (size_t)b * SEQ; const int tlo = r16 + 512 * iw, tq = tlo + 16 * q;
        const bf16* Kb = qkv + rowbase * NQKV + 2048 + h * 64; const bf16* Vb = qkv + rowbase * NQKV + 2560 + h * 64;
        bf16x8v qr[4];
#pragma unroll
        for (int d0 = 0; d0 < 4; ++d0) qr[d0] = *(const bf16x8v*)(qkv + (rowbase + tq) * NQKV + 1536 + h * 64 + 16 * d0 + 8 * hi);
        float m, l; f32x16 o[2];
        { const bf16* pp = PART + ((size_t)(b * 8 + h) * SEQ + tq) * 64 + hi * 32; const float* ml = PML + ((size_t)(b * 8 + h) * SEQ + tq) * 2;
#pragma unroll
          for (int d0 = 0; d0 < 2; ++d0)
#pragma unroll
              for (int rg2 = 0; rg2 < 2; ++rg2) { const v4u w = *(const v4u*)(pp + 16 * d0 + 8 * rg2);
                  o[d0][8 * rg2] = bflo(w.x); o[d0][8 * rg2 + 1] = bfhi(w.x); o[d0][8 * rg2 + 2] = bflo(w.y); o[d0][8 * rg2 + 3] = bfhi(w.y);
                  o[d0][8 * rg2 + 4] = bflo(w.z); o[d0][8 * rg2 + 5] = bfhi(w.z); o[d0][8 * rg2 + 6] = bflo(w.w); o[d0][8 * rg2 + 7] = bfhi(w.w); }
          m = ml[0]; l = hi == 0 ? ml[1] : 0.f; }
#define DIL_TILE(ti_, stride_, W_, k0_) do { const int br_ = (ti_) < 8 ? 1 : 2; stride_ = br_ == 1 ? 4 : 16; W_ = 128 * stride_; const int kt_ = (ti_) - (br_ == 1 ? 0 : 8); k0_ = tlo - W_ + 32 * kt_ * stride_; } while (0)
        bf16x8v kfa[4], kfb[4]; v4u vva[4], vvb[4];
        { int st_, W_, k0_; DIL_TILE(0, st_, W_, k0_); if (k0_ + 31 * st_ >= 0) DIL_LOAD(k0_, st_, kfa, vva); DIL_TILE(1, st_, W_, k0_); if (k0_ + 31 * st_ >= 0) DIL_LOAD(k0_, st_, kfb, vvb); }
#define DILB_STEP(ti, KFS, VVS) do { if ((ti) < 13) { bf16x8v kf[4]; v4u vv[4]; int stride, W, k0; DIL_TILE((ti), stride, W, k0); \
            _Pragma("unroll") for (int d0 = 0; d0 < 4; ++d0) { kf[d0] = KFS[d0]; vv[d0] = VVS[d0]; } \
            if ((ti) + 2 < 13) { int st_, W_, k0_; DIL_TILE((ti) + 2, st_, W_, k0_); if (k0_ + 31 * st_ >= 0) DIL_LOAD(k0_, st_, KFS, VVS); } \
            if (k0 + 31 * stride >= 0) DIL_BODY(k0, stride, W); } } while (0)
        for (int ti = 0; ti < 13; ti += 2) { DILB_STEP(ti, kfa, vva); DILB_STEP(ti + 1, kfb, vvb); }
#undef DILB_STEP
#undef DIL_TILE
#undef DIL_LOAD
#undef DIL_BODY
        { const float lt = l + __shfl_xor(l, 32); store_ot(O + (rowbase + tq) * D + 512 + h * 64, o, 1.0f / lt, hi); }
        if (cvt_layer >= 0) { const int e_ = cvt_next + 3 * F.NGW; cvt_run(F, ws, lane, cvt_layer, cvt_next, e_ < CVT_MOE ? e_ : CVT_MOE, F.NGW, 73728 + wid * 8448); cvt_next = e_; }
    }
    if (cvt_layer >= 0) cvt_run(F, ws, lane, cvt_layer, cvt_next, CVT_MOE, F.NGW, 73728 + wid * 8448);
}

constexpr size_t HM_STRIDE = (size_t)64 * SEQ * 128;
constexpr int HL_QS = 0, HL_KS = 17408, HL_KT = 34816, HL_VT = 53248, HL_SEG = 71680, HL_VT2 = 73728;
__device__ __forceinline__ void hgrn_h1_phase(Frame& F, int j) {
    PHASE_BEGIN();
    const bf16* H = (const bf16*)(ws + WS_MIX); const float* lbp = (const float*)(ws + WS_LB) + (size_t)j * D;
    bf16* INTRA = (bf16*)(ws + WS_INTRA); unsigned char* QF = ws + WS_QF; unsigned char* KF = ws + WS_KF; unsigned char* VF = ws + WS_VF; float* DEC = (float*)(ws + WS_DEC);
    LAS unsigned char* L = F.lds;
    const int wid = __builtin_amdgcn_readfirstlane(tid >> 6), q = lane & 31, hi = lane >> 5;
    const int d = tid & 127, tq4 = tid >> 7;
    unsigned short rq[16], rz[16], rv[16];
#define H1_LOAD(u_) do { const int c_ = (u_) & 63, bh_ = (u_) >> 6; const bf16* hp_ = H + ((size_t)bh_ * SEQ + 64 * c_ + 16 * tq4) * 128 + d;     \
        _Pragma("unroll") for (int k = 0; k < 16; ++k) { rq[k] = hp_[(size_t)k * 128]; rz[k] = hp_[(size_t)k * 128 + HM_STRIDE]; rv[k] = hp_[(size_t)k * 128 + 2 * HM_STRIDE]; } } while (0)
    if (bx < BATCH * 8 * 64) H1_LOAD(bx);
    int vto = HL_VT;
    for (int unit = bx; unit < BATCH * 8 * 64; unit += F.G, vto = (HL_VT + HL_VT2) - vto) {
        const int c = unit & 63, bh = unit >> 6, b = bh >> 3, h = bh & 7;
        const size_t row0 = (size_t)b * SEQ + 64 * c;
        const float lbv = lbp[h * 128 + d];
        float bb[16], kk[16]; float run = 0.f;
#pragma unroll
        for (int k = 0; k < 16; ++k) { const float z = bf2f(rz[k]); const float sg = __builtin_amdgcn_rcpf(1.0f + __expf(-z)); const float f = lbv + (1.0f - lbv) * sg;
            kk[k] = (1.0f - lbv) * (1.0f - sg); run += __logf(f); bb[k] = run; }
        ((LAS float*)(L + HL_SEG))[tq4 * 128 + d] = run;
        { v4u w0, w1; w0.x = rv[0] | ((unsigned)rv[1] << 16); w0.y = rv[2] | ((unsigned)rv[3] << 16); w0.z = rv[4] | ((unsigned)rv[5] << 16); w0.w = rv[6] | ((unsigned)rv[7] << 16);
          w1.x = rv[8] | ((unsigned)rv[9] << 16); w1.y = rv[10] | ((unsigned)rv[11] << 16); w1.z = rv[12] | ((unsigned)rv[13] << 16); w1.w = rv[14] | ((unsigned)rv[15] << 16);
          *(LAS v4u*)(L + vto + d * 144 + tq4 * 32) = w0; *(LAS v4u*)(L + vto + d * 144 + tq4 * 32 + 16) = w1; }
        WG_SYNC();
        { const LAS float* sg_ = (const LAS float*)(L + HL_SEG) + d; const float s0 = sg_[0], s1 = sg_[128], s2 = sg_[256], s3 = sg_[384];
          const float pre = (tq4 > 0 ? s0 : 0.f) + (tq4 > 1 ? s1 : 0.f) + (tq4 > 2 ? s2 : 0.f); const float bref = s0 + s1, blast = (s0 + s1) + (s2 + s3); const float ebl = __expf(blast - bref);
          unsigned kt[8];
#pragma unroll
          for (int k = 0; k < 16; ++k) { const float bk = pre + bb[k]; const float e1 = __expf(bk - bref), e2 = __builtin_amdgcn_rcpf(e1), e3 = e2 * ebl;
              const int t = 16 * tq4 + k;
              *(LAS unsigned short*)(L + HL_QS + t * 272 + d * 2) = (unsigned short)f2bf(bf2f(rq[k]) * e1);
              *(LAS unsigned short*)(L + HL_KS + t * 272 + d * 2) = (unsigned short)f2bf(kk[k] * e2);
              const unsigned kb = f2bf(kk[k] * e3); if (k & 1) kt[k >> 1] |= kb << 16; else kt[k >> 1] = kb; }
          { v4u w0, w1; w0.x = kt[0]; w0.y = kt[1]; w0.z = kt[2]; w0.w = kt[3]; w1.x = kt[4]; w1.y = kt[5]; w1.z = kt[6]; w1.w = kt[7];
            *(LAS v4u*)(L + HL_KT + d * 144 + tq4 * 32) = w0; *(LAS v4u*)(L + HL_KT + d * 144 + tq4 * 32 + 16) = w1; }
          if (tq4 == 0) { DEC[(size_t)unit * 256 + d] = __expf(blast); DEC[(size_t)unit * 256 + 128 + d] = __expf(bref); } }
        WG_SYNC();
        if (unit + F.G < BATCH * 8 * 64) H1_LOAD(unit + F.G);
        { const int et = wid & 3, ti = wid >> 2; f32x16 intra = f32x16{};
          for (int tj = 0; tj <= ti; ++tj) { f32x16 acc = f32x16{};
#pragma unroll
              for (int s = 0; s < 8; ++s) { const bf16x8v kf = *(const LAS bf16x8v*)(L + HL_KS + (32 * tj + q) * 272 + (16 * s + 8 * hi) * 2), qf = *(const LAS bf16x8v*)(L + HL_QS + (32 * ti + q) * 272 + (16 * s + 8 * hi) * 2);
                  acc = __builtin_amdgcn_mfma_f32_32x32x16_bf16(kf, qf, acc, 0, 0, 0); }
              if (tj == ti) {
#pragma unroll
                  for (int r = 0; r < 16; ++r) if (crow(r, hi) > q) acc[r] = 0.f;
              }
#pragma unroll
              for (int s2 = 0; s2 < 2; ++s2) { union { unsigned u[4]; bf16x8v v; } pk;
#pragma unroll
                  for (int jj = 0; jj < 4; ++jj) pk.u[jj] = cvtpk_s(acc[8 * s2 + 2 * jj], acc[8 * s2 + 2 * jj + 1]);
                  const LAS unsigned char* vp = L + vto + (32 * et + q) * 144 + (32 * tj + 16 * s2 + 4 * hi) * 2;
                  union { v2u u2[2]; bf16x8v v; } vf; vf.u2[0] = *(const LAS v2u*)vp; vf.u2[1] = *(const LAS v2u*)(vp + 16);
                  intra = __builtin_amdgcn_mfma_f32_32x32x16_bf16(vf.v, pk.v, intra, 0, 0, 0); } }
          bf16* op = INTRA + (row0 + 32 * ti + q) * D + h * 128 + 32 * et;
#pragma unroll
          for (int rg = 0; rg < 4; ++rg) { v2u w; w.x = cvtpk_s(intra[4 * rg], intra[4 * rg + 1]); w.y = cvtpk_s(intra[4 * rg + 2], intra[4 * rg + 3]); *(v2u*)(op + 8 * rg + 4 * hi) = w; } }
#pragma unroll
        for (int k6 = 0; k6 < 6; ++k6) { const int fi = wid + 8 * k6; v4u w;
            if (fi < 16) { const int ti = fi >> 3, Ts = fi & 7;
                const LAS unsigned char* p = L + HL_QS + (32 * ti + q) * 272 + (16 * Ts + 4 * hi) * 2; const v2u a = *(const LAS v2u*)p, c2 = *(const LAS v2u*)(p + 16);
                w.x = a.x; w.y = a.y; w.z = c2.x; w.w = c2.y; *(v4u*)(QF + ((size_t)unit * 16 + fi) * 1024 + lane * 16) = w; }
            else if (fi < 32) { const int f2 = fi - 16, T4 = f2 >> 2, s = f2 & 3;
                w = *(const LAS v4u*)(L + HL_KT + (32 * T4 + q) * 144 + (16 * s + 8 * hi) * 2); *(v4u*)(KF + ((size_t)unit * 16 + f2) * 1024 + lane * 16) = w; }
            else { const int f2 = fi - 32, es = f2 >> 2, s = f2 & 3;
                w = *(const LAS v4u*)(L + vto + (32 * es + q) * 144 + (16 * s + 8 * hi) * 2); *(v4u*)(VF + ((size_t)unit * 16 + f2) * 1024 + lane * 16) = w; } }
    }
}

constexpr int SL_FB = 0, SL_FBSZ = 37888  , SL_PB = 2 * SL_FBSZ, SL_PBSZ = 4 * 2 * 4608;
__device__ __forceinline__ void hgrn_h2_phase(Frame& F) {
    PHASE_BEGIN();
    if (bx >= 256) return;
    const unsigned char* QF = ws + WS_QF; const unsigned char* KF = ws + WS_KF; const unsigned char* VF = ws + WS_VF; const unsigned char* DEC = ws + WS_DEC; bf16* INTER = (bf16*)(ws + WS_INTER);
    LAS unsigned char* L = F.lds;
    const int wid = __builtin_amdgcn_readfirstlane(tid >> 6), q = lane & 31, hi = lane >> 5;
    const int bh = (bx & 7) + 8 * (bx >> 5), es = (bx >> 3) & 3, b = bh >> 3, h = bh & 7;
    f32x16 S = f32x16{};
    struct H2Regs { v4u q0, q1, k0, k1, v, d; };
    H2Regs ra, rb; ra.v = ra.d = rb.v = rb.d = (v4u){0u, 0u, 0u, 0u};
#define H2_LOAD(R, cc) do { if ((cc) < 64) { const size_t uc = (size_t)bh * 64 + (cc); R.q0 = *(const v4u*)(QF + uc * 16384 + tid * 16); R.q1 = *(const v4u*)(QF + uc * 16384 + 8192 + tid * 16); \
        R.k0 = *(const v4u*)(KF + uc * 16384 + tid * 16); R.k1 = *(const v4u*)(KF + uc * 16384 + 8192 + tid * 16); \
        if (tid < 256) R.v = *(const v4u*)(VF + uc * 16384 + es * 4096 + tid * 16); if (tid < 64) R.d = *(const v4u*)(DEC + uc * 1024 + tid * 16); } } while (0)
#define H2_STORE(R, bufi) do { LAS unsigned char* fb = L + SL_FB + (bufi) * SL_FBSZ; *(LAS v4u*)(fb + tid * 16) = R.q0; *(LAS v4u*)(fb + 8192 + tid * 16) = R.q1; \
        *(LAS v4u*)(fb + 16384 + tid * 16) = R.k0; *(LAS v4u*)(fb + 24576 + tid * 16) = R.k1; if (tid < 256) *(LAS v4u*)(fb + 32768 + tid * 16) = R.v; if (tid < 64) *(LAS v4u*)(fb + 36864 + tid * 16) = R.d; } while (0)
#define H2_REDUCE(cc) do { const LAS unsigned char* pb = L + SL_PB + ((cc) & 1) * SL_PBSZ; const int rti = tid >> 8, ri = (tid >> 3) & 31, e4 = tid & 7; f32x4 a = {0.f, 0.f, 0.f, 0.f}; \
        _Pragma("unroll") for (int T4 = 0; T4 < 4; ++T4) a += *(const LAS f32x4*)(pb + (T4 * 2 + rti) * 4608 + ri * 144 + e4 * 16); \
        v2u w; w.x = cvtpk_s(a.x, a.y); w.y = cvtpk_s(a.z, a.w); *(v2u*)(INTER + ((size_t)b * SEQ + 64 * (cc) + 32 * rti + ri) * D + h * 128 + 32 * es + 4 * e4) = w; } while (0)
    H2_LOAD(ra, 0); H2_STORE(ra, 0); H2_LOAD(ra, 1); H2_LOAD(rb, 2);
    WG_SYNC();
    for (int c2 = 0; c2 < 64; c2 += 2) {
        { const int c = c2;
        if (wid < 4) {
            const LAS unsigned char* fb = L + SL_FB + (c & 1) * SL_FBSZ; const int T4 = wid;
            const LAS float* decp = (const LAS float*)(fb + 36864) + 32 * T4 + 4 * hi;
            f32x4 rf[4], df[4]; bf16x8v qf[2][2], kf[4], vf[4];
#pragma unroll
            for (int g4 = 0; g4 < 4; ++g4) { rf[g4] = *(const LAS f32x4*)(decp + 128 + 8 * g4); df[g4] = *(const LAS f32x4*)(decp + 8 * g4); }
#pragma unroll
            for (int ti = 0; ti < 2; ++ti)
#pragma unroll
                for (int s = 0; s < 2; ++s) qf[ti][s] = *(const LAS bf16x8v*)(fb + (ti * 8 + 2 * T4 + s) * 1024 + lane * 16);
#pragma unroll
            for (int s = 0; s < 4; ++s) { kf[s] = *(const LAS bf16x8v*)(fb + 16384 + (T4 * 4 + s) * 1024 + lane * 16); vf[s] = *(const LAS bf16x8v*)(fb + 32768 + s * 1024 + lane * 16); }
            asm volatile("s_waitcnt lgkmcnt(0)" ::: "memory"); __builtin_amdgcn_sched_barrier(0);
            bf16x8v sop[2];
#pragma unroll
            for (int s = 0; s < 2; ++s) { union { unsigned u[4]; bf16x8v v; } pk;
#pragma unroll
                for (int g2 = 0; g2 < 2; ++g2) { const f32x4 r4 = rf[2 * s + g2]; const int r0 = 8 * s + 4 * g2;
                    pk.u[2 * g2] = cvtpk_s(S[r0] * r4.x, S[r0 + 1] * r4.y); pk.u[2 * g2 + 1] = cvtpk_s(S[r0 + 2] * r4.z, S[r0 + 3] * r4.w); }
                sop[s] = pk.v; }
            LAS unsigned char* pb = L + SL_PB + (c & 1) * SL_PBSZ;
            f32x16 acc0 = __builtin_amdgcn_mfma_f32_32x32x16_bf16(sop[0], qf[0][0], f32x16{}, 0, 0, 0), acc1 = __builtin_amdgcn_mfma_f32_32x32x16_bf16(sop[0], qf[1][0], f32x16{}, 0, 0, 0);
#pragma unroll
            for (int rg = 0; rg < 4; ++rg) { S[4 * rg] *= df[rg].x; S[4 * rg + 1] *= df[rg].y; S[4 * rg + 2] *= df[rg].z; S[4 * rg + 3] *= df[rg].w; }
            acc0 = __builtin_amdgcn_mfma_f32_32x32x16_bf16(sop[1], qf[0][1], acc0, 0, 0, 0); acc1 = __builtin_amdgcn_mfma_f32_32x32x16_bf16(sop[1], qf[1][1], acc1, 0, 0, 0);
#pragma unroll
            for (int s = 0; s < 4; ++s) S = __builtin_amdgcn_mfma_f32_32x32x16_bf16(kf[s], vf[s], S, 0, 0, 0);
#pragma unroll
            for (int rg = 0; rg < 4; ++rg) { const f32x4 o4 = {acc0[4 * rg], acc0[4 * rg + 1], acc0[4 * rg + 2], acc0[4 * rg + 3]}, o5 = {acc1[4 * rg], acc1[4 * rg + 1], acc1[4 * rg + 2], acc1[4 * rg + 3]};
                *(LAS f32x4*)(pb + (T4 * 2 + 0) * 4608 + q * 144 + (8 * rg + 4 * hi) * 4) = o4; *(LAS f32x4*)(pb + (T4 * 2 + 1) * 4608 + q * 144 + (8 * rg + 4 * hi) * 4) = o5; }
        }
        if (c > 0) H2_REDUCE(c - 1);
        H2_STORE(ra, 1); H2_LOAD(ra, c + 3);
        WG_SYNC(); }
        { const int c = c2 + 1;
        if (wid < 4) {
            const LAS unsigned char* fb = L + SL_FB + (c & 1) * SL_FBSZ; const int T4 = wid;
            const LAS float* decp = (const LAS float*)(fb + 36864) + 32 * T4 + 4 * hi;
            f32x4 rf[4], df[4]; bf16x8v qf[2][2], kf[4], vf[4];
#pragma unroll
            for (int g4 = 0; g4 < 4; ++g4) { rf[g4] = *(const LAS f32x4*)(decp + 128 + 8 * g4); df[g4] = *(const LAS f32x4*)(decp + 8 * g4); }
#pragma unroll
            for (int ti = 0; ti < 2; ++ti)
#pragma unroll
                for (int s = 0; s < 2; ++s) qf[ti][s] = *(const LAS bf16x8v*)(fb + (ti * 8 + 2 * T4 + s) * 1024 + lane * 16);
#pragma unroll
            for (int s = 0; s < 4; ++s) { kf[s] = *(const LAS bf16x8v*)(fb + 16384 + (T4 * 4 + s) * 1024 + lane * 16); vf[s] = *(const LAS bf16x8v*)(fb + 32768 + s * 1024 + lane * 16); }
            asm volatile("s_waitcnt lgkmcnt(0)" ::: "memory"); __builtin_amdgcn_sched_barrier(0);
            bf16x8v sop[2];
#pragma unroll
            for (int s = 0; s < 2; ++s) { union { unsigned u[4]; bf16x8v v; } pk;
#pragma unroll
                for (int g2 = 0; g2 < 2; ++g2) { const f32x4 r4 = rf[2 * s + g2]; const int r0 = 8 * s + 4 * g2;
                    pk.u[2 * g2] = cvtpk_s(S[r0] * r4.x, S[r0 + 1] * r4.y); pk.u[2 * g2 + 1] = cvtpk_s(S[r0 + 2] * r4.z, S[r0 + 3] * r4.w); }
                sop[s] = pk.v; }
            LAS unsigned char* pb = L + SL_PB + (c & 1) * SL_PBSZ;
            f32x16 acc0 = __builtin_amdgcn_mfma_f32_32x32x16_bf16(sop[0], qf[0][0], f32x16{}, 0, 0, 0), acc1 = __builtin_amdgcn_mfma_f32_32x32x16_bf16(sop[0], qf[1][0], f32x16{}, 0, 0, 0);
#pragma unroll
            for (int rg = 0; rg < 4; ++rg) { S[4 * rg] *= df[rg].x; S[4 * rg + 1] *= df[rg].y; S[4 * rg + 2] *= df[rg].z; S[4 * rg + 3] *= df[rg].w; }
            acc0 = __builtin_amdgcn_mfma_f32_32x32x16_bf16(sop[1], qf[0][1], acc0, 0, 0, 0); acc1 = __builtin_amdgcn_mfma_f32_32x32x16_bf16(sop[1], qf[1][1], acc1, 0, 0, 0);
#pragma unroll
            for (int s = 0; s < 4; ++s) S = __builtin_amdgcn_mfma_f32_32x32x16_bf16(kf[s], vf[s], S, 0, 0, 0);
#pragma unroll
            for (int rg = 0; rg < 4; ++rg) { const f32x4 o4 = {acc0[4 * rg], acc0[4 * rg + 1], acc0[4 * rg + 2], acc0[4 * rg + 3]}, o5 = {acc1[4 * rg], acc1[4 * rg + 1], acc1[4 * rg + 2], acc1[4 * rg + 3]};
                *(LAS f32x4*)(pb + (T4 * 2 + 0) * 4608 + q * 144 + (8 * rg + 4 * hi) * 4) = o4; *(LAS f32x4*)(pb + (T4 * 2 + 1) * 4608 + q * 144 + (8 * rg + 4 * hi) * 4) = o5; }
        }
        H2_REDUCE(c - 1);
        if (c + 1 < 64) H2_STORE(rb, 0); H2_LOAD(rb, c + 3);
        WG_SYNC(); }
    }
    H2_REDUCE(63);
#undef H2_LOAD
#undef H2_STORE
#undef H2_REDUCE
}
__device__ __forceinline__ void hgrn_norm2_phase(Frame& F, int j) {
    PHASE_BEGIN();
    const bf16* INTRA = (const bf16*)(ws + WS_INTRA); const bf16* INTER = (const bf16*)(ws + WS_INTER); const bf16* H = (const bf16*)(ws + WS_MIX); bf16* O = (bf16*)(ws + WS_O);
    const float* ng = in_ptr(F, 5) + (size_t)j * 128 + ((8 * lane) & 127);
    const f32x4 gn0 = *(const f32x4*)ng, gn1 = *(const f32x4*)(ng + 4);
    const float gn[8] = {gn0.x, gn0.y, gn0.z, gn0.w, gn1.x, gn1.y, gn1.z, gn1.w};
    for (int m0 = gw * 4; m0 < T; m0 += F.NGW * 4) {
        v4u ia[4][2], ib[4][2], ig[4][2];
#pragma unroll
        for (int r = 0; r < 4; ++r)
#pragma unroll
            for (int hf = 0; hf < 2; ++hf) { const size_t m = (size_t)(m0 + r);
                ia[r][hf] = *(const v4u*)(INTRA + m * D + 512 * hf + 8 * lane); ib[r][hf] = *(const v4u*)(INTER + m * D + 512 * hf + 8 * lane); ig[r][hf] = *(const v4u*)(H + 3 * HM_STRIDE + ((((m >> 12) * 8 + (lane >> 4) + 4 * hf) * SEQ) + (m & 4095)) * 128 + ((8 * lane) & 127)); }
#pragma unroll
        for (int r = 0; r < 4; ++r)
#pragma unroll
            for (int hf = 0; hf < 2; ++hf) { const unsigned a4[4] = {ia[r][hf].x, ia[r][hf].y, ia[r][hf].z, ia[r][hf].w}, b4[4] = {ib[r][hf].x, ib[r][hf].y, ib[r][hf].z, ib[r][hf].w}, g4[4] = {ig[r][hf].x, ig[r][hf].y, ig[r][hf].z, ig[r][hf].w};
                float o[8]; float ss = 0.f;
#pragma unroll
                for (int k = 0; k < 4; ++k) { o[2 * k] = bflo(a4[k]) + bflo(b4[k]); o[2 * k + 1] = bfhi(a4[k]) + bfhi(b4[k]); ss += o[2 * k] * o[2 * k] + o[2 * k + 1] * o[2 * k + 1]; }
                ss += __shfl_xor(ss, 1); ss += __shfl_xor(ss, 2); ss += __shfl_xor(ss, 4); ss += __shfl_xor(ss, 8);
                const float rr = 1.0f / sqrtf(ss * (1.0f / 128.0f) + RMS_EPS);
                unsigned w4[4];
#pragma unroll
                for (int k = 0; k < 4; ++k) { const float g0 = bflo(g4[k]), g1 = bfhi(g4[k]);
                    w4[k] = pk2(o[2 * k] * rr * gn[2 * k] * (g0 / (1.0f + __expf(-g0))), o[2 * k + 1] * rr * gn[2 * k + 1] * (g1 / (1.0f + __expf(-g1)))); }
                v4u w; w.x = w4[0]; w.y = w4[1]; w.z = w4[2]; w.w = w4[3];
                *(v4u*)(O + (size_t)(m0 + r) * D + 512 * hf + 8 * lane) = w; }
    }
}

constexpr int LNA_HOLD = 24;
constexpr int RL_G = 0, RL_B = 4096, RL_LG = 8192, RL_HIST = 8192 + 8 * 3072, RL_BASE = RL_HIST + 128;
__device__ __forceinline__ void lna_phase(Frame& F, int l) {
    PHASE_BEGIN();
    _Float16* X = (_Float16*)(ws + WS_X); bf16* XB = (bf16*)(ws + WS_XB); const unsigned char* WR = ws + WS_WR;
    const float* XIN = in_ptr(F, 0); const bf16* MO = (const bf16*)(ws + WS_MO);
    const float* lg_ = in_ptr(F, 7) + (size_t)(l * 2) * D; const float* lb_ = in_ptr(F, 8) + (size_t)(l * 2) * D;
    const float* bg = in_ptr(F, 10) + l * 4; const float* be = in_ptr(F, 12) + l * 32;
    float* RW = (float*)(ws + WS_RW); int* POS = (int*)(ws + WS_POS); int* TOK2 = (int*)(ws + WS_TOK2); unsigned* GCNT = (unsigned*)(ws + WS_GCNT) + l * 512;
    LAS unsigned char* L = F.lds; const int wid = __builtin_amdgcn_readfirstlane(tid >> 6);
    if (tid < 256) { ((LAS f32x4*)(L + RL_G))[tid] = ((const f32x4*)lg_)[tid]; ((LAS f32x4*)(L + RL_B))[tid] = ((const f32x4*)lb_)[tid]; }
    if (tid < 32) ((LAS unsigned*)(L + RL_HIST))[tid] = 0u;
    WG_SYNC();
    const int row = lane & 15, kq = lane >> 4; const size_t m = (size_t)gw * 16 + row;
    _Float16* xrow = X + m * D + 8 * kq; bf16* xbrow = XB + m * D + 8 * kq; const float* xin = XIN + m * D + 8 * kq; const bf16* morow = MO + m * D + 8 * kq;
#define LNA_V(ks, a, b2) do { f32x4 xa_, xb_; if (l == 0) { xa_ = *(const f32x4*)(xin + 32 * (ks)); xb_ = *(const f32x4*)(xin + 32 * (ks) + 4); } \
        else { const f32x8 x8_ = __builtin_convertvector(*(const f16x8*)(xrow + 32 * (ks)), f32x8); xa_ = (f32x4){x8_[0], x8_[1], x8_[2], x8_[3]}; xb_ = (f32x4){x8_[4], x8_[5], x8_[6], x8_[7]}; } \
        const v4u mo_ = *(const v4u*)(morow + 32 * (ks)); \
        a.x = ALPHA * xa_.x + bflo(mo_.x); a.y = ALPHA * xa_.y + bfhi(mo_.x); a.z = ALPHA * xa_.z + bflo(mo_.y); a.w = ALPHA * xa_.w + bfhi(mo_.y); \
        b2.x = ALPHA * xb_.x + bflo(mo_.z); b2.y = ALPHA * xb_.y + bfhi(mo_.z); b2.z = ALPHA * xb_.z + bflo(mo_.w); b2.w = ALPHA * xb_.w + bfhi(mo_.w); } while (0)
    float s1 = 0.f, s2 = 0.f; f16x8 vh[LNA_HOLD];
#pragma unroll
    for (int ks = 0; ks < 32; ++ks) { f32x4 a, b2; LNA_V(ks, a, b2);
        s1 += (a.x + a.y) + (a.z + a.w) + (b2.x + b2.y) + (b2.z + b2.w);
        s2 += (a.x * a.x + a.y * a.y) + (a.z * a.z + a.w * a.w) + (b2.x * b2.x + b2.y * b2.y) + (b2.z * b2.z + b2.w * b2.w);
        if (ks < LNA_HOLD) { const f32x8 v8 = {a.x, a.y, a.z, a.w, b2.x, b2.y, b2.z, b2.w}; vh[ks] = __builtin_convertvector(v8, f16x8); }
        if ((ks & 7) == 7) __builtin_amdgcn_sched_barrier(0); }
    s1 += __shfl_xor(s1, 16); s1 += __shfl_xor(s1, 32); s2 += __shfl_xor(s2, 16); s2 += __shfl_xor(s2, 32);
    const float mean = s1 * (1.f / D); const float var = fmaxf(s2 * (1.f / D) - mean * mean, 0.f); const float rstd = 1.f / sqrtf(var + LN_EPS);
    typedef float f32x4a __attribute__((ext_vector_type(4)));
    f32x4a acc[3]; acc[0] = acc[1] = acc[2] = (f32x4a){0.f, 0.f, 0.f, 0.f};
#pragma unroll
    for (int kk = 0; kk < 32; ++kk) { const int ks = (kk + LNA_HOLD) & 31;
        f32x4 a, b2;
        if (ks < LNA_HOLD) { const f32x8 v8 = __builtin_convertvector(vh[ks], f32x8); a = (f32x4){v8[0], v8[1], v8[2], v8[3]}; b2 = (f32x4){v8[4], v8[5], v8[6], v8[7]}; }
        else LNA_V(ks, a, b2);
        const LAS float* gp = (const LAS float*)(L + RL_G) + 32 * ks + 8 * kq; const LAS float* bp = (const LAS float*)(L + RL_B) + 32 * ks + 8 * kq;
        const f32x4 g0 = *(const LAS f32x4*)gp, g1 = *(const LAS f32x4*)(gp + 4), c0 = *(const LAS f32x4*)bp, c1 = *(const LAS f32x4*)(bp + 4);
        const f32x4 y0 = (a - mean) * rstd * g0 + c0, y1 = (b2 - mean) * rstd * g1 + c1;
        { const f32x8 y8 = {y0.x, y0.y, y0.z, y0.w, y1.x, y1.y, y1.z, y1.w}; *(f16x8*)(xrow + 32 * ks) = __builtin_convertvector(y8, f16x8); }
        union { unsigned u[4]; bf16x8v v; v4u q; } xh, xl;
        xh.u[0] = pk2(y0.x, y0.y); xh.u[1] = pk2(y0.z, y0.w); xh.u[2] = pk2(y1.x, y1.y); xh.u[3] = pk2(y1.z, y1.w);
        xl.u[0] = pk2(y0.x - bflo(xh.u[0]), y0.y - bfhi(xh.u[0])); xl.u[1] = pk2(y0.z - bflo(xh.u[1]), y0.w - bfhi(xh.u[1]));
        xl.u[2] = pk2(y1.x - bflo(xh.u[2]), y1.y - bfhi(xh.u[2])); xl.u[3] = pk2(y1.z - bflo(xh.u[3]), y1.w - bfhi(xh.u[3]));
#pragma unroll
        for (int nt = 0; nt < 3; ++nt) { const bf16x8v wh = *(const bf16x8v*)(WR + ((size_t)((ks * 3 + nt) * 2 + 0) * 64 + lane) * 16), wl = *(const bf16x8v*)(WR + ((size_t)((ks * 3 + nt) * 2 + 1) * 64 + lane) * 16);
            acc[nt] = __builtin_amdgcn_mfma_f32_16x16x32_bf16(xh.v, wh, acc[nt], 0, 0, 0);
            acc[nt] = __builtin_amdgcn_mfma_f32_16x16x32_bf16(xh.v, wl, acc[nt], 0, 0, 0);
            acc[nt] = __builtin_amdgcn_mfma_f32_16x16x32_bf16(xl.v, wh, acc[nt], 0, 0, 0); }
        if ((kk & 3) == 3) __builtin_amdgcn_sched_barrier(0);
    }
    LAS float* lgs = (LAS float*)(L + RL_LG + wid * 3072);
#pragma unroll
    for (int nt = 0; nt < 3; ++nt)
#pragma unroll
        for (int r = 0; r < 4; ++r) lgs[(4 * kq + r) * 48 + 16 * nt + row] = acc[nt][r];
    LDS_WAIT(); asm volatile("" ::: "memory");
    int e1 = 0, e2 = 0; unsigned r1 = 0u, r2 = 0u;
    if (lane < 16) {
        float lg[4], le[32];
        { const f32x4 t0 = *(const LAS f32x4*)(lgs + lane * 48); lg[0] = t0.x + bg[0]; lg[1] = t0.y + bg[1]; lg[2] = t0.z + bg[2]; lg[3] = t0.w + bg[3]; }
#pragma unroll
        for (int q4 = 0; q4 < 8; ++q4) { const f32x4 t0 = *(const LAS f32x4*)(lgs + lane * 48 + 4 + 4 * q4); const f32x4 bb = *(const f32x4*)(be + 4 * q4);
            le[4 * q4] = t0.x + bb.x; le[4 * q4 + 1] = t0.y + bb.y; le[4 * q4 + 2] = t0.z + bb.z; le[4 * q4 + 3] = t0.w + bb.w; }
        float best = lg[0]; int grp = 0;
#pragma unroll
        for (int i = 1; i < 4; ++i) if (lg[i] > best) { best = lg[i]; grp = i; }
        float den = 0.f;
#pragma unroll
        for (int i = 0; i < 4; ++i) den += expf(lg[i] - best);
        const float pg = 1.0f / den;
        float b1 = -INFINITY, b2v = -INFINITY; int i1 = 0, i2 = 0;
#pragma unroll
        for (int i = 0; i < 32; ++i) if ((i >> 3) == grp && le[i] > b1) { b1 = le[i]; i1 = i; }
#pragma unroll
        for (int i = 0; i < 32; ++i) if ((i >> 3) == grp && i != i1 && le[i] > b2v) { b2v = le[i]; i2 = i; }
        const float e21 = expf(b2v - b1); const float w1 = pg / (1.0f + e21), w2 = pg * e21 / (1.0f + e21);
        const size_t mt = (size_t)gw * 16 + lane; RW[2 * mt] = w1; RW[2 * mt + 1] = w2; e1 = i1; e2 = i2;
        r1 = __hip_atomic_fetch_add((LAS unsigned*)(L + RL_HIST) + i1, 1u, __ATOMIC_RELAXED, __HIP_MEMORY_SCOPE_WORKGROUP); r2 = __hip_atomic_fetch_add((LAS unsigned*)(L + RL_HIST) + i2, 1u, __ATOMIC_RELAXED, __HIP_MEMORY_SCOPE_WORKGROUP);
    }
    WG_SYNC();
    if (tid < 32) { const unsigned c = ((LAS unsigned*)(L + RL_HIST))[tid]; unsigned base = 0u; if (c) base = __hip_atomic_fetch_add(GCNT + tid * 16, c, __ATOMIC_RELAXED, __HIP_MEMORY_SCOPE_AGENT); ((LAS unsigned*)(L + RL_BASE))[tid] = base; }
    WG_SYNC();
    if (lane < 16) { const int mt = gw * 16 + lane; const unsigned o1 = ((LAS unsigned*)(L + RL_BASE))[e1] + r1, o2 = ((LAS unsigned*)(L + RL_BASE))[e2] + r2;
        POS[2 * mt] = (int)(((unsigned)e1 << 20) | o1); POS[2 * mt + 1] = (int)(((unsigned)e2 << 20) | o2); TOK2[(size_t)e1 * TOKCAP + o1] = mt; TOK2[(size_t)e2 * TOKCAP + o2] = mt; }
}
__device__ __forceinline__ void lnb_phase(Frame& F, int l) {
    PHASE_BEGIN();
    _Float16* X = (_Float16*)(ws + WS_X); bf16* XB = (bf16*)(ws + WS_XB); const bf16* YB = (const bf16*)(ws + WS_YB);
    const float* lg_ = in_ptr(F, 7) + (size_t)(l * 2 + 1) * D; const float* lb_ = in_ptr(F, 8) + (size_t)(l * 2 + 1) * D;
    const int* POS = (const int*)(ws + WS_POS); const float* RW = (const float*)(ws + WS_RW);
    const bool last = (l == DEPTH - 1); float* OUT = (float*)in_ptr(F, 16);
    f32x4 gv[4], bv[4];
#pragma unroll
    for (int j = 0; j < 4; ++j) { gv[j] = *(const f32x4*)(lg_ + 4 * lane + 256 * j); bv[j] = *(const f32x4*)(lb_ + 4 * lane + 256 * j); }
    for (int p = gw; p < T / 2; p += F.NGW) {
        const v4u pp = *(const v4u*)(POS + 4 * p); const f32x4 ww = *(const f32x4*)(RW + 4 * p);
        const int ps[4] = {(int)F.MISC[320 + (pp.x >> 20)] * 256 + (int)(pp.x & 0xFFFFFu), (int)F.MISC[320 + (pp.y >> 20)] * 256 + (int)(pp.y & 0xFFFFFu), (int)F.MISC[320 + (pp.z >> 20)] * 256 + (int)(pp.z & 0xFFFFFu), (int)F.MISC[320 + (pp.w >> 20)] * 256 + (int)(pp.w & 0xFFFFFu)}; const float wv[4] = {ww.x, ww.y, ww.z, ww.w};
        f32x4 xv[2][4]; v2u ya[2][4], yc[2][4];
#pragma unroll
        for (int t = 0; t < 2; ++t) { const f16x4* xr = (const f16x4*)(X + (size_t)(2 * p + t) * D) + lane;
            const v2u* y0 = (const v2u*)(YB + (size_t)ps[2 * t] * D) + lane; const v2u* y1 = (const v2u*)(YB + (size_t)ps[2 * t + 1] * D) + lane;
#pragma unroll
            for (int j = 0; j < 4; ++j) { xv[t][j] = __builtin_convertvector(xr[64 * j], f32x4); ya[t][j] = y0[64 * j]; yc[t][j] = y1[64 * j]; } }
#pragma unroll
        for (int t = 0; t < 2; ++t) { const float w0 = wv[2 * t], w1 = wv[2 * t + 1]; f32x4 v[4]; float s = 0.f;
#pragma unroll
            for (int j = 0; j < 4; ++j) { const f32x4 x4 = xv[t][j]; const v2u a = ya[t][j], c = yc[t][j];
                v[j].x = ALPHA * x4.x + w0 * bflo(a.x) + w1 * bflo(c.x); v[j].y = ALPHA * x4.y + w0 * bfhi(a.x) + w1 * bfhi(c.x);
                v[j].z = ALPHA * x4.z + w0 * bflo(a.y) + w1 * bflo(c.y); v[j].w = ALPHA * x4.w + w0 * bfhi(a.y) + w1 * bfhi(c.y);
                s += (v[j].x + v[j].y) + (v[j].z + v[j].w); }
            const float mean = wave_sum(s) * (1.f / D); float s2 = 0.f;
#pragma unroll
            for (int j = 0; j < 4; ++j) { v[j] = v[j] - mean; s2 += (v[j].x * v[j].x + v[j].y * v[j].y) + (v[j].z * v[j].z + v[j].w * v[j].w); }
            const float rstd = 1.f / sqrtf(wave_sum(s2) * (1.f / D) + LN_EPS);
            f32x4* outr = (f32x4*)(OUT + (size_t)(2 * p + t) * D) + lane; f16x4* outh = (f16x4*)(X + (size_t)(2 * p + t) * D) + lane; v2u* o8 = (v2u*)(XB + (size_t)(2 * p + t) * D) + lane;
#pragma unroll
            for (int j = 0; j < 4; ++j) { v[j] = v[j] * rstd * gv[j] + bv[j]; if (last) outr[64 * j] = v[j]; else outh[64 * j] = __builtin_convertvector(v[j], f16x4);
} }
    }
}

struct Args { const float* in[16]; float* out; unsigned char* ws; };
#ifndef PROBE_MASK
#define PROBE_MASK 0
#endif
#define GRID_BAR(g) do { unsigned char* wsb_ = F.ws; asm volatile("" : "+s"(wsb_)); XcdBarrier bar_; bar_.bar = (unsigned*)(wsb_ + WS_CTL) + CW_BAR; bar_.x = xb_xcc_id(); bar_.st = F.MISC; xcd_barrier(bar_); STAMP(g); } while (0)
template <int l>
__device__ __forceinline__ void layer_body(Frame& F, PG8_LAS unsigned char* ring) {
    constexpr bool even = (l & 1) == 0; constexpr int j = l >> 1; int moe_done = 0;
    if constexpr (even) { LAUNDER_WS();
        pg8::Gemm g{(const pg8::bf16_t*)(ws + WS_X), (const pg8::bf16_t*)(ws + WS_WIN), T, NQKV, D}; pg8::StaticOrder S; S.init(T, NQKV, F.G, bx);
        pg8::EpiQKV E{(pg8::bf16_t*)(ws + WS_MIX), (const float*)(ws + WS_ROPE), (float*)(ws + WS_KMEAN) + (size_t)j * 65536};
        pg8::gemm_phase<pg8::EpiQKV, pg8::StaticOrder, true, true, true>(ring, g, S, E); }
    else { LAUNDER_WS();
        pg8::Gemm g{(const pg8::bf16_t*)(ws + WS_X), (const pg8::bf16_t*)(ws + WS_WIN), T, NH4, D}; pg8::StaticOrder S; S.init(T, NH4, F.G, bx);
        pg8::EpiHeadMajor E{(pg8::bf16_t*)(ws + WS_MIX)};
        pg8::gemm_phase<pg8::EpiHeadMajor, pg8::StaticOrder, true, true, true>(ring, g, S, E); }
    GRID_BAR(1);
    if constexpr (even) {
        attn_fast_phase(F, j); GRID_BAR(12);
        attn_gather_phase(F, j); attn_dil2_phase(F, l == 0 ? 0 : -1); GRID_BAR(2);
        attn_own_phase(F); GRID_BAR(13);
    } else {
        hgrn_h1_phase(F, j); GRID_BAR(3);
        hgrn_h2_phase(F); GRID_BAR(4);
        hgrn_norm2_phase(F, j); GRID_BAR(5);
    }
    { LAUNDER_WS(); pg8::Gemm g{(const pg8::bf16_t*)(ws + WS_O), (const pg8::bf16_t*)(ws + WS_WOUT), T, D, D}; pg8::StaticOrder S; S.init(T, D, F.G, bx);
      pg8::EpiPlain E{(pg8::bf16_t*)(ws + WS_MO), D, 0xffff};
      pg8::gemm_phase<pg8::EpiPlain, pg8::StaticOrder, true, true>(ring, g, S, E); }
    GRID_BAR(6);
    lna_phase(F, l); GRID_BAR(7);
    { LAUNDER_WS(); pg8::Gemm g{(const pg8::bf16_t*)(ws + WS_X), (const pg8::bf16_t*)(ws + ((l & 1) ? WS_W13B : WS_W13)), T, 1024, D};
      pg8::MoeOrder S{(const PG8_LAS int*)(F.lds + MISC_OFF + 64), F.G, (F.G % 8 == 0) ? (bx % 8) * (F.G / 8) + bx / 8 : bx};
      pg8::EpiSwiGlu E{(pg8::bf16_t*)(ws + WS_HB), FEXP};
      PG8_LAS int* tokl = (PG8_LAS int*)(F.lds + RING_BYTES); const int* TOK2 = (const int*)(ws + WS_TOK2);
      { volatile LAS int* MI = (volatile LAS int*)F.MISC; unsigned* GC = (unsigned*)(ws + WS_GCNT) + l * 512;
        if (threadIdx.x < 64) { const int e = threadIdx.x & 31; const int tot = (int)__hip_atomic_load(GC + e * 16, __ATOMIC_RELAXED, __HIP_MEMORY_SCOPE_AGENT); const int n = (tot + 255) >> 8; int inc = n;
#pragma unroll
            for (int d = 1; d < 32; d <<= 1) { const int o_ = __shfl_up(inc, d, 32); if (e >= d) inc += o_; }
            const int acc = inc - n;
            if (threadIdx.x < 32) { MI[320 + e] = acc; MI[352 + e] = tot;
                for (int k = 0; k < n; ++k) MI[17 + acc + k] = e;
                if (e == 31) MI[16] = inc; } }
        WG_SYNC();
        for (int i = 0; i < 5; ++i) { pg8::Unit u; if (!S.next(i, u)) break;
            if (threadIdx.x < 256) { const int e = u.pn >> 2; const int loc = (u.pm - MI[320 + e]) * 256 + (int)threadIdx.x; int t = 0; if (loc < MI[352 + e]) t = TOK2[(size_t)e * TOKCAP + loc]; tokl[i * 256 + threadIdx.x] = ((unsigned)t < (unsigned)T) ? t : 0; } } }
      WG_SYNC();
      if constexpr (l + 1 < DEPTH) { (void)cvt_tail(F, l + 1, (int)F.MISC[16], S.vc, 0, 80, 0); WG_SYNC(); }
      pg8::gemm_phase_gather<pg8::EpiSwiGlu, pg8::MoeOrder, true>(ring, g, S, E, tokl);
      if constexpr (l + 1 < DEPTH) { WG_SYNC(); moe_done = cvt_tail(F, l + 1, (int)F.MISC[16], S.vc, 0, 80, 1); } }
    GRID_BAR(9);
    { LAUNDER_WS(); pg8::Gemm g{(const pg8::bf16_t*)(ws + WS_HB), (const pg8::bf16_t*)(ws + ((l & 1) ? WS_W2B : WS_W2)), MAX_TILES * 256, 1024, FEXP};
      pg8::MoeOrder S{(const PG8_LAS int*)(F.lds + MISC_OFF + 64), F.G, (F.G % 8 == 0) ? (bx % 8) * (F.G / 8) + bx / 8 : bx};
      pg8::EpiPlain E{(pg8::bf16_t*)(ws + WS_YB), D, 3};
      if constexpr (l + 1 < DEPTH) { (void)cvt_tail(F, l + 1, (int)F.MISC[16], S.vc, moe_done, 48, 0); WG_SYNC(); }
      pg8::gemm_phase<pg8::EpiPlain, pg8::MoeOrder, false, true>(ring, g, S, E);
      if constexpr (l + 1 < DEPTH) { WG_SYNC(); moe_done = cvt_tail(F, l + 1, (int)F.MISC[16], S.vc, moe_done, 48, 1); } }
    GRID_BAR(10);
    lnb_phase(F, l);
    if constexpr (l + 1 < DEPTH) { convert_weights(F, l + 1, moe_done); GRID_BAR(11); }
}
__global__ void __launch_bounds__(NWAVES * 64, 2) mega_fwd(Args args) {
    extern __shared__ __attribute__((aligned(16))) unsigned char lds[];
    Frame F;
    F.lds = (LAS unsigned char*)lds; F.MISC = (volatile LAS unsigned*)(F.lds + MISC_OFF);
    F.tid = threadIdx.x; F.lane = F.tid & 63; F.wave = __builtin_amdgcn_readfirstlane(F.tid >> 6);
    F.G = gridDim.x; F.gw = blockIdx.x * NWAVES + F.wave; F.NGW = F.G * NWAVES;
    F.ws = args.ws;
    for (int u = F.tid; u < (LDS_BYTES - MISC_OFF) / 4; u += NWAVES * 64) F.MISC[u] = 0u;
    __syncthreads();
    if (F.tid < 17) { const unsigned long long p = F.tid < 16 ? (unsigned long long)args.in[F.tid] : (unsigned long long)args.out; F.MISC[512 + 2 * F.tid] = (unsigned)p; F.MISC[513 + 2 * F.tid] = (unsigned)(p >> 32); }
    if (PROBE_MASK != 0 && F.tid == 0) F.MISC[599] = (unsigned)__builtin_amdgcn_s_memrealtime();
    __syncthreads();
    { XcdBarrier b0 = xcd_barrier_post((unsigned*)(F.ws + WS_CTL) + CW_BAR, F.MISC); (void)b0; }
    PG8_LAS unsigned char* ring = (PG8_LAS unsigned char*)lds;
    prologue(F); convert_weights(F, 0, CVT_MOE);
    GRID_BAR(0);
    layer_body<0>(F, ring); layer_body<1>(F, ring); layer_body<2>(F, ring); layer_body<3>(F, ring);
    if (PROBE_MASK != 0 && blockIdx.x == 0 && F.tid == 0) {
        STAMP(11); unsigned tot = 0;
        for (int g = 0; g < 16; ++g) if ((PROBE_MASK >> g) & 1) tot += F.MISC[600 + g];
        const unsigned long long t0 = __builtin_amdgcn_s_memrealtime(), wait = 8ull * tot;
        while (__builtin_amdgcn_s_memrealtime() - t0 < wait) __builtin_amdgcn_s_sleep(32);
    }
}

extern "C" void kernel_launch(void* const* d_in, const int* in_sizes, int n_in, void* d_out, int out_size, void* d_ws, size_t ws_size, hipStream_t stream) {
    static int grid = 0;
    if (grid == 0) {
        if (n_in != 16 || in_sizes[0] != T * D || out_size != T * D || ws_size < WS_END) { fprintf(stderr, "kernel_launch: unexpected shapes (n_in %d, in0 %d, out %d, ws %zu)\n", n_in, n_in > 0 ? in_sizes[0] : -1, out_size, ws_size); grid = -1; return; }
        int dev = 0, cus = 0, per_cu = 0;
        if (hipGetDevice(&dev) != hipSuccess || hipDeviceGetAttribute(&cus, hipDeviceAttributeMultiprocessorCount, dev) != hipSuccess) { grid = -1; return; }
        if (hipFuncSetAttribute((const void*)mega_fwd, hipFuncAttributeMaxDynamicSharedMemorySize, LDS_BYTES) != hipSuccess) { fprintf(stderr, "kernel_launch: hipFuncSetAttribute failed\n"); grid = -1; return; }
        if (hipOccupancyMaxActiveBlocksPerMultiprocessor(&per_cu, (const void*)mega_fwd, NWAVES * 64, LDS_BYTES) != hipSuccess || per_cu < 1) fprintf(stderr, "kernel_launch: occupancy query reports %d\n", per_cu);
        (void)hipGetLastError();
        grid = cus;
    }
    if (grid < 0) return;
    if (hipMemsetAsync((char*)d_ws + WS_CTL, 0, CTL_ZERO_BYTES, stream) != hipSuccess) return;
    Args a{};
    for (int i = 0; i < 16; ++i) a.in[i] = (const float*)d_in[i];
    a.out = (float*)d_out; a.ws = (unsigned char*)d_ws;
    hipLaunchKernelGGL(mega_fwd, dim3(grid), dim3(NWAVES * 64), LDS_BYTES, stream, a);
}
```
